# Optimizing an MI355X kernel written in HIP

```python
import math
import jax, jax.numpy as jnp
from jax import lax
import numpy as np

D_MODEL = 4096
BATCH = 1
SEQ = 8192
DEPTH = 2
DEC_BATCH = 8
DEC_SEQ = 2048
PAST_LEN = 128

N_EVEN = (DEPTH + 1) // 2
N_ODD = DEPTH // 2

POOL_WINDOWS = (2, 4, 8, 16)
N_POOL = len(POOL_WINDOWS)
POOL_DIM = (3 * D_MODEL) // 4
POOL_GROUP = POOL_DIM // N_POOL
FOURIER_DIM = D_MODEL - POOL_DIM
N_FOURIER_HEADS = 4
FOURIER_HEAD_DIM = FOURIER_DIM // N_FOURIER_HEADS

DIFF_HEAD_DIM = 128
N_DIFF_HEADS = D_MODEL // (2 * DIFF_HEAD_DIM)
ROT_DIM = DIFF_HEAD_DIM // 4
ROPE_THETA = 500000.0
Q_BLOCK = 128
SUBLN_EPS = 1e-5

D_FF = 11008
CONV_WIDTH = 3
NORM_EPS = 1e-6

kernel_name = 'hybrid_pool_fourier_diffattn_encoder'


def rms_norm(x, g, eps=NORM_EPS):
    xf = x.astype(jnp.float32)
    y = xf * lax.rsqrt(jnp.mean(xf * xf, axis=-1, keepdims=True) + eps)
    return (y * g.astype(jnp.float32)).astype(x.dtype)


def pool_mixer(u, pool_w, pool_scale):
    B, L, _ = u.shape
    ug = u.reshape(B, L, N_POOL, POOL_GROUP).astype(jnp.float32)
    cs = jnp.pad(jnp.cumsum(ug, axis=1), ((0, 0), (1, 0), (0, 0), (0, 0)))
    t = jnp.arange(L)
    outs = []
    for g, w in enumerate(POOL_WINDOWS):
        h = w // 2
        csg = jnp.pad(cs[:, :, g], ((0, 0), (h, h), (0, 0)), mode='edge')
        win = csg[:, 2 * h:2 * h + L] - csg[:, :L]
        cnt = (jnp.minimum(t + h, L) - jnp.maximum(t - h, 0)).astype(jnp.float32)
        outs.append(win / cnt[None, :, None] - ug[:, :, g])
    pooled = jnp.stack(outs, axis=2).astype(u.dtype)
    mixed = jnp.einsum('blgc,gcd->blgd', pooled, pool_w).reshape(B, L, POOL_DIM)
    return mixed * pool_scale


def fourier_mixer(v, fourier_w):
    B, L, _ = v.shape
    vh = v.reshape(B, L, N_FOURIER_HEADS, FOURIER_HEAD_DIM).astype(jnp.float32)
    f = jnp.fft.fft2(vh, axes=(1, 3), norm='ortho').real
    return f.reshape(B, L, FOURIER_DIM).astype(v.dtype) @ fourier_w


def even_mixer(x, norm_g, w_in, pool_w, pool_scale, fourier_w, w_out):
    h = rms_norm(x, norm_g)
    u = h @ w_in
    a = pool_mixer(u[..., :POOL_DIM], pool_w, pool_scale)
    b = fourier_mixer(u[..., POOL_DIM:], fourier_w)
    return jnp.concatenate([a, b], axis=-1) @ w_out


def partial_rotary(x, pos):
    inv = ROPE_THETA ** (-jnp.arange(0, ROT_DIM, 2, dtype=jnp.float32) / ROT_DIM)
    ang = pos[:, None] * inv[None, :]
    cos = jnp.concatenate([jnp.cos(ang), jnp.cos(ang)], axis=-1)
    sin = jnp.concatenate([jnp.sin(ang), jnp.sin(ang)], axis=-1)
    xr = x[..., :ROT_DIM].astype(jnp.float32)
    x1, x2 = xr[..., :ROT_DIM // 2], xr[..., ROT_DIM // 2:]
    rot = jnp.concatenate([-x2, x1], axis=-1)
    xr = xr * cos + rot * sin
    return jnp.concatenate([xr.astype(x.dtype), x[..., ROT_DIM:]], axis=-1)


def diff_attention(x, norm_g, w_qkv, lq1, lk1, lq2, lk2, subln_w, w_out, layer):
    B, L, _ = x.shape
    h = rms_norm(x, norm_g)
    qkv = h @ w_qkv
    q, k, v = jnp.split(qkv, 3, axis=-1)
    q = q.reshape(B, L, N_DIFF_HEADS, 2, DIFF_HEAD_DIM).transpose(0, 2, 3, 1, 4)
    k = k.reshape(B, L, N_DIFF_HEADS, 2, DIFF_HEAD_DIM).transpose(0, 2, 3, 1, 4)
    v = v.reshape(B, L, N_DIFF_HEADS, 2 * DIFF_HEAD_DIM).transpose(0, 2, 1, 3)
    pos = jnp.arange(L, dtype=jnp.float32)
    q = partial_rotary(q, pos)
    k = partial_rotary(k, pos)
    lambda_init = 0.8 - 0.6 * math.exp(-0.3 * layer)
    lam = (jnp.exp(jnp.sum(lq1.astype(jnp.float32) * lk1.astype(jnp.float32)))
           - jnp.exp(jnp.sum(lq2.astype(jnp.float32) * lk2.astype(jnp.float32)))
           + lambda_init)
    scale = DIFF_HEAD_DIM ** -0.5
    vf = v.astype(jnp.float32)
    nb = L // Q_BLOCK
    qb = jnp.moveaxis(q.reshape(B, N_DIFF_HEADS, 2, nb, Q_BLOCK, DIFF_HEAD_DIM), 3, 0)

    def block(qi):
        s = jnp.einsum('bhmqd,bhmkd->bhmqk', qi, k, preferred_element_type=jnp.float32) * scale
        p = jax.nn.softmax(s, axis=-1)
        a = p[:, :, 0] - lam * p[:, :, 1]
        return jnp.einsum('bhqk,bhkv->bhqv', a, vf)

    o = lax.map(block, qb)
    o = jnp.moveaxis(o, 0, 2).reshape(B, N_DIFF_HEADS, L, 2 * DIFF_HEAD_DIM)
    o = rms_norm(o, subln_w, eps=SUBLN_EPS) * (1.0 - lambda_init)
    o = o.transpose(0, 2, 1, 3).reshape(B, L, D_MODEL).astype(x.dtype)
    return o @ w_out


def conv_ffn(x, norm_g, w_up, conv_w, conv_b, w_down):
    h = rms_norm(x, norm_g)
    u = h @ w_up
    p = jnp.pad(u, ((0, 0), (1, 1), (0, 0)))
    c = p[:, :-2] * conv_w[0] + p[:, 1:-1] * conv_w[1] + p[:, 2:] * conv_w[2] + conv_b
    gate, up = jnp.split(c, 2, axis=-1)
    return (jax.nn.silu(gate) * up) @ w_down


def trunk(x, mix_norm_even, w_in_even, pool_w, pool_scale, fourier_w, w_out_even,
          mix_norm_odd, w_qkv, lambda_q1, lambda_k1, lambda_q2, lambda_k2, subln_w, w_out_odd,
          ffn_norm, w_up, conv_w, conv_b, w_down, final_norm):
    for layer in range(DEPTH):
        i = layer // 2
        if layer % 2 == 0:
            x = x + even_mixer(x, mix_norm_even[i], w_in_even[i], pool_w[i], pool_scale[i],
                               fourier_w[i], w_out_even[i])
        else:
            x = x + diff_attention(x, mix_norm_odd[i], w_qkv[i], lambda_q1[i], lambda_k1[i],
                                   lambda_q2[i], lambda_k2[i], subln_w[i], w_out_odd[i], layer)
        x = x + conv_ffn(x, ffn_norm[layer], w_up[layer], conv_w[layer], conv_b[layer], w_down[layer])
    return rms_norm(x, final_norm)


def setup_inputs(seed: int = 0) -> dict:
    key = jax.random.key(seed)
    ks = jax.random.split(key, 24)
    f32 = jnp.float32
    D = D_MODEL

    def nrm(k, shape, s):
        return jax.random.normal(k, shape, f32) * s

    return {
        'x_prompt': nrm(ks[0], (BATCH, SEQ, D), 1.0),
        'x_sample': nrm(ks[1], (DEC_BATCH, DEC_SEQ, D), 1.0),
        'mix_norm_even': 1.0 + nrm(ks[2], (N_EVEN, D), 0.02),
        'w_in_even': nrm(ks[3], (N_EVEN, D, D), D ** -0.5),
        'pool_w': nrm(ks[4], (N_EVEN, N_POOL, POOL_GROUP, POOL_GROUP), POOL_GROUP ** -0.5),
        'pool_scale': 1.0 + nrm(ks[5], (N_EVEN, POOL_DIM), 0.1),
        'fourier_w': nrm(ks[6], (N_EVEN, FOURIER_DIM, FOURIER_DIM), FOURIER_DIM ** -0.5),
        'w_out_even': nrm(ks[7], (N_EVEN, D, D), D ** -0.5),
        'mix_norm_odd': 1.0 + nrm(ks[8], (N_ODD, D), 0.02),
        'w_qkv': nrm(ks[9], (N_ODD, D, 3 * D), D ** -0.5),
        'lambda_q1': nrm(ks[10], (N_ODD, DIFF_HEAD_DIM), 0.1),
        'lambda_k1': nrm(ks[11], (N_ODD, DIFF_HEAD_DIM), 0.1),
        'lambda_q2': nrm(ks[12], (N_ODD, DIFF_HEAD_DIM), 0.1),
        'lambda_k2': nrm(ks[13], (N_ODD, DIFF_HEAD_DIM), 0.1),
        'subln_w': 1.0 + nrm(ks[14], (N_ODD, 2 * DIFF_HEAD_DIM), 0.02),
        'w_out_odd': nrm(ks[15], (N_ODD, D, D), D ** -0.5),
        'ffn_norm': 1.0 + nrm(ks[16], (DEPTH, D), 0.02),
        'w_up': nrm(ks[17], (DEPTH, D, 2 * D_FF), D ** -0.5),
        'conv_w': nrm(ks[18], (DEPTH, CONV_WIDTH, 2 * D_FF), CONV_WIDTH ** -0.5),
        'conv_b': nrm(ks[19], (DEPTH, 2 * D_FF), 0.01),
        'w_down': nrm(ks[20], (DEPTH, D_FF, D), D_FF ** -0.5),
        'final_norm': 1.0 + nrm(ks[21], (D,), 0.02),
    }


def reference(x_prompt, x_sample, mix_norm_even, w_in_even, pool_w, pool_scale, fourier_w,
              w_out_even, mix_norm_odd, w_qkv, lambda_q1, lambda_k1, lambda_q2, lambda_k2,
              subln_w, w_out_odd, ffn_norm, w_up, conv_w, conv_b, w_down, final_norm):
    y_prompt = trunk(x_prompt, mix_norm_even, w_in_even, pool_w, pool_scale, fourier_w, w_out_even,
                     mix_norm_odd, w_qkv, lambda_q1, lambda_k1, lambda_q2, lambda_k2, subln_w,
                     w_out_odd, ffn_norm, w_up, conv_w, conv_b, w_down, final_norm)
    y_sample = trunk(x_sample, mix_norm_even, w_in_even, pool_w, pool_scale, fourier_w, w_out_even,
                     mix_norm_odd, w_qkv, lambda_q1, lambda_k1, lambda_q2, lambda_k2, subln_w,
                     w_out_odd, ffn_norm, w_up, conv_w, conv_b, w_down, final_norm)
    return (y_prompt, y_sample)
```

```cpp
#include <hip/hip_runtime.h>
#include <cstdio>
#include <cstdint>

#ifndef MK_N_LAUNCHES
#define MK_N_LAUNCHES 1
#endif

#define GAS __attribute__((address_space(1)))
#define LAS __attribute__((address_space(3)))
typedef unsigned short bf16_t;
typedef short bf16x8 __attribute__((ext_vector_type(8)));
typedef short s16x4 __attribute__((ext_vector_type(4)));
typedef float f32x4 __attribute__((ext_vector_type(4)));
typedef float f32x2 __attribute__((ext_vector_type(2)));
typedef float f32x16 __attribute__((ext_vector_type(16)));
typedef unsigned u32x4 __attribute__((ext_vector_type(4)));
typedef unsigned u32x2 __attribute__((ext_vector_type(2)));
typedef GAS unsigned gu32;
#define RLX_AGENT __ATOMIC_RELAXED, __HIP_MEMORY_SCOPE_AGENT
#define LDS_WAIT() asm volatile("s_waitcnt lgkmcnt(0)" ::: "memory")
#define VM_WAIT() asm volatile("s_waitcnt vmcnt(0)" ::: "memory")

constexpr int D = 4096, LP = 8192, NSS = 8, LS = 2048, MP = LP, M = LP + NSS * LS;
constexpr int POOL_DIM = 3072, PG = 768, FD = 1024, FH = 256;
constexpr int DFF = 11008, NUP = 2 * DFF, NQKV = 3 * D;
constexpr float NORM_EPS = 1e-6f, SUBLN_EPS = 1e-5f;
constexpr float LAMBDA_INIT = 0.35550906759096327f;
constexpr int NWAVES = 8, NTHREADS = 512;

constexpr size_t MiB = 1u << 20;
constexpr size_t al256(size_t x) { return (x + 255) / 256 * 256; }
constexpr size_t WS_CTL = 0, CTL_ZERO_BYTES = 1 * MiB;
constexpr size_t WS_ROT = WS_CTL + CTL_ZERO_BYTES;
constexpr size_t WS_RSTD = WS_ROT + (size_t)LP * 32 * 4;
constexpr size_t WS_PSUM = WS_RSTD + al256((size_t)M * 4);
constexpr size_t WS_WIN = WS_PSUM + (size_t)M * 64 * 4;
constexpr size_t WS_GT = WS_WIN + (size_t)D * D * 2;
constexpr size_t WS_POOLT = WS_GT + (size_t)2048 * 1024 * 2;
constexpr size_t WS_WOE = WS_POOLT + (size_t)4 * PG * PG * 2;
constexpr size_t WS_WQKV = WS_WOE + (size_t)D * D * 2;
constexpr size_t WS_WOO = WS_WQKV + (size_t)NQKV * D * 2;
constexpr size_t WS_WUP = WS_WOO + (size_t)D * D * 2;
constexpr size_t WS_WDN = WS_WUP + (size_t)2 * NUP * D * 2;
constexpr size_t WS_DFTP = WS_WDN + (size_t)2 * D * DFF * 2;
constexpr size_t WS_DFTS = WS_DFTP + (size_t)LP * 2 * LP * 2;
constexpr size_t WS_XB = WS_DFTS + (size_t)LS * 2 * LS * 2;
constexpr size_t WS_OV = WS_XB + (size_t)M * D * 2;
constexpr size_t WS_U = WS_OV;
constexpr size_t WS_POOLED = WS_U + (size_t)M * D * 2;
constexpr size_t WS_CAT = WS_POOLED + (size_t)M * POOL_DIM * 2;
constexpr size_t WS_YP = WS_CAT + (size_t)M * D * 2;
constexpr size_t WS_YS = WS_YP + (size_t)FD * 2 * LP * 2;
constexpr size_t WS_OV_END0 = WS_YS + (size_t)NSS * FD * 2 * LS * 2;
constexpr size_t WS_ACT = WS_OV;
constexpr size_t WS_HALO = WS_ACT + (size_t)M * DFF * 2;
constexpr size_t WS_OV_END1 = WS_HALO + (size_t)(M / 128) * 4 * NUP * 4;
constexpr size_t WS_QKV = WS_OV;
constexpr size_t WS_OA = WS_QKV + (size_t)M * NQKV * 2;
constexpr size_t WS_OV_END2 = WS_OA + (size_t)2 * M * D * 4;
constexpr size_t WS_OB = WS_QKV;
constexpr size_t WS_END = WS_OV_END2 > WS_OV_END1 ? (WS_OV_END2 > WS_OV_END0 ? WS_OV_END2 : WS_OV_END0) : (WS_OV_END1 > WS_OV_END0 ? WS_OV_END1 : WS_OV_END0);
static_assert(WS_END <= (size_t)4 * 2 * D * NUP * 4, "workspace must fit 4 x the largest input tensor");

constexpr int CW_TMO = 0, CW_LAM = 64  , CW_BAR = 4096;

constexpr int RING_OFF = 0, RING_BYTES = 131072;
constexpr int LDSCTL_OFF = RING_BYTES, MISC_OFF = LDSCTL_OFF + 320;
constexpr int LDS_BYTES = 147456;

__device__ __forceinline__ unsigned f2bf(float f) { unsigned u = __builtin_bit_cast(unsigned, f); return (u + 0x7fffu + ((u >> 16) & 1u)) >> 16; }
__device__ __forceinline__ unsigned pk2(float lo, float hi) { return f2bf(lo) | (f2bf(hi) << 16); }
__device__ __forceinline__ unsigned cvt_pk_bf16(float lo, float hi) { unsigned r; asm volatile("v_cvt_pk_bf16_f32 %0, %1, %2" : "=v"(r) : "v"(lo), "v"(hi)); return r; }
__device__ __forceinline__ float bf2f(unsigned short b) { return __builtin_bit_cast(float, (unsigned)b << 16); }
__device__ __forceinline__ int tid_opaque(int wave) { int l; asm volatile("v_mbcnt_lo_u32_b32 %0, -1, 0\n\tv_mbcnt_hi_u32_b32 %0, -1, %0" : "=v"(l)); return wave * 64 + l; }
__device__ __forceinline__ float wave_sum(float v) {
#pragma unroll
    for (int o = 1; o < 64; o <<= 1) v += __shfl_xor(v, o);
    return v;
}

#define XB_TMO      128
#define XB_XCNT(j)  (256  + 64 * (j))
#define XB_XSUB(j)  (1280 + 64 * (j))
#define XB_XGEN(j)  (2304 + 64 * (j))
#define XB_TOP      3328
#define XB_TOPGEN   3392
#define XCD_BAR_WORDS 3456
#define XB_SPIN_CAP (1u << 18)
__device__ __forceinline__ unsigned xb_ld(unsigned* p)              { return __hip_atomic_load(p, __ATOMIC_RELAXED, __HIP_MEMORY_SCOPE_AGENT); }
__device__ __forceinline__ unsigned xb_add(unsigned* p, unsigned v) { return __hip_atomic_fetch_add(p, v, __ATOMIC_RELAXED, __HIP_MEMORY_SCOPE_AGENT); }
__device__ __forceinline__ unsigned xb_xcc_id() { return (unsigned)__builtin_amdgcn_s_getreg((3 << 11) | 20) & 0xFu; }
#define XB_SPIN(cond, bar) do { unsigned _sp = 0; while (cond) { __builtin_amdgcn_s_sleep(1); \
    if ((++_sp & 255u) == 0u) { if (xb_ld(&(bar)[XB_TMO])) break; if (_sp > XB_SPIN_CAP) { atomicAdd(&(bar)[XB_TMO], 1u); break; } } } } while (0)
struct XcdBarrier { unsigned* bar; unsigned x; volatile LAS unsigned* st; };
__device__ __forceinline__ XcdBarrier xcd_barrier_post(unsigned* bar, volatile LAS unsigned* st) {
    XcdBarrier b; b.bar = bar; b.x = xb_xcc_id(); b.st = st;
    if (threadIdx.x == 0) (void)xb_add(&bar[XB_XCNT(b.x)], 1u);
    return b;
}
__device__ __forceinline__ void xcd_barrier_complete(unsigned* bar, unsigned x, unsigned& nloc, unsigned& nx) {
    const unsigned G = gridDim.x * gridDim.y * gridDim.z;
    unsigned sum, cnt, mine, sp = 0u;
    for (;;) {
        sum = 0u; cnt = 0u; mine = 0u;
#pragma unroll
        for (unsigned j = 0; j < 16; ++j) { const unsigned c = xb_ld(&bar[XB_XCNT(j)]); sum += c; cnt += (c > 0u) ? 1u : 0u; mine = (j == x) ? c : mine; }
        if (sum == G) break;
        __builtin_amdgcn_s_sleep(1);
        if ((++sp & 255u) == 0u) { if (xb_ld(&bar[XB_TMO])) break; if (sp > XB_SPIN_CAP) { atomicAdd(&bar[XB_TMO], 1u); break; } }
    }
    nloc = mine > 0u ? mine : 1u; nx = cnt > 0u ? cnt : 1u;
}
__device__ __forceinline__ void xcd_barrier(const XcdBarrier& b) {
    asm volatile("s_waitcnt vmcnt(0)" ::: "memory");
    __syncthreads();
    if (threadIdx.x == 0) {
        unsigned* bar = b.bar;
        __builtin_amdgcn_s_waitcnt(0);
        unsigned nloc = b.st[0], nx = b.st[1];
        if (nloc == 0u) { xcd_barrier_complete(bar, b.x, nloc, nx); b.st[0] = nloc; b.st[1] = nx; }
        const unsigned old = xb_add(&bar[XB_XSUB(b.x)], 1u);
        const unsigned gen = old / nloc;
        if (old + 1u == (gen + 1u) * nloc) {
            __builtin_amdgcn_fence(__ATOMIC_RELEASE, "agent");
            asm volatile("s_waitcnt vmcnt(0)" ::: "memory");
            const unsigned og = xb_add(&bar[XB_TOP], 1u);
            const unsigned tg = og / nx;
            if (og + 1u == (tg + 1u) * nx) xb_add(&bar[XB_TOPGEN], 1u);
            else XB_SPIN(xb_ld(&bar[XB_TOPGEN]) == tg, bar);
            __builtin_amdgcn_fence(__ATOMIC_ACQUIRE, "agent");
            xb_add(&bar[XB_XGEN(b.x)], 1u);
            asm volatile("s_waitcnt vmcnt(0)" ::: "memory");
        } else {
            XB_SPIN(xb_ld(&bar[XB_XGEN(b.x)]) == gen, bar);
            __builtin_amdgcn_fence(__ATOMIC_ACQUIRE, "agent");
            asm volatile("s_waitcnt vmcnt(0)" ::: "memory");
        }
    }
    __syncthreads();
}

namespace pg {
constexpr int BM = 256, BK = 64, HALF = 128, HTB = HALF * BK * 2, STAGE_BYTES = 8 * HTB;
__host__ __device__ __forceinline__ int lds_byte(int r, int c) { const int st = (r >> 4) * 2 + (c >> 5), rr = r & 15, cc = c & 31, ob = rr * 64 + cc * 2; return st * 1024 + (ob ^ (((ob >> 9) & 1) << 5)); }
__host__ __device__ __forceinline__ void stage_rc(int b, int& R, int& C) { const int st = b / 1024, sb = b % 1024, swz = sb ^ (((sb >> 9) & 1) << 5); R = (st >> 1) * 16 + swz / 64; C = (st & 1) * 32 + (swz % 64) / 2; }
__host__ __device__ __forceinline__ int perm32(int rho) { const int n = rho >> 4, i = rho & 15; return 8 * (i >> 2) + 4 * n + (i & 3); }
__host__ __device__ __forceinline__ int rowperm(int rho) { return (rho >> 6) * 128 + (rho & 15) * 8 + ((rho >> 4) & 3); }

struct GUnit {
    const char* A; const char* B;
    unsigned lda, ldb;
    int nt;
    char* C; unsigned ldc;
    int grow0, gcol0;
};

struct EpiBf16 {
    static constexpr bool PERM = true, ROWPERM = false;
    const float* rstd;
    __device__ __forceinline__ void operator()(f32x4 (&acc)[2][2][4][2], const GUnit& u, int wr, int wc, int fr, int fq) const {
        bf16_t* base = (bf16_t*)u.C + wc * 32 + 8 * fq;
#pragma unroll
        for (int ai = 0; ai < 2; ++ai)
#pragma unroll
            for (int m = 0; m < 4; ++m) {
                const int r = ai * HALF + wr * 64 + m * 16 + fr;
                const float s = rstd ? rstd[u.grow0 + r] : 1.0f;
                bf16_t* rowp = base + (size_t)r * u.ldc;
#pragma unroll
                for (int bj = 0; bj < 2; ++bj) { const f32x4 v0 = acc[ai][bj][m][0] * s, v1 = acc[ai][bj][m][1] * s;
                    u32x4 w; w.x = cvt_pk_bf16(v0[0], v0[1]); w.y = cvt_pk_bf16(v0[2], v0[3]); w.z = cvt_pk_bf16(v1[0], v1[1]); w.w = cvt_pk_bf16(v1[2], v1[3]);
                    *(u32x4*)(rowp + bj * HALF) = w; }
            }
    }
};
struct EpiResid {
    static constexpr bool PERM = true, ROWPERM = false;
    const float* xinP; const float* xinS;
    float* xout; bf16_t* xb; float* psum;
    __device__ __forceinline__ void operator()(f32x4 (&acc)[2][2][4][2], const GUnit& u, int wr, int wc, int fr, int fq) const {
        const float* xin = (u.grow0 < MP) ? xinP + (size_t)u.grow0 * D : xinS + (size_t)(u.grow0 - MP) * D;
        const int c0 = u.gcol0 + wc * 32 + 8 * fq;
#pragma unroll
        for (int ai = 0; ai < 2; ++ai)
#pragma unroll
            for (int m = 0; m < 4; ++m) {
                const int r = ai * HALF + wr * 64 + m * 16 + fr;
                const float* ip = xin + (size_t)r * D + c0;
                float* op = xout + (size_t)(u.grow0 + r) * D + c0;
                bf16_t* bp = xb + (size_t)(u.grow0 + r) * D + c0;
                float ss = 0.f;
#pragma unroll
                for (int bj = 0; bj < 2; ++bj) {
                    const f32x4 o0 = *(const f32x4*)(ip + bj * HALF), o1 = *(const f32x4*)(ip + bj * HALF + 4);
                    const f32x4 v0 = acc[ai][bj][m][0] + o0, v1 = acc[ai][bj][m][1] + o1;
                    *(f32x4*)(op + bj * HALF) = v0; *(f32x4*)(op + bj * HALF + 4) = v1;
                    u32x4 w; w.x = cvt_pk_bf16(v0[0], v0[1]); w.y = cvt_pk_bf16(v0[2], v0[3]); w.z = cvt_pk_bf16(v1[0], v1[1]); w.w = cvt_pk_bf16(v1[2], v1[3]);
                    *(u32x4*)(bp + bj * HALF) = w;
                    ss += (v0[0] * v0[0] + v0[1] * v0[1]) + (v0[2] * v0[2] + v0[3] * v0[3]) + (v1[0] * v1[0] + v1[1] * v1[1]) + (v1[2] * v1[2] + v1[3] * v1[3]);
                }
                ss += __shfl_xor(ss, 16); ss += __shfl_xor(ss, 32);
                if (fq == 0) psum[(size_t)(u.grow0 + r) * 64 + (u.gcol0 >> 8) * 4 + wc] = ss;
                asm volatile("" ::: "memory");
            }
    }
};
struct EpiFfnUp {
    static constexpr bool PERM = true, ROWPERM = true;
    bf16_t* act; float* halo; const float* rstd; const float* cw; const float* cb;
    __device__ __forceinline__ void operator()(f32x4 (&acc)[2][2][4][2], const GUnit& u, int wr, int wc, int fr, int fq) const {
        const int t0 = u.grow0 + wr * 128 + fr * 8;
        const int c0 = (u.gcol0 >> 1) + wc * 32 + 8 * fq;
        {   const f32x4 ra = *(const f32x4*)(rstd + t0), rb = *(const f32x4*)(rstd + t0 + 4);
#pragma unroll
            for (int bj = 0; bj < 2; ++bj)
#pragma unroll
                for (int n = 0; n < 2; ++n) {
#pragma unroll
                    for (int m = 0; m < 4; ++m) { acc[0][bj][m][n] *= ra[m]; acc[1][bj][m][n] *= rb[m]; } } }
        const int blk = (u.grow0 >> 7) + wr;
        if (fr == 0 || fr == 15) {
            float* hp = halo + (size_t)blk * 4 * NUP + (fr == 0 ? 0 : 2 * NUP);
#pragma unroll
            for (int bj = 0; bj < 2; ++bj)
#pragma unroll
                for (int n = 0; n < 2; ++n) {
                    const f32x4 e0 = (fr == 0) ? acc[0][bj][0][n] : acc[1][bj][2][n];
                    const f32x4 e1 = (fr == 0) ? acc[0][bj][1][n] : acc[1][bj][3][n];
                    *(f32x4*)(hp + bj * DFF + c0 + 4 * n) = e0; *(f32x4*)(hp + NUP + bj * DFF + c0 + 4 * n) = e1; }
        }
        unsigned pk[8][4];
#pragma unroll
        for (int n = 0; n < 2; ++n) {
            const int cg = c0 + 4 * n, cu = DFF + c0 + 4 * n;
            const f32x4 g0 = *(const f32x4*)(cw + cg), g1 = *(const f32x4*)(cw + NUP + cg), g2 = *(const f32x4*)(cw + 2 * NUP + cg), gb = *(const f32x4*)(cb + cg);
            const f32x4 u0 = *(const f32x4*)(cw + cu), u1 = *(const f32x4*)(cw + NUP + cu), u2 = *(const f32x4*)(cw + 2 * NUP + cu), ub = *(const f32x4*)(cb + cu);
            f32x4 gm1, gp8, um1, up8;
#pragma unroll
            for (int q = 0; q < 4; ++q) { gm1[q] = __shfl_up(acc[1][0][3][n][q], 1, 16); gp8[q] = __shfl_down(acc[0][0][0][n][q], 1, 16);
                                          um1[q] = __shfl_up(acc[1][1][3][n][q], 1, 16); up8[q] = __shfl_down(acc[0][1][0][n][q], 1, 16); }
#pragma unroll
            for (int j = 0; j < 8; ++j) {
                const f32x4 gl = (j == 0) ? gm1 : acc[(j + 7) >> 2 & 1][0][(j + 7) & 3][n], gc = acc[j >> 2][0][j & 3][n], gr = (j == 7) ? gp8 : acc[((j + 1) >> 2) & 1][0][(j + 1) & 3][n];
                const f32x4 ul = (j == 0) ? um1 : acc[(j + 7) >> 2 & 1][1][(j + 7) & 3][n], uc = acc[j >> 2][1][j & 3][n], ur = (j == 7) ? up8 : acc[((j + 1) >> 2) & 1][1][(j + 1) & 3][n];
                const f32x4 yg = gl * g0 + gc * g1 + gr * g2 + gb, yu = ul * u0 + uc * u1 + ur * u2 + ub;
                f32x4 a;
#pragma unroll
                for (int q = 0; q < 4; ++q) { const float g = yg[q]; a[q] = g * __builtin_amdgcn_rcpf(1.0f + __expf(-g)) * yu[q]; }
                pk[j][2 * n] = cvt_pk_bf16(a[0], a[1]); pk[j][2 * n + 1] = cvt_pk_bf16(a[2], a[3]);
            }
        }
#pragma unroll
        for (int j = 0; j < 8; ++j) {
            const bool edge = (j == 0 && fr == 0) || (j == 7 && fr == 15);
            if (!edge) { u32x4 w; w.x = pk[j][0]; w.y = pk[j][1]; w.z = pk[j][2]; w.w = pk[j][3]; *(u32x4*)(act + (size_t)(t0 + j) * DFF + c0) = w; }
        }
    }
};
struct EpiQkv {
    static constexpr bool PERM = true, ROWPERM = false;
    const float* rstd; const float* rot;
    __device__ __forceinline__ void operator()(f32x4 (&acc)[2][2][4][2], const GUnit& u, int wr, int wc, int fr, int fq) const {
        bf16_t* base = (bf16_t*)u.C + wc * 32 + 8 * fq;
        const bool rotary = (u.gcol0 < 2 * D) && (wc == 0);
#pragma unroll
        for (int ai = 0; ai < 2; ++ai)
#pragma unroll
            for (int m = 0; m < 4; ++m) {
                const int r = ai * HALF + wr * 64 + m * 16 + fr, gr = u.grow0 + r;
                const float s = rstd[gr];
                f32x4 v[2][2];
#pragma unroll
                for (int bj = 0; bj < 2; ++bj)
#pragma unroll
                    for (int n = 0; n < 2; ++n) v[bj][n] = acc[ai][bj][m][n] * s;
                if (rotary) {
                    const int pos = (gr < MP) ? gr : (gr & (LS - 1));
                    const float* rp = rot + (size_t)pos * 32 + 8 * (fq & 1);
                    const float sgn = (fq < 2) ? -1.0f : 1.0f;
#pragma unroll
                    for (int n = 0; n < 2; ++n) { const f32x4 cs = *(const f32x4*)(rp + 4 * n), sn = *(const f32x4*)(rp + 16 + 4 * n);
#pragma unroll
                        for (int bj = 0; bj < 2; ++bj) { f32x4 p;
#pragma unroll
                            for (int q = 0; q < 4; ++q) p[q] = __shfl_xor(v[bj][n][q], 32);
                            v[bj][n] = v[bj][n] * cs + p * (sn * sgn); } }
                }
                bf16_t* rowp = base + (size_t)r * u.ldc;
#pragma unroll
                for (int bj = 0; bj < 2; ++bj) { u32x4 w; w.x = cvt_pk_bf16(v[bj][0][0], v[bj][0][1]); w.y = cvt_pk_bf16(v[bj][0][2], v[bj][0][3]); w.z = cvt_pk_bf16(v[bj][1][0], v[bj][1][1]); w.w = cvt_pk_bf16(v[bj][1][2], v[bj][1][3]);
                    *(u32x4*)(rowp + bj * HALF) = w; }
            }
    }
};

template <class Epi, class Sched, bool ALIGN_EPI, bool SP2>
__device__ __forceinline__ void gemm_phase(LAS unsigned char* lds, const Sched& S, const Epi& E, const int wid) {
    const int tid = tid_opaque(wid), lane = tid & 63, wr = wid >> 2, wc = wid & 3, fr = lane & 15, fq = lane >> 4;
    unsigned RA[2], RB[2], C2[2];
#pragma unroll
    for (int i = 0; i < 2; ++i) { int R, C; stage_rc(tid * 16 + i * 8192, R, C);
        RA[i] = (unsigned)(Epi::ROWPERM ? rowperm(R) : R); RB[i] = (unsigned)(Epi::PERM ? ((R & ~31) + perm32(R & 31)) : R); C2[i] = (unsigned)C * 2u; }
    constexpr unsigned HROWS_A = Epi::ROWPERM ? 4u : 128u;
    const size_t kstep = (size_t)(BK * 2);
    const unsigned ldsw = (unsigned)wid * 1024u;
    const int aoff = lds_byte(wr * 64 + fr, fq * 8), boff = lds_byte(wc * 32 + fr, fq * 8);
#define PG_SA(b, h) (((b) * 2 + (h)) * HTB)
#define PG_SB(b, h) ((4 + (b) * 2 + (h)) * HTB)
#define PG_STAGE(bufoff, gbase, R, ld) do { _Pragma("unroll") for (int _i = 0; _i < 2; ++_i) \
        __builtin_amdgcn_global_load_lds((const unsigned*)((gbase) + (size_t)((R)[_i] * (ld) + C2[_i])), (LAS unsigned*)(lds + (bufoff) + ldsw + _i * 8192), 16, 0, 0); } while (0)
#define PG_LDA(dst, b, h) do { _Pragma("unroll") for (int m = 0; m < 4; ++m) _Pragma("unroll") for (int k = 0; k < 2; ++k) dst[m][k] = *(const LAS bf16x8*)(lds + PG_SA(b, h) + aoff + m * 2048 + k * 1024); } while (0)
#define PG_LDB(dst, b, h) do { _Pragma("unroll") for (int n = 0; n < 2; ++n) _Pragma("unroll") for (int k = 0; k < 2; ++k) dst[n][k] = *(const LAS bf16x8*)(lds + PG_SB(b, h) + boff + n * 2048 + k * 1024); } while (0)
#define PG_MMA(ai, bj, At, Bt) do { __builtin_amdgcn_s_setprio(1); _Pragma("unroll") for (int m = 0; m < 4; ++m) _Pragma("unroll") for (int n = 0; n < 2; ++n) _Pragma("unroll") for (int k = 0; k < 2; ++k) \
        acc[ai][bj][m][n] = __builtin_amdgcn_mfma_f32_16x16x32_bf16(Bt[n][k], At[m][k], acc[ai][bj][m][n], 0, 0, 0); __builtin_amdgcn_s_setprio(0); } while (0)
#define PG_WAIT_V(n) asm volatile("s_waitcnt vmcnt(" #n ")" ::: "memory")
#define PG_WAIT_L(n) asm volatile("s_waitcnt lgkmcnt(" #n ")" ::: "memory")
#define PG_BAR __builtin_amdgcn_s_barrier()
#define PG_SCHED __builtin_amdgcn_sched_barrier(0)
    GUnit cur, nxt; int ui = 0;
    if (!S.next(0, cur)) return;
    f32x4 acc[2][2][4][2];
#pragma unroll
    for (int a = 0; a < 2; ++a)
#pragma unroll
        for (int b = 0; b < 2; ++b)
#pragma unroll
            for (int m = 0; m < 4; ++m)
#pragma unroll
                for (int n = 0; n < 2; ++n) acc[a][b][m][n] = (f32x4){0.f, 0.f, 0.f, 0.f};
    bf16x8 At[4][2], B0[2][2], B1[2][2];
    const char* cA = cur.A; const char* cB = cur.B; unsigned lda = cur.lda, ldb = cur.ldb; int nt = cur.nt;
    {   const size_t hA = (size_t)HROWS_A * lda, hB = (size_t)128 * ldb;
        if constexpr (SP2) {
            PG_STAGE(PG_SB(0, 0), cB, RB, ldb); PG_STAGE(PG_SB(0, 1), cB + hB, RB, ldb); PG_STAGE(PG_SA(0, 0), cA, RA, lda); PG_STAGE(PG_SA(0, 1), cA + hA, RA, lda);
            if (wr == 1) PG_BAR;
            PG_WAIT_V(2); PG_BAR;
            PG_STAGE(PG_SB(1, 0), cB + kstep, RB, ldb); PG_STAGE(PG_SA(1, 0), cA + kstep, RA, lda); PG_STAGE(PG_SB(1, 1), cB + hB + kstep, RB, ldb);
            PG_WAIT_V(6); PG_BAR;
        } else {
            PG_STAGE(PG_SB(0, 0), cB, RB, ldb); PG_STAGE(PG_SA(0, 0), cA, RA, lda); PG_STAGE(PG_SB(0, 1), cB + hB, RB, ldb); PG_STAGE(PG_SA(0, 1), cA + hA, RA, lda);
            if (wr == 1) PG_BAR;
            PG_WAIT_V(4); PG_BAR;
            PG_STAGE(PG_SB(1, 0), cB + kstep, RB, ldb); PG_STAGE(PG_SA(1, 0), cA + kstep, RA, lda); PG_STAGE(PG_SB(1, 1), cB + hB + kstep, RB, ldb);
            PG_WAIT_V(6); PG_BAR;
        }
    }
    for (;;) {
        const bool has_next = S.next(ui + 1, nxt);
        const char* nA = has_next ? nxt.A : cA; const char* nB = has_next ? nxt.B : cB;
        const unsigned nlda = has_next ? nxt.lda : lda, nldb = has_next ? nxt.ldb : ldb;
        const size_t hA = (size_t)HROWS_A * lda, hB = (size_t)128 * ldb;
        for (int t = 0; t < nt; t += 2) {
            const bool last = (t == nt - 2);
            const char* a1 = cA + (size_t)(t + 1) * kstep;
            const char* a2 = last ? nA : cA + (size_t)(t + 2) * kstep; const char* b2 = last ? nB : cB + (size_t)(t + 2) * kstep;
            const unsigned lda2 = last ? nlda : lda, ldb2 = last ? nldb : ldb;
            const size_t hA2 = (size_t)HROWS_A * lda2, hB2 = (size_t)128 * ldb2;
            const char* a3 = a2 + kstep; const char* b3 = b2 + kstep;
            if constexpr (SP2) {
            PG_LDB(B0, 0, 0); PG_LDB(B1, 0, 1); PG_SCHED; PG_LDA(At, 0, 0); PG_STAGE(PG_SA(1, 1), a1 + hA, RA, lda);
            PG_WAIT_V(8); PG_WAIT_L(0); PG_BAR; PG_MMA(0, 0, At, B0); PG_MMA(0, 1, At, B1); PG_BAR; PG_SCHED;
            PG_LDA(At, 0, 1); PG_STAGE(PG_SB(0, 0), b2, RB, ldb2); PG_STAGE(PG_SB(0, 1), b2 + hB2, RB, ldb2); PG_STAGE(PG_SA(0, 0), a2, RA, lda2);
            PG_WAIT_V(8); PG_WAIT_L(0); PG_BAR; PG_MMA(1, 0, At, B0); PG_MMA(1, 1, At, B1); PG_BAR; PG_SCHED;
            PG_LDB(B0, 1, 0); PG_LDB(B1, 1, 1); PG_SCHED; PG_LDA(At, 1, 0); PG_STAGE(PG_SA(0, 1), a2 + hA2, RA, lda2);
            PG_WAIT_V(8); PG_WAIT_L(0); PG_BAR; PG_MMA(0, 0, At, B0); PG_MMA(0, 1, At, B1); PG_BAR; PG_SCHED;
            PG_LDA(At, 1, 1); PG_STAGE(PG_SB(1, 0), b3, RB, ldb2); PG_STAGE(PG_SB(1, 1), b3 + hB2, RB, ldb2); PG_STAGE(PG_SA(1, 0), a3, RA, lda2);
            PG_WAIT_V(8); PG_WAIT_L(0); PG_BAR; PG_MMA(1, 0, At, B0); PG_MMA(1, 1, At, B1); PG_BAR; PG_SCHED;
            } else {
            PG_LDB(B0, 0, 0); PG_SCHED; PG_LDA(At, 0, 0); PG_STAGE(PG_SA(1, 1), a1 + hA, RA, lda);
            PG_WAIT_L(8); PG_BAR; PG_WAIT_L(0); PG_MMA(0, 0, At, B0); PG_BAR; PG_SCHED;
            PG_LDB(B1, 0, 1); PG_STAGE(PG_SB(0, 0), b2, RB, ldb2);
            PG_BAR; PG_WAIT_L(0); PG_MMA(0, 1, At, B1); PG_BAR;
            PG_LDA(At, 0, 1); PG_STAGE(PG_SA(0, 0), a2, RA, lda2);
            PG_BAR; PG_WAIT_L(0); PG_MMA(1, 0, At, B0); PG_BAR; PG_SCHED;
            PG_STAGE(PG_SB(0, 1), b2 + hB2, RB, ldb2);
            PG_WAIT_V(6); PG_BAR; PG_MMA(1, 1, At, B1); PG_BAR;
            PG_LDB(B0, 1, 0); PG_SCHED; PG_LDA(At, 1, 0); PG_STAGE(PG_SA(0, 1), a2 + hA2, RA, lda2);
            PG_WAIT_L(8); PG_BAR; PG_WAIT_L(0); PG_MMA(0, 0, At, B0); PG_BAR; PG_SCHED;
            PG_LDB(B1, 1, 1); PG_STAGE(PG_SB(1, 0), b3, RB, ldb2);
            PG_BAR; PG_WAIT_L(0); PG_MMA(0, 1, At, B1); PG_BAR;
            PG_LDA(At, 1, 1); PG_STAGE(PG_SA(1, 0), a3, RA, lda2);
            PG_BAR; PG_WAIT_L(0); PG_MMA(1, 0, At, B0); PG_BAR; PG_SCHED;
            PG_STAGE(PG_SB(1, 1), b3 + hB2, RB, ldb2);
            PG_WAIT_V(6); PG_BAR; PG_MMA(1, 1, At, B1); PG_BAR;
            }
        }
        if constexpr (ALIGN_EPI) { if (wr == 0) PG_BAR; }
        E(acc, cur, wr, wc, fr, fq);
        if (!has_next) break;
#pragma unroll
        for (int a = 0; a < 2; ++a)
#pragma unroll
            for (int b = 0; b < 2; ++b)
#pragma unroll
                for (int m = 0; m < 4; ++m)
#pragma unroll
                    for (int n = 0; n < 2; ++n) acc[a][b][m][n] = (f32x4){0.f, 0.f, 0.f, 0.f};
        cur = nxt; cA = nA; cB = nB; lda = nlda; ldb = nldb; nt = cur.nt; ++ui;
        if constexpr (ALIGN_EPI) { if (wr == 1) PG_BAR; }
    }
    PG_WAIT_V(0);
    if constexpr (!ALIGN_EPI) { if (wr == 0) PG_BAR; }
    PG_BAR;
#undef PG_SA
#undef PG_SB
#undef PG_STAGE
#undef PG_LDA
#undef PG_LDB
#undef PG_MMA
#undef PG_WAIT_V
#undef PG_WAIT_L
#undef PG_BAR
#undef PG_SCHED
}

struct DenseOrder {
    const char* A; const char* B; char* C; unsigned lda, ldb, ldc; int csz; int nM, nN, nt, G, c;
    __device__ __forceinline__ bool next(int i, GUnit& u) const {
        const int nwg = nM * nN; const long L = (long)i * G + c; if (L >= nwg) return false;
        int wgid = (int)L; { const int q = nwg / 8, r = nwg % 8, xcd = wgid % 8, off = wgid / 8; wgid = (xcd < r ? xcd * (q + 1) : r * (q + 1) + (xcd - r) * q) + off; }
        const int nig = 8 * nN, gid = wgid / nig, fm = gid * 8, gsz = (nM - fm) < 8 ? (nM - fm) : 8;
        const int pm = fm + ((wgid % nig) % gsz), pn = (wgid % nig) / gsz;
        u.A = A + (size_t)pm * 256 * lda; u.B = B + (size_t)pn * 256 * ldb; u.lda = lda; u.ldb = ldb; u.nt = nt;
        u.C = C + ((size_t)pm * 256 * ldc + (size_t)pn * 256) * csz; u.ldc = ldc; u.grow0 = pm * 256; u.gcol0 = pn * 256;
        return true;
    }
};
}

namespace at {
constexpr int DH = 128, NW = 8, QBLK = 32, KVBLK = 64;
constexpr float SCALE = 0.088388347648318440f;
constexpr float THR = 8.f;
constexpr int LDQ = NQKV, LDK = NQKV, LDO = D;
constexpr size_t SHM_V = KVBLK * DH * 2, SHM_K = KVBLK * DH * 2, SHM_ATTN = 2 * SHM_V + 2 * SHM_K + NW * 64 * 4;
#define KSWZ(row, colB) ((row) * 256 + ((colB) ^ (((row) & 7) << 4)))
#define SBAR() __builtin_amdgcn_sched_barrier(0)
__device__ __forceinline__ int crow(int r, int hi) { return (r & 3) + 8 * (r >> 2) + 4 * hi; }
__device__ __forceinline__ unsigned cvtpk(float lo, float hi) { unsigned r; asm volatile("v_cvt_pk_bf16_f32 %0, %1, %2" : "=v"(r) : "v"(lo), "v"(hi)); return r; }
__device__ __forceinline__ void partialSM(f32x16& p0, f32x16& p1, float& m_reg, float& mn, float& alpha) {
  constexpr float C = SCALE * 1.4426950408889634f;
  float pmax = p0[0]; for (int r = 1; r < 16; ++r) pmax = fmaxf(pmax, p0[r]); for (int r = 0; r < 16; ++r) pmax = fmaxf(pmax, p1[r]);
  { auto rr = __builtin_amdgcn_permlane32_swap(__float_as_uint(pmax), __float_as_uint(pmax), false, false);
    pmax = fmaxf(__uint_as_float(rr[0]), __uint_as_float(rr[1])); }
  if (__builtin_expect(__all(pmax - m_reg <= THR / SCALE), 1)) { mn = m_reg; alpha = 1.f; }
  else { mn = fmaxf(m_reg, pmax); alpha = __builtin_amdgcn_exp2f((m_reg - mn) * C); m_reg = mn; }
  float mnC = -mn * C;
  for (int r = 0; r < 16; ++r) p0[r] = fmaf(p0[r], C, mnC); for (int r = 0; r < 16; ++r) p1[r] = fmaf(p1[r], C, mnC);
  for (int r = 0; r < 16; ++r) p0[r] = __builtin_amdgcn_exp2f(p0[r]);
}
__device__ __forceinline__ void finishSM(f32x16& p0, f32x16& p1, float alpha, float& l_reg, bf16x8& pa0, bf16x8& pa1, bf16x8& pa2, bf16x8& pa3) {
  for (int r = 0; r < 16; ++r) p1[r] = __builtin_amdgcn_exp2f(p1[r]);
  float ps = 0; for (int r = 0; r < 16; ++r) ps += p0[r]; for (int r = 0; r < 16; ++r) ps += p1[r];
  { auto rr = __builtin_amdgcn_permlane32_swap(__float_as_uint(ps), __float_as_uint(ps), false, false);
    ps = __uint_as_float(rr[0]) + __uint_as_float(rr[1]); }
  l_reg = l_reg * alpha + ps;
#define PK4(P, BASE, OUT) do { unsigned a0 = cvtpk(P[BASE + 0], P[BASE + 1]), a1 = cvtpk(P[BASE + 2], P[BASE + 3]);   \
    unsigned b0 = cvtpk(P[BASE + 4], P[BASE + 5]), b1 = cvtpk(P[BASE + 6], P[BASE + 7]);                              \
    auto r0 = __builtin_amdgcn_permlane32_swap(a0, b0, false, false); auto r1 = __builtin_amdgcn_permlane32_swap(a1, b1, false, false); \
    u32x4 w = {r0[0], r1[0], r0[1], r1[1]}; OUT = *reinterpret_cast<bf16x8*>(&w); } while (0)
  PK4(p0, 0, pa0); PK4(p0, 8, pa1); PK4(p1, 0, pa2); PK4(p1, 8, pa3);
#undef PK4
}
__device__ __forceinline__ void qkt(f32x16& p0, f32x16& p1, const bf16_t* Ks, const bf16x8* qr, int r32, int hi) {
  p0 = f32x16{}; p1 = f32x16{};
  for (int d0 = 0; d0 < 8; ++d0) { int cb = (d0 * 16 + hi * 8) * 2;
    bf16x8 b0 = *reinterpret_cast<const bf16x8*>((const char*)Ks + KSWZ(r32, cb));
    bf16x8 b1 = *reinterpret_cast<const bf16x8*>((const char*)Ks + KSWZ(32 + r32, cb));
    p0 = __builtin_amdgcn_mfma_f32_32x32x16_bf16(b0, qr[d0], p0, 0, 0, 0);
    p1 = __builtin_amdgcn_mfma_f32_32x32x16_bf16(b1, qr[d0], p1, 0, 0, 0); }
}
__device__ __forceinline__ int v_st(int k, int c) { const int kk = (k & ~0xC) | ((k & 4) << 1) | ((k & 8) >> 1); return ((kk >> 3) * 4 + (c >> 5)) * 512 + ((kk & 7) * 32 + (c & 31)) * 2; }
__device__ __forceinline__ int v_rd_base(int lane) { return ((lane & 3) << 3) | (((lane >> 2) & 3) << 6) | (((lane >> 4) & 1) << 5) | (((lane >> 5) & 1) << 8); }
constexpr int v_rd_off(int d0, int ks, int half) { return d0 * 512 + ks * 4096 + half * 2048; }
template <int OFF> __device__ __forceinline__ s16x4 tr_read(int vb) {
  s16x4 r; asm volatile("ds_read_b64_tr_b16 %0, %1 offset:%2" : "=&v"(r) : "v"(vb), "i"(OFF) : "memory"); return r;
}
template <int D0> __device__ __forceinline__ void pv_one(f32x16& od, int vb, bf16x8 pa0, bf16x8 pa1, bf16x8 pa2, bf16x8 pa3) {
  const s16x4 l0 = tr_read<v_rd_off(D0, 0, 0)>(vb), h0 = tr_read<v_rd_off(D0, 0, 1)>(vb), l1 = tr_read<v_rd_off(D0, 1, 0)>(vb), h1 = tr_read<v_rd_off(D0, 1, 1)>(vb);
  const s16x4 l2 = tr_read<v_rd_off(D0, 2, 0)>(vb), h2 = tr_read<v_rd_off(D0, 2, 1)>(vb), l3 = tr_read<v_rd_off(D0, 3, 0)>(vb), h3 = tr_read<v_rd_off(D0, 3, 1)>(vb);
  asm volatile("s_waitcnt lgkmcnt(0)" ::: "memory"); SBAR();
#define PK(L, H) (bf16x8){L[0], L[1], L[2], L[3], H[0], H[1], H[2], H[3]}
  od = __builtin_amdgcn_mfma_f32_32x32x16_bf16(pa0, PK(l0, h0), od, 0, 0, 0);
  od = __builtin_amdgcn_mfma_f32_32x32x16_bf16(pa1, PK(l1, h1), od, 0, 0, 0);
  od = __builtin_amdgcn_mfma_f32_32x32x16_bf16(pa2, PK(l2, h2), od, 0, 0, 0);
  od = __builtin_amdgcn_mfma_f32_32x32x16_bf16(pa3, PK(l3, h3), od, 0, 0, 0);
#undef PK
}
__device__ __forceinline__ void pv_d0(f32x16* o, int vb, bf16x8 pa0, bf16x8 pa1, bf16x8 pa2, bf16x8 pa3) {
  pv_one<0>(o[0], vb, pa0, pa1, pa2, pa3); pv_one<1>(o[1], vb, pa0, pa1, pa2, pa3); pv_one<2>(o[2], vb, pa0, pa1, pa2, pa3); pv_one<3>(o[3], vb, pa0, pa1, pa2, pa3);
}
__device__ __forceinline__ void attn_dense_body(const bf16_t* __restrict__ Qb, const bf16_t* __restrict__ Kh, const bf16_t* __restrict__ Vh, float* __restrict__ Ob, int seq, char* lds, const int wid) {
  const int tid = tid_opaque(wid), lane = tid & 63, r32 = lane & 31, hi = lane >> 5;
  bf16_t* V_lds = (bf16_t*)lds; bf16_t* K_lds = (bf16_t*)(lds + 2 * SHM_V);
  float* ws = (float*)(lds + 2 * SHM_V + 2 * SHM_K) + wid * 64; float* li_l = ws; float* al_l = ws + 32;
  float m_reg = -1e30f, l_reg = 0; f32x16 o[4] = {}; bf16x8 qr[8];
  const bf16_t* Qw = Qb + (long)(wid * QBLK + r32) * LDQ + hi * 8;
#pragma unroll
  for (int d0 = 0; d0 < 8; ++d0) qr[d0] = *reinterpret_cast<const bf16x8*>(Qw + d0 * 16);
  const int sr = tid >> 4, sc = (tid & 15) * 8, vst0 = v_st(sr, sc), vst1 = v_st(32 + sr, sc);
  const int vb0 = (int)(uintptr_t)V_lds + v_rd_base(lane);
  struct { bf16x8 vs0, vs1, ks0, ks1; } sr_[2];
#define SLOAD(i, k0) do { sr_[i].vs0 = *reinterpret_cast<const bf16x8*>(&Vh[(long)((k0) + sr) * LDK + sc]); sr_[i].vs1 = *reinterpret_cast<const bf16x8*>(&Vh[(long)((k0) + 32 + sr) * LDK + sc]); \
    sr_[i].ks0 = *reinterpret_cast<const bf16x8*>(&Kh[(long)((k0) + sr) * LDK + sc]); sr_[i].ks1 = *reinterpret_cast<const bf16x8*>(&Kh[(long)((k0) + 32 + sr) * LDK + sc]); } while (0)
#define SWRITE(b, i) do { *(bf16x8*)((char*)V_lds + (b) * SHM_V + vst0) = sr_[i].vs0;          \
    *(bf16x8*)((char*)V_lds + (b) * SHM_V + vst1) = sr_[i].vs1; int kc = sc * 2;               \
    *(bf16x8*)((char*)K_lds + (b) * SHM_K + KSWZ(sr, kc)) = sr_[i].ks0;                       \
    *(bf16x8*)((char*)K_lds + (b) * SHM_K + KSWZ(32 + sr, kc)) = sr_[i].ks1; } while (0)
#define SWAIT() asm volatile("s_waitcnt vmcnt(4)" ::: "memory")
#define RESC(a) do { if (__any((a) < 1.f)) { if (hi == 0) al_l[r32] = (a); asm volatile("s_waitcnt lgkmcnt(0)" ::: "memory"); \
    for (int d = 0; d < 4; ++d) for (int r = 0; r < 16; ++r) o[d][r] *= al_l[crow(r, hi)]; } } while (0)
  f32x16 pA0, pA1, pB0, pB1; float mnA, mnB, alA, alB; bf16x8 pa0, pa1, pa2, pa3; const int NT = seq / KVBLK;
  constexpr int SE = 0, SO = 1;
  SLOAD(SE, 0); asm volatile("s_waitcnt vmcnt(0)" ::: "memory"); SWRITE(0, SE); __syncthreads();
  qkt(pA0, pA1, K_lds, qr, r32, hi); partialSM(pA0, pA1, m_reg, mnA, alA);
  SLOAD(SO, KVBLK); if (2 < NT) SLOAD(SE, 2 * KVBLK);
  SWAIT(); SWRITE(1, SO); __syncthreads();
  for (int j = 1; j + 1 < NT; j += 2) {
    SBAR(); qkt(pB0, pB1, (bf16_t*)((char*)K_lds + SHM_K), qr, r32, hi);
    finishSM(pA0, pA1, alA, l_reg, pa0, pa1, pa2, pa3); SBAR();
    SLOAD(SO, (j + 2) * KVBLK); SBAR();
    pv_d0(o, vb0, pa0, pa1, pa2, pa3); partialSM(pB0, pB1, m_reg, mnB, alB);
    __syncthreads(); SWAIT(); SWRITE(0, SE);
    RESC(alB); __syncthreads();
    SBAR(); qkt(pA0, pA1, K_lds, qr, r32, hi);
    finishSM(pB0, pB1, alB, l_reg, pa0, pa1, pa2, pa3); SBAR();
    if (j + 3 < NT) SLOAD(SE, (j + 3) * KVBLK); SBAR();
    pv_d0(o, vb0 + (int)SHM_V, pa0, pa1, pa2, pa3); partialSM(pA0, pA1, m_reg, mnA, alA);
    __syncthreads(); SWAIT(); SWRITE(1, SO);
    RESC(alA); __syncthreads();
  }
  SBAR(); qkt(pB0, pB1, (bf16_t*)((char*)K_lds + SHM_K), qr, r32, hi);
  finishSM(pA0, pA1, alA, l_reg, pa0, pa1, pa2, pa3); SBAR();
  pv_d0(o, vb0, pa0, pa1, pa2, pa3); partialSM(pB0, pB1, m_reg, mnB, alB);
  __syncthreads(); RESC(alB);
  finishSM(pB0, pB1, alB, l_reg, pa0, pa1, pa2, pa3); SBAR();
  pv_d0(o, vb0 + (int)SHM_V, pa0, pa1, pa2, pa3);
  if (hi == 0) li_l[r32] = l_reg; asm volatile("s_waitcnt lgkmcnt(0)" ::: "memory");
  float rli[16];
#pragma unroll
  for (int r = 0; r < 16; ++r) rli[r] = __builtin_amdgcn_rcpf(li_l[crow(r, hi)]);
  float* Ow = Ob + (long)(wid * QBLK) * LDO;
#pragma unroll
  for (int r = 0; r < 16; ++r) { int orow = crow(r, hi);
    for (int d0 = 0; d0 < 4; ++d0) Ow[(long)orow * LDO + d0 * 32 + r32] = o[d0][r] * rli[r]; }
  __syncthreads();
#undef SLOAD
#undef SWRITE
#undef SWAIT
#undef RESC
}
#undef KSWZ
#undef SBAR
}

struct Frame {
    LAS unsigned char* lds; volatile LAS unsigned* MISC; unsigned* ctl;
    int wave, G, bx;
    const float* in[22]; float* out; unsigned char* ws;
};

__device__ __forceinline__ void transpose_item(const float* W, int K, int N, bf16_t* WT, int k0, int n0, int dst_row0, const float* gk, int gmask, float gmul, const float* gn,
                                               LAS float* scr, int lane) {
    const float ns = gn ? gn[n0 + (lane & 31)] : 1.0f;
#pragma unroll 8
    for (int i = 0; i < 32; ++i) { const int kk = 2 * i + (lane >> 5); const float ks = (gk ? gk[(k0 + kk) & gmask] : 1.0f) * gmul;
        scr[kk * 33 + (lane & 31)] = W[(size_t)(k0 + kk) * N + n0 + (lane & 31)] * (ks * ns); }
    LDS_WAIT(); asm volatile("" ::: "memory");
    const int c = lane & 7;
#pragma unroll
    for (int j = 0; j < 4; ++j) { const int n = (lane >> 3) + 8 * j; const LAS float* s = scr + (8 * c) * 33 + n;
        u32x4 o; o.x = pk2(s[0 * 33], s[1 * 33]); o.y = pk2(s[2 * 33], s[3 * 33]); o.z = pk2(s[4 * 33], s[5 * 33]); o.w = pk2(s[6 * 33], s[7 * 33]);
        *(GAS u32x4*)(WT + (size_t)(dst_row0 + n) * K + k0 + 8 * c) = o; }
    LDS_WAIT(); asm volatile("" ::: "memory");
}
template <class RowMap>
__device__ __forceinline__ void transpose_matrix(const float* W, int K, int N, bf16_t* WT, const float* gk, int gmask, float gmul, const float* gn, RowMap rowmap,
                                                 LAS float* scr, int lane, int gw, int NGW) {
    const int nblk = N / 32, nitems = (K / 64) * nblk;
    for (int it = gw; it < nitems; it += NGW) { const int kb = it / nblk, nb = it % nblk;
        transpose_item(W, K, N, WT, 64 * kb, 32 * nb, rowmap(32 * nb), gk, gmask, gmul, gn, scr, lane); }
}
struct RowId { __device__ __forceinline__ int operator()(int n0) const { return n0; } };
struct RowUp { __device__ __forceinline__ int operator()(int n0) const { const int up = n0 >= DFF, nn = up ? n0 - DFF : n0; return (nn >> 7) * 256 + up * 128 + (nn & 127); } };

__device__ __forceinline__ void p_prologue(Frame& F) {
    LAS float* scr = (LAS float*)(F.lds + RING_OFF + F.wave * 16384);
    const int tid = tid_opaque(F.wave), lane = tid & 63;
    const int gw = F.bx * NWAVES + F.wave, NGW = F.G * NWAVES;
    unsigned char* ws = F.ws;
    {   float* rstd = (float*)(ws + WS_RSTD); bf16_t* xb = (bf16_t*)(ws + WS_XB);
        for (int r = gw; r < M; r += NGW) {
            const float* xrow = (r < MP) ? F.in[0] + (size_t)r * D : F.in[1] + (size_t)(r - MP) * D;
            const GAS f32x4* xr = (const GAS f32x4*)xrow + lane;
            f32x4 v[16]; float s = 0.f;
#pragma unroll
            for (int j = 0; j < 16; ++j) { v[j] = xr[64 * j]; s += (v[j].x * v[j].x + v[j].y * v[j].y) + (v[j].z * v[j].z + v[j].w * v[j].w); }
            s = wave_sum(s);
            if (lane == 0) rstd[r] = 1.0f / sqrtf(s * (1.0f / D) + NORM_EPS);
            GAS u32x2* o8 = (GAS u32x2*)(xb + (size_t)r * D) + lane;
#pragma unroll
            for (int j = 0; j < 16; ++j) { u32x2 w; w.x = pk2(v[j].x, v[j].y); w.y = pk2(v[j].z, v[j].w); o8[64 * j] = w; }
        }
    }
    transpose_matrix(F.in[3], D, D, (bf16_t*)(ws + WS_WIN), F.in[2], 0xffff, 1.0f, nullptr, RowId(), scr, lane, gw, NGW);
    for (int g = 0; g < 4; ++g)
        transpose_matrix(F.in[4] + (size_t)g * PG * PG, PG, PG, (bf16_t*)(ws + WS_POOLT) + (size_t)g * PG * PG, nullptr, 0, 1.0f, F.in[5] + g * PG, RowId(), scr, lane, gw, NGW);
    transpose_matrix(F.in[7], D, D, (bf16_t*)(ws + WS_WOE), nullptr, 0, 1.0f, nullptr, RowId(), scr, lane, gw, NGW);
    transpose_matrix(F.in[9], D, NQKV, (bf16_t*)(ws + WS_WQKV), F.in[8], 0xffff, 1.0f, nullptr, RowId(), scr, lane, gw, NGW);
    transpose_matrix(F.in[15], D, D, (bf16_t*)(ws + WS_WOO), F.in[14], 255, 1.0f - LAMBDA_INIT, nullptr, RowId(), scr, lane, gw, NGW);
    for (int l = 0; l < 2; ++l) {
        transpose_matrix(F.in[17] + (size_t)l * D * NUP, D, NUP, (bf16_t*)(ws + WS_WUP) + (size_t)l * NUP * D, F.in[16] + l * D, 0xffff, 1.0f, nullptr, RowUp(), scr, lane, gw, NGW);
        transpose_matrix(F.in[20] + (size_t)l * DFF * D, DFF, D, (bf16_t*)(ws + WS_WDN) + (size_t)l * D * DFF, nullptr, 0, 1.0f, nullptr, RowId(), scr, lane, gw, NGW);
    }
    for (int which = 0; which < 2; ++which) {
        const int L = which ? LS : LP; bf16_t* dft = (bf16_t*)(ws + (which ? WS_DFTS : WS_DFTP));
        const float inv = 1.0f / (float)L, nrm = 1.0f / sqrtf((float)L);
        const int chunks = 2 * L / 512, nitems = L * chunks;
        for (int it = gw; it < nitems; it += NGW) { const int k = it / chunks, kk0 = (it % chunks) * 512 + lane * 8; float v[8];
#pragma unroll
            for (int e = 0; e < 8; ++e) { const int kk = kk0 + e, t = kk & (L - 1); const int idx = (k * t + (kk >= L ? (L >> 2) : 0)) & (L - 1);
                v[e] = __builtin_amdgcn_cosf((float)idx * inv) * nrm; }
            u32x4 o; o.x = pk2(v[0], v[1]); o.y = pk2(v[2], v[3]); o.z = pk2(v[4], v[5]); o.w = pk2(v[6], v[7]);
            *(GAS u32x4*)(dft + (size_t)k * 2 * L + kk0) = o; }
    }
    {   LAS float* tab = (LAS float*)(F.lds + RING_OFF + 12288);
        if (tid < 256) tab[tid] = cospif((float)tid * (1.0f / 128.0f));
        __syncthreads();
        bf16_t* gt = (bf16_t*)(ws + WS_GT); const float* fw = F.in[6];
        for (int it = gw; it < 2048 * 16; it += NGW) { const int mrow = it >> 4, kk = (it & 15) * 64 + lane, h = kk >> 8, c = kk & 255, cpp = mrow >> 1, shift = (mrow & 1) ? 192 : 0;
            float a = 0.f;
            for (int cp = 0; cp < 256; ++cp) a += tab[(c * cp + shift) & 255] * fw[(size_t)(h * 256 + cp) * FD + cpp];
            gt[(size_t)mrow * FD + kk] = (bf16_t)f2bf(a * (1.0f / 16.0f)); }
    }
    {   float* rot = (float*)(ws + WS_ROT);
        for (int i = gw * 64 + lane; i < LP * 16; i += NGW * 64) { const int pos = i >> 4, j = i & 15;
            const float invf = (float)pow(500000.0, -(double)(2 * j) / 32.0); const float ang = (float)pos * invf;
            rot[pos * 32 + j] = (float)cos((double)ang); rot[pos * 32 + 16 + j] = (float)sin((double)ang); }
        if (F.bx == 0 && F.wave == 0) {
            float a = F.in[10][lane] * F.in[11][lane] + F.in[10][lane + 64] * F.in[11][lane + 64];
            float b = F.in[12][lane] * F.in[13][lane] + F.in[12][lane + 64] * F.in[13][lane + 64];
            a = wave_sum(a); b = wave_sum(b);
            if (lane == 0) F.ctl[CW_LAM] = __builtin_bit_cast(unsigned, expf(a) - expf(b) + LAMBDA_INIT);
        }
    }
}

__device__ __forceinline__ void p_finalize_rstd(Frame& F) {
    const float* psum = (const float*)(F.ws + WS_PSUM); float* rstd = (float*)(F.ws + WS_RSTD);
    const int tid = tid_opaque(F.wave);
    for (int r = F.bx * NTHREADS + tid; r < M; r += F.G * NTHREADS) { const f32x4* p = (const f32x4*)(psum + (size_t)r * 64); float s = 0.f;
#pragma unroll
        for (int j = 0; j < 16; ++j) { const f32x4 v = p[j]; s += (v.x + v.y) + (v.z + v.w); }
        rstd[r] = 1.0f / sqrtf(s * (1.0f / D) + NORM_EPS); }
}

__device__ __forceinline__ void p_pool(Frame& F) {
    const bf16_t* u = (const bf16_t*)(F.ws + WS_U); bf16_t* pooled = (bf16_t*)(F.ws + WS_POOLED);
    const int gw = F.bx * NWAVES + F.wave, NGW = F.G * NWAVES, lane = tid_opaque(F.wave) & 63;
    for (int it = gw; it < (M / 64) * 12; it += NGW) {
        const int rc = it / 12, cb = it % 12, t0 = rc * 64, col = cb * 256 + lane * 4, g = cb / 3, h = 1 << g;
        const int s0 = (t0 < MP) ? 0 : MP + ((t0 - MP) / LS) * LS, s1 = (t0 < MP) ? MP : s0 + LS;
        const bf16_t* up = u + col;
        f32x4 sum = {0.f, 0.f, 0.f, 0.f};
        const int lo = (t0 - h > s0) ? t0 - h : s0, hi = (t0 + h < s1) ? t0 + h : s1;
        for (int s = lo; s < hi; ++s) { const u32x2 w = *(const u32x2*)(up + (size_t)s * D); sum += (f32x4){bf2f(w.x & 0xffff), bf2f(w.x >> 16), bf2f(w.y & 0xffff), bf2f(w.y >> 16)}; }
        for (int t = t0; t < t0 + 64; ++t) {
            const int a = (t - h > s0) ? t - h : s0, b = (t + h < s1) ? t + h : s1;
            const u32x2 w = *(const u32x2*)(up + (size_t)t * D); const f32x4 ut = {bf2f(w.x & 0xffff), bf2f(w.x >> 16), bf2f(w.y & 0xffff), bf2f(w.y >> 16)};
            const f32x4 o = sum * (1.0f / (float)(b - a)) - ut;
            u32x2 ow; ow.x = pk2(o.x, o.y); ow.y = pk2(o.z, o.w); *(u32x2*)(pooled + (size_t)t * POOL_DIM + col) = ow;
            if (t + h < s1) { const u32x2 w2 = *(const u32x2*)(up + (size_t)(t + h) * D); sum += (f32x4){bf2f(w2.x & 0xffff), bf2f(w2.x >> 16), bf2f(w2.y & 0xffff), bf2f(w2.y >> 16)}; }
            if (t - h >= s0) { const u32x2 w3 = *(const u32x2*)(up + (size_t)(t - h) * D); sum -= (f32x4){bf2f(w3.x & 0xffff), bf2f(w3.x >> 16), bf2f(w3.y & 0xffff), bf2f(w3.y >> 16)}; }
        }
    }
}

__device__ __forceinline__ void p_fixup(Frame& F, const float* cw, const float* cb) {
    const float* halo = (const float*)(F.ws + WS_HALO); bf16_t* act = (bf16_t*)(F.ws + WS_ACT);
    constexpr int CH = DFF / 4;
    const int tid = tid_opaque(F.wave);
    for (int i = F.bx * NTHREADS + tid; i < (M / 128) * 2 * CH; i += F.G * NTHREADS) {
        const int ch = i % CH, be = i / CH, blk = be >> 1, e = be & 1, c = ch * 4;
        const int t = blk * 128 + (e ? 127 : 0);
        const int s0 = (t < MP) ? 0 : MP + ((t - MP) / LS) * LS, s1 = (t < MP) ? MP : s0 + LS;
        const float* hb = halo + (size_t)blk * 4 * NUP;
        f32x4 a4;
        f32x4 y[2];
#pragma unroll
        for (int bj = 0; bj < 2; ++bj) { const int cc = bj * DFF + c;
            f32x4 xl, xc, xr; const f32x4 z = {0.f, 0.f, 0.f, 0.f};
            if (e == 0) { xl = (t > s0) ? *(const f32x4*)(hb - (size_t)4 * NUP + 3 * NUP + cc) : z; xc = *(const f32x4*)(hb + cc); xr = *(const f32x4*)(hb + NUP + cc); }
            else { xl = *(const f32x4*)(hb + 2 * NUP + cc); xc = *(const f32x4*)(hb + 3 * NUP + cc); xr = (t + 1 < s1) ? *(const f32x4*)(hb + (size_t)4 * NUP + cc) : z; }
            y[bj] = xl * *(const f32x4*)(cw + cc) + xc * *(const f32x4*)(cw + NUP + cc) + xr * *(const f32x4*)(cw + 2 * NUP + cc) + *(const f32x4*)(cb + cc); }
#pragma unroll
        for (int q = 0; q < 4; ++q) { const float g = y[0][q]; a4[q] = g * __builtin_amdgcn_rcpf(1.0f + __expf(-g)) * y[1][q]; }
        u32x2 w; w.x = cvt_pk_bf16(a4[0], a4[1]); w.y = cvt_pk_bf16(a4[2], a4[3]);
        *(u32x2*)(act + (size_t)t * DFF + c) = w;
    }
}

__device__ __forceinline__ void p_combine(Frame& F) {
    const float* oa0 = (const float*)(F.ws + WS_OA); const float* oa1 = oa0 + (size_t)M * D; bf16_t* ob = (bf16_t*)(F.ws + WS_OB);
    const float lam = __builtin_bit_cast(float, __hip_atomic_load(F.ctl + CW_LAM, RLX_AGENT));
    const int gw = F.bx * NWAVES + F.wave, NGW = F.G * NWAVES, lane = tid_opaque(F.wave) & 63;
    for (int r = gw; r < M; r += NGW) {
        const f32x4* a = (const f32x4*)(oa0 + (size_t)r * D) + lane; const f32x4* b = (const f32x4*)(oa1 + (size_t)r * D) + lane;
        u32x2* o = (u32x2*)(ob + (size_t)r * D) + lane;
#pragma unroll 4
        for (int h = 0; h < 16; ++h) { const f32x4 v = a[64 * h] - b[64 * h] * lam;
            const float ss = wave_sum((v.x * v.x + v.y * v.y) + (v.z * v.z + v.w * v.w));
            const float rs = 1.0f / sqrtf(ss * (1.0f / 256.0f) + SUBLN_EPS);
            u32x2 w; w.x = pk2(v.x * rs, v.y * rs); w.y = pk2(v.z * rs, v.w * rs); o[64 * h] = w; }
    }
}

__device__ __forceinline__ void p_final(Frame& F) {
    const float* psum = (const float*)(F.ws + WS_PSUM); const float* fn = F.in[21];
    const int gw = F.bx * NWAVES + F.wave, NGW = F.G * NWAVES, lane = tid_opaque(F.wave) & 63;
    for (int r = gw; r < M; r += NGW) {
        const float s = wave_sum(psum[(size_t)r * 64 + lane]); const float rs = 1.0f / sqrtf(s * (1.0f / D) + NORM_EPS);
        f32x4* x = (f32x4*)(F.out + (size_t)r * D) + lane; const f32x4* g = (const f32x4*)fn + lane;
#pragma unroll 4
        for (int j = 0; j < 16; ++j) x[64 * j] = x[64 * j] * rs * g[64 * j];
    }
}

struct YOrder {
    const char* gt; const char* u; char* yp; char* ys; int G, c;
    __device__ __forceinline__ bool next(int i, pg::GUnit& un) const {
        const int id = i * G + c; if (id >= 768) return false;
        int pm, pn, row0, L; char* Cb;
        if (id < 256) { pm = id & 7; pn = id >> 3; row0 = 0; L = LP; Cb = yp; }
        else { const int j = id - 256, s = j >> 6; pm = j & 7; pn = (j >> 3) & 7; row0 = MP + s * LS; L = LS; Cb = ys + (size_t)s * FD * 2 * LS * 2; }
        un.A = gt + (size_t)pm * 256 * (FD * 2); un.lda = FD * 2; un.B = u + ((size_t)(row0 + pn * 256) * D + POOL_DIM) * 2; un.ldb = D * 2; un.nt = FD / 64;
        un.C = Cb + ((size_t)pm * 256 * L + (size_t)pn * 256) * 2; un.ldc = (unsigned)L; un.grow0 = 0; un.gcol0 = 0;
        return true;
    }
};
struct MixOrder {
    const char* dftp; const char* dfts; const char* yp; const char* ys; const char* pooled; const char* poolt; char* cat; int G, c;
    __device__ __forceinline__ void dft_unit(int s, int pm, int pn, pg::GUnit& un) const {
        const int L = s ? LS : LP, row0 = s ? MP + (s - 1) * LS : 0;
        un.A = (s ? dfts : dftp) + (size_t)pm * 256 * (4 * (size_t)L); un.lda = 4u * L; un.B = (s ? ys + (size_t)(s - 1) * FD * 2 * LS * 2 : yp) + (size_t)pn * 256 * (4 * (size_t)L); un.ldb = 4u * L; un.nt = 2 * L / 64;
        un.C = cat + ((size_t)(row0 + pm * 256) * D + POOL_DIM + pn * 256) * 2; un.ldc = D; un.grow0 = row0 + pm * 256; un.gcol0 = POOL_DIM + pn * 256;
    }
    __device__ __forceinline__ void pool_unit(int id, pg::GUnit& un) const {
        const int g = id / 288, r = id % 288, pm = r / 3, pn = r % 3;
        un.A = pooled + ((size_t)pm * 256 * POOL_DIM + g * PG) * 2; un.lda = POOL_DIM * 2; un.B = poolt + ((size_t)g * PG * PG + (size_t)pn * 256 * PG) * 2; un.ldb = PG * 2; un.nt = PG / 64;
        un.C = cat + ((size_t)pm * 256 * D + g * PG + pn * 256) * 2; un.ldc = D; un.grow0 = pm * 256; un.gcol0 = g * PG + pn * 256;
    }
    __device__ __forceinline__ bool next(int i, pg::GUnit& un) const {
        if (G == 256) {
            if (c < 128) { if (i > 0) return false; dft_unit(0, c >> 2, c & 3, un); return true; }
            const int j = c - 128;
            if (i < 2) { const int id = 2 * j + i; dft_unit(1 + (id >> 5), (id >> 2) & 7, id & 3, un); return true; }
            if (i < 11) { pool_unit(9 * j + (i - 2), un); return true; }
            return false;
        }
        const int id = i * G + c;
        if (id < 128) { dft_unit(0, id >> 2, id & 3, un); return true; }
        if (id < 384) { const int k = id - 128; dft_unit(1 + (k >> 5), (k >> 2) & 7, k & 3, un); return true; }
        if (id < 384 + 1152) { pool_unit(id - 384, un); return true; }
        return false;
    }
};

struct Args { const float* in[22]; float* out; unsigned char* ws; int ph_lo, ph_hi; };
constexpr int N_PHASES = 20;

__global__ void __launch_bounds__(NTHREADS, 2) mk_fwd(Args args) {
    extern __shared__ __attribute__((aligned(16))) unsigned char lds[];
    Frame F;
    F.lds = (LAS unsigned char*)lds; F.MISC = (volatile LAS unsigned*)(F.lds + MISC_OFF);
    F.wave = __builtin_amdgcn_readfirstlane((int)threadIdx.x >> 6);
    F.G = gridDim.x; F.bx = blockIdx.x;
#pragma unroll
    for (int i = 0; i < 22; ++i) F.in[i] = args.in[i];
    F.out = args.out; F.ws = args.ws; F.ctl = (unsigned*)(args.ws + WS_CTL);
    unsigned char* ws = args.ws;
    for (int u = threadIdx.x; u < (LDS_BYTES - LDSCTL_OFF) / 4; u += NTHREADS) ((LAS unsigned*)(F.lds + LDSCTL_OFF))[u] = 0u;
    __syncthreads();
    XcdBarrier bar; bar.bar = F.ctl + CW_BAR; bar.x = 0; bar.st = nullptr;
    if (MK_N_LAUNCHES == 1) bar = xcd_barrier_post(F.ctl + CW_BAR, F.MISC + 8);
    const int lo = args.ph_lo, hi = args.ph_hi;
#define IN(k) (lo <= (k) && (k) < hi)
#define SEAM(k) do { if (IN(k) && IN((k) + 1)) xcd_barrier(bar); } while (0)
    LAS unsigned char* ring = F.lds + RING_OFF;
    const int G = F.G, c = F.bx;
    float* rstd = (float*)(ws + WS_RSTD); float* psum = (float*)(ws + WS_PSUM); bf16_t* xb = (bf16_t*)(ws + WS_XB);

    if (IN(0)) p_prologue(F);
    SEAM(0);
    if (IN(1)) { pg::DenseOrder S{(const char*)xb, (const char*)(ws + WS_WIN), (char*)(ws + WS_U), D * 2, D * 2, D, 2, M / 256, D / 256, D / 64, G, c};
        pg::EpiBf16 E{rstd}; pg::gemm_phase<pg::EpiBf16, pg::DenseOrder, true, true>(ring, S, E, F.wave); }
    SEAM(1);
    if (IN(2)) { p_pool(F);
        YOrder S{(const char*)(ws + WS_GT), (const char*)(ws + WS_U), (char*)(ws + WS_YP), (char*)(ws + WS_YS), G, c};
        pg::EpiBf16 E{nullptr}; pg::gemm_phase<pg::EpiBf16, YOrder, true, true>(ring, S, E, F.wave); }
    SEAM(2);
    if (IN(3)) { MixOrder S{(const char*)(ws + WS_DFTP), (const char*)(ws + WS_DFTS), (const char*)(ws + WS_YP), (const char*)(ws + WS_YS), (const char*)(ws + WS_POOLED), (const char*)(ws + WS_POOLT), (char*)(ws + WS_CAT), G, c};
        pg::EpiBf16 E{nullptr}; pg::gemm_phase<pg::EpiBf16, MixOrder, true, true>(ring, S, E, F.wave); }
    SEAM(3);
    if (IN(4)) { pg::DenseOrder S{(const char*)(ws + WS_CAT), (const char*)(ws + WS_WOE), nullptr, D * 2, D * 2, D, 4, M / 256, D / 256, D / 64, G, c};
        pg::EpiResid E{F.in[0], F.in[1], F.out, xb, psum}; pg::gemm_phase<pg::EpiResid, pg::DenseOrder, true, true>(ring, S, E, F.wave); }
    SEAM(4);
    if (IN(5)) p_finalize_rstd(F);
    SEAM(5);
    if (IN(6)) { pg::DenseOrder S{(const char*)xb, (const char*)(ws + WS_WUP), nullptr, D * 2, D * 2, 0, 0, M / 256, NUP / 256, D / 64, G, c};
        pg::EpiFfnUp E{(bf16_t*)(ws + WS_ACT), (float*)(ws + WS_HALO), rstd, F.in[18], F.in[19]}; pg::gemm_phase<pg::EpiFfnUp, pg::DenseOrder, true, true>(ring, S, E, F.wave); }
    SEAM(6);
    if (IN(7)) p_fixup(F, F.in[18], F.in[19]);
    SEAM(7);
    if (IN(8)) { pg::DenseOrder S{(const char*)(ws + WS_ACT), (const char*)(ws + WS_WDN), nullptr, DFF * 2, DFF * 2, D, 4, M / 256, D / 256, DFF / 64, G, c};
        pg::EpiResid E{F.out, F.out + (size_t)MP * D, F.out, xb, psum}; pg::gemm_phase<pg::EpiResid, pg::DenseOrder, true, true>(ring, S, E, F.wave); }
    SEAM(8);
    if (IN(9)) p_finalize_rstd(F);
    SEAM(9);
    if (IN(10)) { pg::DenseOrder S{(const char*)xb, (const char*)(ws + WS_WQKV), (char*)(ws + WS_QKV), D * 2, D * 2, NQKV, 2, M / 256, NQKV / 256, D / 64, G, c};
        pg::EpiQkv E{rstd, (const float*)(ws + WS_ROT)}; pg::gemm_phase<pg::EpiQkv, pg::DenseOrder, true, true>(ring, S, E, F.wave); }
    SEAM(10);
    if (IN(11)) {
        const bf16_t* qkv = (const bf16_t*)(ws + WS_QKV); float* oa = (float*)(ws + WS_OA);
        const int nun = 2048 + 4096;
        for (int i = 0;; ++i) {
            int id;
            if (G == 256) { const int x = c & 7, j = c >> 3;
                if (i < 8) id = (8 * x + i) * 32 + j;
                else if (i < 24) { const int p = 64 * x + 4 * (i - 8) + (j >> 3); id = 2048 + p * 8 + (j & 7); }
                else break;
            } else { id = i * G + c; if (id >= nun) break; }
            int row0, L, vh, qb;
            if (id < 2048) { vh = id >> 5; qb = id & 31; row0 = 0; L = LP; }
            else { const int k = id - 2048, p = k >> 3; qb = k & 7; vh = p & 63; row0 = MP + (p >> 6) * LS; L = LS; }
            const int h = vh >> 2, m = (vh >> 1) & 1, half = vh & 1;
            const bf16_t* Qb = qkv + (size_t)(row0 + qb * 256) * NQKV + h * 256 + m * 128;
            const bf16_t* Kh = qkv + (size_t)row0 * NQKV + D + h * 256 + m * 128;
            const bf16_t* Vh = qkv + (size_t)row0 * NQKV + 2 * D + h * 256 + half * 128;
            float* Ob = oa + (size_t)m * M * D + (size_t)(row0 + qb * 256) * D + h * 256 + half * 128;
            at::attn_dense_body(Qb, Kh, Vh, Ob, L, (char*)lds + RING_OFF, F.wave);
        }
    }
    SEAM(11);
    if (IN(12)) p_combine(F);
    SEAM(12);
    if (IN(13)) { pg::DenseOrder S{(const char*)(ws + WS_OB), (const char*)(ws + WS_WOO), nullptr, D * 2, D * 2, D, 4, M / 256, D / 256, D / 64, G, c};
        pg::EpiResid E{F.out, F.out + (size_t)MP * D, F.out, xb, psum}; pg::gemm_phase<pg::EpiResid, pg::DenseOrder, true, true>(ring, S, E, F.wave); }
    SEAM(13);
    if (IN(14)) p_finalize_rstd(F);
    SEAM(14);
    if (IN(15)) { pg::DenseOrder S{(const char*)xb, (const char*)(ws + WS_WUP + (size_t)NUP * D * 2), nullptr, D * 2, D * 2, 0, 0, M / 256, NUP / 256, D / 64, G, c};
        pg::EpiFfnUp E{(bf16_t*)(ws + WS_ACT), (float*)(ws + WS_HALO), rstd, F.in[18] + 3 * NUP, F.in[19] + NUP}; pg::gemm_phase<pg::EpiFfnUp, pg::DenseOrder, true, true>(ring, S, E, F.wave); }
    SEAM(15);
    if (IN(16)) p_fixup(F, F.in[18] + 3 * NUP, F.in[19] + NUP);
    SEAM(16);
    if (IN(17)) { pg::DenseOrder S{(const char*)(ws + WS_ACT), (const char*)(ws + WS_WDN + (size_t)D * DFF * 2), nullptr, DFF * 2, DFF * 2, D, 4, M / 256, D / 256, DFF / 64, G, c};
        pg::EpiResid E{F.out, F.out + (size_t)MP * D, F.out, xb, psum}; pg::gemm_phase<pg::EpiResid, pg::DenseOrder, true, true>(ring, S, E, F.wave); }
    SEAM(17);
    if (IN(18)) p_final(F);
#undef IN
#undef SEAM
}

extern "C" void kernel_launch(void* const* d_in, const int* in_sizes, int n_in, void* d_out, int out_size, void* d_ws, size_t ws_size, hipStream_t stream) {
    static int grid = 0;
    if (grid == 0) {
        if (n_in != 22 || out_size != M * D || ws_size < WS_END) { fprintf(stderr, "kernel_launch: unexpected shapes: n_in %d out %d ws %zu (need %zu)\n", n_in, out_size, ws_size, (size_t)WS_END); grid = -1; return; }
        int dev = 0, cus = 0, per_cu = 0;
        if (hipGetDevice(&dev) != hipSuccess || hipDeviceGetAttribute(&cus, hipDeviceAttributeMultiprocessorCount, dev) != hipSuccess) { grid = -1; return; }
        if (hipFuncSetAttribute((const void*)mk_fwd, hipFuncAttributeMaxDynamicSharedMemorySize, LDS_BYTES) != hipSuccess) { fprintf(stderr, "kernel_launch: hipFuncSetAttribute failed\n"); grid = -1; return; }
        if (hipOccupancyMaxActiveBlocksPerMultiprocessor(&per_cu, (const void*)mk_fwd, NTHREADS, LDS_BYTES) != hipSuccess || per_cu < 1)
            fprintf(stderr, "kernel_launch: note: occupancy query reports %d workgroups per CU\n", per_cu);
        (void)hipGetLastError();
        grid = cus;
    }
    if (grid < 0) return;
    if (hipMemsetAsync((char*)d_ws + WS_CTL, 0, CTL_ZERO_BYTES, stream) != hipSuccess) { fprintf(stderr, "kernel_launch: memset failed\n"); return; }
    Args a{};
    for (int i = 0; i < 22; ++i) a.in[i] = (const float*)d_in[i];
    a.out = (float*)d_out; a.ws = (unsigned char*)d_ws;
#if MK_N_LAUNCHES == 1
    a.ph_lo = 0; a.ph_hi = N_PHASES;
    hipLaunchKernelGGL(mk_fwd, dim3(grid), dim3(NTHREADS), LDS_BYTES, stream, a);
#else
    for (int p = 0; p < 19; ++p) { a.ph_lo = p; a.ph_hi = p + 1; hipLaunchKernelGGL(mk_fwd, dim3(grid), dim3(NTHREADS), LDS_BYTES, stream, a); }
#endif
    const hipError_t le = hipPeekAtLastError();
    if (le != hipSuccess) fprintf(stderr, "kernel_launch: launch failed: %s\n", hipGetErrorName(le));
}
```

```cpp
#include <hip/hip_runtime.h>
#include <cstdio>
#include <cstdint>

#ifndef MK_N_LAUNCHES
#define MK_N_LAUNCHES 1
#endif

#ifndef PROBE_PH
#define PROBE_PH -1
#endif
#define GAS __attribute__((address_space(1)))
#define LAS __attribute__((address_space(3)))
typedef unsigned short bf16_t;
typedef short bf16x8 __attribute__((ext_vector_type(8)));
typedef short s16x4 __attribute__((ext_vector_type(4)));
typedef float f32x4 __attribute__((ext_vector_type(4)));
typedef float f32x2 __attribute__((ext_vector_type(2)));
typedef float f32x16 __attribute__((ext_vector_type(16)));
typedef unsigned u32x4 __attribute__((ext_vector_type(4)));
typedef unsigned u32x2 __attribute__((ext_vector_type(2)));
typedef GAS unsigned gu32;
#define RLX_AGENT __ATOMIC_RELAXED, __HIP_MEMORY_SCOPE_AGENT
#define LDS_WAIT() asm volatile("s_waitcnt lgkmcnt(0)" ::: "memory")
#define VM_WAIT() asm volatile("s_waitcnt vmcnt(0)" ::: "memory")

constexpr int D = 4096, LP = 8192, NSS = 8, LS = 2048, MP = LP, M = LP + NSS * LS;
constexpr int POOL_DIM = 3072, PG = 768, FD = 1024, FH = 256;
constexpr int DFF = 11008, NUP = 2 * DFF, NQKV = 3 * D;
constexpr float NORM_EPS = 1e-6f, SUBLN_EPS = 1e-5f;
constexpr float LAMBDA_INIT = 0.35550906759096327f;
constexpr int NWAVES = 8, NTHREADS = 512;

constexpr size_t MiB = 1u << 20;
constexpr size_t al256(size_t x) { return (x + 255) / 256 * 256; }
constexpr size_t WS_CTL = 0, CTL_ZERO_BYTES = 65536;
constexpr size_t WS_ROT = WS_CTL + CTL_ZERO_BYTES;
constexpr size_t WS_RSTD = WS_ROT + (size_t)LP * 32 * 4;
constexpr size_t WS_PSUM = WS_RSTD + al256((size_t)M * 4);
constexpr size_t WS_WIN = WS_PSUM + (size_t)M * 64 * 4;
constexpr size_t WS_GT = WS_WIN + (size_t)D * D * 2;
constexpr size_t WS_POOLT = WS_GT + (size_t)2048 * 1024 * 2;
constexpr size_t WS_WOE = WS_POOLT + (size_t)4 * PG * PG * 2;
constexpr size_t WS_WQKV = WS_WOE + (size_t)D * D * 2;
constexpr size_t WS_WOO = WS_WQKV + (size_t)NQKV * D * 2;
constexpr size_t WS_WUP = WS_WOO + (size_t)D * D * 2;
constexpr size_t WS_WDN = WS_WUP + (size_t)2 * NUP * D * 2;
constexpr int HP = LP / 2, HS = LS / 2, MH = M / 2;
constexpr size_t WS_DFTP = WS_WDN + (size_t)2 * D * DFF * 2;
constexpr size_t WS_DFTS = WS_DFTP + (size_t)2 * HP * HP * 2;
constexpr size_t WS_XB = WS_DFTS + (size_t)2 * HS * HS * 2;
constexpr size_t WS_OV = WS_XB + (size_t)M * D * 2;
constexpr size_t WS_U = WS_OV;
constexpr size_t WS_POOLED = WS_U + (size_t)M * D * 2;
constexpr size_t WS_CAT = WS_POOLED + (size_t)M * POOL_DIM * 2;
constexpr size_t WS_UFP = WS_CAT + (size_t)M * D * 2;
constexpr size_t WS_UFM = WS_UFP + (size_t)MH * FD * 2;
constexpr size_t WS_YFP = WS_UFM + (size_t)MH * FD * 2;
constexpr size_t WS_YFS = WS_YFP + (size_t)2 * FD * HP * 2;
constexpr size_t WS_EB = WS_YFS + (size_t)NSS * 2 * FD * HS * 2;
constexpr size_t WS_OB2 = WS_EB + (size_t)MH * FD * 4;
constexpr size_t WS_YCH = WS_OB2 + (size_t)MH * FD * 4;
constexpr size_t WS_ALT = WS_YCH + (size_t)9 * FD * 4;
constexpr size_t WS_OV_END0 = WS_ALT + (size_t)9 * FD * 4;
constexpr size_t WS_ACT = WS_OV;
constexpr size_t WS_HALO = WS_ACT + (size_t)M * DFF * 2;
constexpr size_t WS_OV_END1 = WS_HALO + (size_t)(M / 128) * 4 * NUP * 4;
constexpr size_t WS_QKV = WS_OV;
constexpr size_t WS_OA = WS_QKV + (size_t)M * NQKV * 2;
constexpr size_t WS_OV_END2 = WS_OA + (size_t)2 * M * D * 2;
constexpr size_t WS_OB = WS_QKV;
constexpr size_t WS_END = WS_OV_END2 > WS_OV_END1 ? (WS_OV_END2 > WS_OV_END0 ? WS_OV_END2 : WS_OV_END0) : (WS_OV_END1 > WS_OV_END0 ? WS_OV_END1 : WS_OV_END0);
static_assert(WS_END <= (size_t)4 * 2 * D * NUP * 4, "workspace must fit 4 x the largest input tensor");

constexpr int CW_TMO = 0, CW_LAM = 64  , CW_BAR = 4096, CW_DYN = 8192  ;

constexpr int RING_OFF = 0, RING_BYTES = 131072;
constexpr int LDS_BYTES = 147456;
constexpr int LDSCTL_OFF = LDS_BYTES - 1024, MISC_OFF = LDSCTL_OFF + 320;

__device__ __forceinline__ unsigned f2bf(float f) { unsigned u = __builtin_bit_cast(unsigned, f); return (u + 0x7fffu + ((u >> 16) & 1u)) >> 16; }
__device__ __forceinline__ unsigned pk2(float lo, float hi) { return f2bf(lo) | (f2bf(hi) << 16); }
__device__ __forceinline__ unsigned cvt_pk_bf16(float lo, float hi) { unsigned r; asm volatile("v_cvt_pk_bf16_f32 %0, %1, %2" : "=v"(r) : "v"(lo), "v"(hi)); return r; }
__device__ __forceinline__ float bf2f(unsigned short b) { return __builtin_bit_cast(float, (unsigned)b << 16); }
__device__ __forceinline__ int tid_opaque(int wave) { int l; asm volatile("v_mbcnt_lo_u32_b32 %0, -1, 0\n\tv_mbcnt_hi_u32_b32 %0, -1, %0" : "=v"(l)); return wave * 64 + l; }
__device__ __forceinline__ float wave_sum(float v) {
#pragma unroll
    for (int o = 1; o < 64; o <<= 1) v += __shfl_xor(v, o);
    return v;
}

#define XB_TMO      128
#define XB_XCNT(j)  (256  + 64 * (j))
#define XB_XSUB(j)  (1280 + 64 * (j))
#define XB_XGEN(j)  (2304 + 64 * (j))
#define XB_TOP      3328
#define XB_TOPGEN   3392
#define XCD_BAR_WORDS 3456
#define XB_SPIN_CAP (1u << 18)
__device__ __forceinline__ unsigned xb_ld(unsigned* p)              { return __hip_atomic_load(p, __ATOMIC_RELAXED, __HIP_MEMORY_SCOPE_AGENT); }
__device__ __forceinline__ unsigned xb_add(unsigned* p, unsigned v) { return __hip_atomic_fetch_add(p, v, __ATOMIC_RELAXED, __HIP_MEMORY_SCOPE_AGENT); }
__device__ __forceinline__ unsigned xb_xcc_id() { return (unsigned)__builtin_amdgcn_s_getreg((3 << 11) | 20) & 0xFu; }
#define XB_SPIN(cond, bar) do { unsigned _sp = 0; while (cond) { __builtin_amdgcn_s_sleep(1); \
    if ((++_sp & 255u) == 0u) { if (xb_ld(&(bar)[XB_TMO])) break; if (_sp > XB_SPIN_CAP) { atomicAdd(&(bar)[XB_TMO], 1u); break; } } } } while (0)
struct XcdBarrier { unsigned* bar; unsigned x; volatile LAS unsigned* st; };
__device__ __forceinline__ XcdBarrier xcd_barrier_post(unsigned* bar, volatile LAS unsigned* st) {
    XcdBarrier b; b.bar = bar; b.x = xb_xcc_id(); b.st = st;
    if (threadIdx.x == 0) (void)xb_add(&bar[XB_XCNT(b.x)], 1u);
    return b;
}
__device__ __forceinline__ void xcd_barrier_complete(unsigned* bar, unsigned x, unsigned& nloc, unsigned& nx) {
    const unsigned G = gridDim.x * gridDim.y * gridDim.z;
    unsigned sum, cnt, mine, sp = 0u;
    for (;;) {
        sum = 0u; cnt = 0u; mine = 0u;
#pragma unroll
        for (unsigned j = 0; j < 16; ++j) { const unsigned c = xb_ld(&bar[XB_XCNT(j)]); sum += c; cnt += (c > 0u) ? 1u : 0u; mine = (j == x) ? c : mine; }
        if (sum == G) break;
        __builtin_amdgcn_s_sleep(1);
        if ((++sp & 255u) == 0u) { if (xb_ld(&bar[XB_TMO])) break; if (sp > XB_SPIN_CAP) { atomicAdd(&bar[XB_TMO], 1u); break; } }
    }
    nloc = mine > 0u ? mine : 1u; nx = cnt > 0u ? cnt : 1u;
}
__device__ __forceinline__ void xcd_barrier(const XcdBarrier& b) {
    asm volatile("s_waitcnt vmcnt(0)" ::: "memory");
    __syncthreads();
    if (threadIdx.x == 0) {
        unsigned* bar = b.bar;
        __builtin_amdgcn_s_waitcnt(0);
        unsigned nloc = b.st[0], nx = b.st[1];
        if (nloc == 0u) { xcd_barrier_complete(bar, b.x, nloc, nx); b.st[0] = nloc; b.st[1] = nx; }
        const unsigned old = xb_add(&bar[XB_XSUB(b.x)], 1u);
        const unsigned gen = old / nloc;
        if (old + 1u == (gen + 1u) * nloc) {
            __builtin_amdgcn_fence(__ATOMIC_RELEASE, "agent");
            asm volatile("s_waitcnt vmcnt(0)" ::: "memory");
            const unsigned og = xb_add(&bar[XB_TOP], 1u);
            const unsigned tg = og / nx;
            if (og + 1u == (tg + 1u) * nx) xb_add(&bar[XB_TOPGEN], 1u);
            else XB_SPIN(xb_ld(&bar[XB_TOPGEN]) == tg, bar);
            __builtin_amdgcn_fence(__ATOMIC_ACQUIRE, "agent");
            xb_add(&bar[XB_XGEN(b.x)], 1u);
            asm volatile("s_waitcnt vmcnt(0)" ::: "memory");
        } else {
            XB_SPIN(xb_ld(&bar[XB_XGEN(b.x)]) == gen, bar);
            __builtin_amdgcn_fence(__ATOMIC_ACQUIRE, "agent");
            asm volatile("s_waitcnt vmcnt(0)" ::: "memory");
        }
    }
    __syncthreads();
}

namespace pg {
constexpr int BM = 256, BK = 64, HALF = 128, HTB = HALF * BK * 2, STAGE_BYTES = 8 * HTB;
__host__ __device__ __forceinline__ int lds_byte(int r, int c) { const int st = (r >> 4) * 2 + (c >> 5), rr = r & 15, cc = c & 31, ob = rr * 64 + cc * 2; return st * 1024 + (ob ^ (((ob >> 9) & 1) << 5)); }
__host__ __device__ __forceinline__ void stage_rc(int b, int& R, int& C) { const int st = b / 1024, sb = b % 1024, swz = sb ^ (((sb >> 9) & 1) << 5); R = (st >> 1) * 16 + swz / 64; C = (st & 1) * 32 + (swz % 64) / 2; }
__host__ __device__ __forceinline__ int perm32(int rho) { const int n = rho >> 4, i = rho & 15; return 8 * (i >> 2) + 4 * n + (i & 3); }
__host__ __device__ __forceinline__ int rowperm(int rho) { return (rho >> 6) * 128 + (rho & 15) * 8 + ((rho >> 4) & 3); }

struct GUnit {
    const char* A; const char* B;
    unsigned lda, ldb;
    int nt;
    char* C; unsigned ldc;
    int grow0, gcol0;
    int aux;
};

struct EpiBf16 {
    static constexpr bool PERM = true, ROWPERM = false, PREFETCH = false;
    const float* rstd;
    __device__ __forceinline__ void operator()(f32x4 (&acc)[2][2][4][2], const GUnit& u, int wr, int wc, int fr, int fq) const {
        bf16_t* base = (bf16_t*)u.C + wc * 32 + 8 * fq;
#pragma unroll
        for (int ai = 0; ai < 2; ++ai)
#pragma unroll
            for (int m = 0; m < 4; ++m) {
                const int r = ai * HALF + wr * 64 + m * 16 + fr;
                const float s = rstd ? rstd[u.grow0 + r] : 1.0f;
                bf16_t* rowp = base + (size_t)r * u.ldc;
#pragma unroll
                for (int bj = 0; bj < 2; ++bj) { const f32x4 v0 = acc[ai][bj][m][0] * s, v1 = acc[ai][bj][m][1] * s;
                    u32x4 w; w.x = cvt_pk_bf16(v0[0], v0[1]); w.y = cvt_pk_bf16(v0[2], v0[3]); w.z = cvt_pk_bf16(v1[0], v1[1]); w.w = cvt_pk_bf16(v1[2], v1[3]);
                    *(u32x4*)(rowp + bj * HALF) = w; }
            }
    }
};
struct EpiMix {
    static constexpr bool PERM = true, ROWPERM = false, PREFETCH = false;
    __device__ __forceinline__ void operator()(f32x4 (&acc)[2][2][4][2], const GUnit& u, int wr, int wc, int fr, int fq) const {
        if (u.aux == 0) {
            bf16_t* base = (bf16_t*)u.C + wc * 32 + 8 * fq;
#pragma unroll
            for (int ai = 0; ai < 2; ++ai)
#pragma unroll
                for (int m = 0; m < 4; ++m) { bf16_t* rowp = base + (size_t)(ai * HALF + wr * 64 + m * 16 + fr) * u.ldc;
#pragma unroll
                    for (int bj = 0; bj < 2; ++bj) { const f32x4 v0 = acc[ai][bj][m][0], v1 = acc[ai][bj][m][1];
                        u32x4 w; w.x = cvt_pk_bf16(v0[0], v0[1]); w.y = cvt_pk_bf16(v0[2], v0[3]); w.z = cvt_pk_bf16(v1[0], v1[1]); w.w = cvt_pk_bf16(v1[2], v1[3]);
                        *(u32x4*)(rowp + bj * HALF) = w; } }
        } else {
            float* base = (float*)u.C + wc * 32 + 8 * fq;
#pragma unroll
            for (int ai = 0; ai < 2; ++ai)
#pragma unroll
                for (int m = 0; m < 4; ++m) { float* rowp = base + (size_t)(ai * HALF + wr * 64 + m * 16 + fr) * u.ldc;
#pragma unroll
                    for (int bj = 0; bj < 2; ++bj) { *(f32x4*)(rowp + bj * HALF) = acc[ai][bj][m][0]; *(f32x4*)(rowp + bj * HALF + 4) = acc[ai][bj][m][1]; } }
        }
    }
};
struct EpiResid {
    static constexpr bool PERM = true, ROWPERM = false, PREFETCH = false;
    bf16_t* xb; float* psum;
    __device__ __forceinline__ void operator()(f32x4 (&acc)[2][2][4][2], const GUnit& u, int wr, int wc, int fr, int fq) const {
        const int c0 = u.gcol0 + wc * 32 + 8 * fq;
        bf16_t* base = xb + (size_t)u.grow0 * D + c0;
#pragma unroll
        for (int ai = 0; ai < 2; ++ai) {
            u32x4 old[4][2];
#pragma unroll
            for (int m = 0; m < 4; ++m)
#pragma unroll
                for (int bj = 0; bj < 2; ++bj) old[m][bj] = *(const u32x4*)(base + (size_t)(ai * HALF + wr * 64 + m * 16 + fr) * D + bj * HALF);
#pragma unroll
            for (int m = 0; m < 4; ++m) {
                const int r = ai * HALF + wr * 64 + m * 16 + fr;
                float ss = 0.f;
#pragma unroll
                for (int bj = 0; bj < 2; ++bj) {
                    const u32x4 w0 = old[m][bj];
                    const f32x4 o0 = {bf2f(w0.x & 0xffff), bf2f(w0.x >> 16), bf2f(w0.y & 0xffff), bf2f(w0.y >> 16)}, o1 = {bf2f(w0.z & 0xffff), bf2f(w0.z >> 16), bf2f(w0.w & 0xffff), bf2f(w0.w >> 16)};
                    const f32x4 v0 = acc[ai][bj][m][0] + o0, v1 = acc[ai][bj][m][1] + o1;
                    u32x4 w; w.x = cvt_pk_bf16(v0[0], v0[1]); w.y = cvt_pk_bf16(v0[2], v0[3]); w.z = cvt_pk_bf16(v1[0], v1[1]); w.w = cvt_pk_bf16(v1[2], v1[3]);
                    *(u32x4*)(base + (size_t)r * D + bj * HALF) = w;
                    ss += (v0[0] * v0[0] + v0[1] * v0[1]) + (v0[2] * v0[2] + v0[3] * v0[3]) + (v1[0] * v1[0] + v1[1] * v1[1]) + (v1[2] * v1[2] + v1[3] * v1[3]);
                }
                ss += __shfl_xor(ss, 16); ss += __shfl_xor(ss, 32);
                if (fq == 0) psum[(size_t)(u.grow0 + r) * 64 + (u.gcol0 >> 8) * 4 + wc] = ss;
            }
            asm volatile("" ::: "memory");
        }
    }
};
struct EpiFfnUp {
    static constexpr bool PERM = true, ROWPERM = true, PREFETCH = true;
    bf16_t* act; float* halo; const float* rstd; const float* cw; const float* cb;
    static constexpr int PAR_BYTES = 5120;
    __device__ __forceinline__ void prefetch(const GUnit& u, LAS unsigned char* par, int wid, int lane) const {
        if (wid == 0) __builtin_amdgcn_global_load_lds((const unsigned*)(rstd + u.grow0 + lane * 4), (LAS unsigned*)(par), 16, 0, 0);
        else if (wid < 5) { const int a = 2 * (wid - 1) + (lane >> 5), cg = (u.gcol0 >> 1) + (lane & 31) * 4;
            const float* src = ((a & 3) == 3 ? cb : cw + (size_t)(a & 3) * NUP) + (a >> 2) * DFF + cg;
            __builtin_amdgcn_global_load_lds((const unsigned*)src, (LAS unsigned*)(par + 1024 + (wid - 1) * 1024), 16, 0, 0); }
    }
    __device__ __forceinline__ void operator()(f32x4 (&acc)[2][2][4][2], const GUnit& u, int wr, int wc, int fr, int fq, const LAS unsigned char* par) const {
        const int t0 = u.grow0 + wr * 128 + fr * 8;
        const int c0 = (u.gcol0 >> 1) + wc * 32 + 8 * fq;
        const int cl = wc * 32 + 8 * fq;
        {   const LAS f32x4* rp = (const LAS f32x4*)(par + (wr * 128 + fr * 8) * 4); const f32x4 ra = rp[0], rb = rp[1];
#pragma unroll
            for (int bj = 0; bj < 2; ++bj)
#pragma unroll
                for (int n = 0; n < 2; ++n) {
#pragma unroll
                    for (int m = 0; m < 4; ++m) { acc[0][bj][m][n] *= ra[m]; acc[1][bj][m][n] *= rb[m]; } } }
        const int blk = (u.grow0 >> 7) + wr;
        if (fr == 0 || fr == 15) {
            float* hp = halo + (size_t)blk * 4 * NUP + (fr == 0 ? 0 : 2 * NUP);
#pragma unroll
            for (int bj = 0; bj < 2; ++bj)
#pragma unroll
                for (int n = 0; n < 2; ++n) {
                    const f32x4 e0 = (fr == 0) ? acc[0][bj][0][n] : acc[1][bj][2][n];
                    const f32x4 e1 = (fr == 0) ? acc[0][bj][1][n] : acc[1][bj][3][n];
                    *(f32x4*)(hp + bj * DFF + c0 + 4 * n) = e0; *(f32x4*)(hp + NUP + bj * DFF + c0 + 4 * n) = e1; }
        }
        unsigned pk[8][4];
#pragma unroll
        for (int n = 0; n < 2; ++n) {
            const LAS f32x4* wp = (const LAS f32x4*)(par + 1024 + (cl + 4 * n) * 4);
            const f32x4 g0 = wp[0], g1 = wp[32], g2 = wp[64], gb = wp[96], u0 = wp[128], u1 = wp[160], u2 = wp[192], ub = wp[224];
            f32x4 gm1, gp8, um1, up8;
#pragma unroll
            for (int q = 0; q < 4; ++q) { gm1[q] = __shfl_up(acc[1][0][3][n][q], 1, 16); gp8[q] = __shfl_down(acc[0][0][0][n][q], 1, 16);
                                          um1[q] = __shfl_up(acc[1][1][3][n][q], 1, 16); up8[q] = __shfl_down(acc[0][1][0][n][q], 1, 16); }
#pragma unroll
            for (int j = 0; j < 8; ++j) {
                const f32x4 gl = (j == 0) ? gm1 : acc[(j + 7) >> 2 & 1][0][(j + 7) & 3][n], gc = acc[j >> 2][0][j & 3][n], gr = (j == 7) ? gp8 : acc[((j + 1) >> 2) & 1][0][(j + 1) & 3][n];
                const f32x4 ul = (j == 0) ? um1 : acc[(j + 7) >> 2 & 1][1][(j + 7) & 3][n], uc = acc[j >> 2][1][j & 3][n], ur = (j == 7) ? up8 : acc[((j + 1) >> 2) & 1][1][(j + 1) & 3][n];
                const f32x4 yg = __builtin_elementwise_fma(gr, g2, __builtin_elementwise_fma(gc, g1, __builtin_elementwise_fma(gl, g0, gb)));
                const f32x4 yu = __builtin_elementwise_fma(ur, u2, __builtin_elementwise_fma(uc, u1, __builtin_elementwise_fma(ul, u0, ub)));
                const f32x4 e = yg * (-1.4426950408889634f);
                f32x4 a;
#pragma unroll
                for (int q = 0; q < 4; ++q) a[q] = __builtin_amdgcn_rcpf(1.0f + __builtin_amdgcn_exp2f(e[q]));
                a = a * yg * yu;
                pk[j][2 * n] = cvt_pk_bf16(a[0], a[1]); pk[j][2 * n + 1] = cvt_pk_bf16(a[2], a[3]);
            }
        }
#pragma unroll
        for (int j = 0; j < 8; ++j) {
            const bool edge = (j == 0 && fr == 0) || (j == 7 && fr == 15);
            if (!edge) { u32x4 w; w.x = pk[j][0]; w.y = pk[j][1]; w.z = pk[j][2]; w.w = pk[j][3]; *(u32x4*)(act + (size_t)(t0 + j) * DFF + c0) = w; }
        }
    }
};
struct EpiQkv {
    static constexpr bool PERM = true, ROWPERM = false, PREFETCH = false;
    const float* rstd; const float* rot;
    __device__ __forceinline__ void operator()(f32x4 (&acc)[2][2][4][2], const GUnit& u, int wr, int wc, int fr, int fq) const {
        bf16_t* base = (bf16_t*)u.C + wc * 32 + 8 * fq;
        const bool rotary = (u.gcol0 < 2 * D) && (wc == 0);
#pragma unroll
        for (int ai = 0; ai < 2; ++ai)
#pragma unroll
            for (int m = 0; m < 4; ++m) {
                const int r = ai * HALF + wr * 64 + m * 16 + fr, gr = u.grow0 + r;
                const float s = rstd[gr];
                f32x4 v[2][2];
#pragma unroll
                for (int bj = 0; bj < 2; ++bj)
#pragma unroll
                    for (int n = 0; n < 2; ++n) v[bj][n] = acc[ai][bj][m][n] * s;
                if (rotary) {
                    const int pos = (gr < MP) ? gr : (gr & (LS - 1));
                    const float* rp = rot + (size_t)pos * 32 + 8 * (fq & 1);
                    const float sgn = (fq < 2) ? -1.0f : 1.0f;
#pragma unroll
                    for (int n = 0; n < 2; ++n) { const f32x4 cs = *(const f32x4*)(rp + 4 * n), sn = *(const f32x4*)(rp + 16 + 4 * n);
#pragma unroll
                        for (int bj = 0; bj < 2; ++bj) { f32x4 p;
#pragma unroll
                            for (int q = 0; q < 4; ++q) p[q] = __shfl_xor(v[bj][n][q], 32);
                            v[bj][n] = v[bj][n] * cs + p * (sn * sgn); } }
                }
                bf16_t* rowp = base + (size_t)r * u.ldc;
#pragma unroll
                for (int bj = 0; bj < 2; ++bj) { u32x4 w; w.x = cvt_pk_bf16(v[bj][0][0], v[bj][0][1]); w.y = cvt_pk_bf16(v[bj][0][2], v[bj][0][3]); w.z = cvt_pk_bf16(v[bj][1][0], v[bj][1][1]); w.w = cvt_pk_bf16(v[bj][1][2], v[bj][1][3]);
                    *(u32x4*)(rowp + bj * HALF) = w; }
            }
    }
};

template <class Epi, class Sched, bool ALIGN_EPI, bool SP2>
__device__ __forceinline__ void gemm_phase(LAS unsigned char* lds, const Sched& S, const Epi& E, const int wid, unsigned long long& epi_ticks) {
    const int tid = tid_opaque(wid), lane = tid & 63, wr = wid >> 2, wc = wid & 3, fr = lane & 15, fq = lane >> 4;
    unsigned RA[2], RB[2], C2[2];
#pragma unroll
    for (int i = 0; i < 2; ++i) { int R, C; stage_rc(tid * 16 + i * 8192, R, C);
        RA[i] = (unsigned)(Epi::ROWPERM ? rowperm(R) : R); RB[i] = (unsigned)(Epi::PERM ? ((R & ~31) + perm32(R & 31)) : R); C2[i] = (unsigned)C * 2u; }
    constexpr unsigned HROWS_A = Epi::ROWPERM ? 4u : 128u;
    const size_t kstep = (size_t)(BK * 2);
    const unsigned ldsw = (unsigned)wid * 1024u;
    const int aoff = lds_byte(wr * 64 + fr, fq * 8), boff = lds_byte(wc * 32 + fr, fq * 8);
#define PG_SA(b, h) (((b) * 2 + (h)) * HTB)
#define PG_SB(b, h) ((4 + (b) * 2 + (h)) * HTB)
#define PG_STAGE(bufoff, gbase, R, ld) do { _Pragma("unroll") for (int _i = 0; _i < 2; ++_i) \
        __builtin_amdgcn_global_load_lds((const unsigned*)((gbase) + (size_t)((R)[_i] * (ld) + C2[_i])), (LAS unsigned*)(lds + (bufoff) + ldsw + _i * 8192), 16, 0, 0); } while (0)
#define PG_LDA(dst, b, h) do { _Pragma("unroll") for (int m = 0; m < 4; ++m) _Pragma("unroll") for (int k = 0; k < 2; ++k) dst[m][k] = *(const LAS bf16x8*)(lds + PG_SA(b, h) + aoff + m * 2048 + k * 1024); } while (0)
#define PG_LDB(dst, b, h) do { _Pragma("unroll") for (int n = 0; n < 2; ++n) _Pragma("unroll") for (int k = 0; k < 2; ++k) dst[n][k] = *(const LAS bf16x8*)(lds + PG_SB(b, h) + boff + n * 2048 + k * 1024); } while (0)
#define PG_MMA(ai, bj, At, Bt) do { __builtin_amdgcn_s_setprio(1); _Pragma("unroll") for (int m = 0; m < 4; ++m) _Pragma("unroll") for (int n = 0; n < 2; ++n) _Pragma("unroll") for (int k = 0; k < 2; ++k) \
        acc[ai][bj][m][n] = __builtin_amdgcn_mfma_f32_16x16x32_bf16(Bt[n][k], At[m][k], acc[ai][bj][m][n], 0, 0, 0); __builtin_amdgcn_s_setprio(0); } while (0)
#define PG_WAIT_V(n) asm volatile("s_waitcnt vmcnt(" #n ")" ::: "memory")
#define PG_WAIT_L(n) asm volatile("s_waitcnt lgkmcnt(" #n ")" ::: "memory")
#define PG_BAR __builtin_amdgcn_s_barrier()
#define PG_SCHED __builtin_amdgcn_sched_barrier(0)
    GUnit cur, nxt; int ui = 0;
    if (!S.next(0, cur)) return;
    f32x4 acc[2][2][4][2];
#pragma unroll
    for (int a = 0; a < 2; ++a)
#pragma unroll
        for (int b = 0; b < 2; ++b)
#pragma unroll
            for (int m = 0; m < 4; ++m)
#pragma unroll
                for (int n = 0; n < 2; ++n) acc[a][b][m][n] = (f32x4){0.f, 0.f, 0.f, 0.f};
    bf16x8 At[4][2], B0[2][2], B1[2][2];
    const char* cA = cur.A; const char* cB = cur.B; unsigned lda = cur.lda, ldb = cur.ldb; int nt = cur.nt;
    LAS unsigned char* const par = lds + STAGE_BYTES;
    if constexpr (Epi::PREFETCH) E.prefetch(cur, par, wid, lane);
    {   const size_t hA = (size_t)HROWS_A * lda, hB = (size_t)128 * ldb;
        if constexpr (SP2) {
            PG_STAGE(PG_SB(0, 0), cB, RB, ldb); PG_STAGE(PG_SB(0, 1), cB + hB, RB, ldb); PG_STAGE(PG_SA(0, 0), cA, RA, lda); PG_STAGE(PG_SA(0, 1), cA + hA, RA, lda);
            if (wr == 1) PG_BAR;
            PG_WAIT_V(2); PG_BAR;
            PG_STAGE(PG_SB(1, 0), cB + kstep, RB, ldb); PG_STAGE(PG_SA(1, 0), cA + kstep, RA, lda); PG_STAGE(PG_SB(1, 1), cB + hB + kstep, RB, ldb);
            PG_WAIT_V(6); PG_BAR;
        } else {
            PG_STAGE(PG_SB(0, 0), cB, RB, ldb); PG_STAGE(PG_SA(0, 0), cA, RA, lda); PG_STAGE(PG_SB(0, 1), cB + hB, RB, ldb); PG_STAGE(PG_SA(0, 1), cA + hA, RA, lda);
            if (wr == 1) PG_BAR;
            PG_WAIT_V(4); PG_BAR;
            PG_STAGE(PG_SB(1, 0), cB + kstep, RB, ldb); PG_STAGE(PG_SA(1, 0), cA + kstep, RA, lda); PG_STAGE(PG_SB(1, 1), cB + hB + kstep, RB, ldb);
            PG_WAIT_V(6); PG_BAR;
        }
    }
    for (;;) {
        const bool has_next = S.next(ui + 1, nxt);
        const char* nA = has_next ? nxt.A : cA; const char* nB = has_next ? nxt.B : cB;
        const unsigned nlda = has_next ? nxt.lda : lda, nldb = has_next ? nxt.ldb : ldb;
        const size_t hA = (size_t)HROWS_A * lda, hB = (size_t)128 * ldb;
        for (int t = 0; t < nt; t += 2) {
            const bool last = (t == nt - 2);
            const char* a1 = cA + (size_t)(t + 1) * kstep;
            const char* a2 = last ? nA : cA + (size_t)(t + 2) * kstep; const char* b2 = last ? nB : cB + (size_t)(t + 2) * kstep;
            const unsigned lda2 = last ? nlda : lda, ldb2 = last ? nldb : ldb;
            const size_t hA2 = (size_t)HROWS_A * lda2, hB2 = (size_t)128 * ldb2;
            const char* a3 = a2 + kstep; const char* b3 = b2 + kstep;
            if constexpr (SP2) {
            PG_LDB(B0, 0, 0); PG_LDB(B1, 0, 1); PG_SCHED; PG_LDA(At, 0, 0); PG_STAGE(PG_SA(1, 1), a1 + hA, RA, lda);
            PG_WAIT_V(8); PG_WAIT_L(0); PG_BAR; PG_MMA(0, 0, At, B0); PG_MMA(0, 1, At, B1); PG_BAR; PG_SCHED;
            PG_LDA(At, 0, 1); PG_STAGE(PG_SB(0, 0), b2, RB, ldb2); PG_STAGE(PG_SB(0, 1), b2 + hB2, RB, ldb2); PG_STAGE(PG_SA(0, 0), a2, RA, lda2);
            PG_WAIT_V(8); PG_WAIT_L(0); PG_BAR; PG_MMA(1, 0, At, B0); PG_MMA(1, 1, At, B1); PG_BAR; PG_SCHED;
            PG_LDB(B0, 1, 0); PG_LDB(B1, 1, 1); PG_SCHED; PG_LDA(At, 1, 0); PG_STAGE(PG_SA(0, 1), a2 + hA2, RA, lda2);
            PG_WAIT_V(8); PG_WAIT_L(0); PG_BAR; PG_MMA(0, 0, At, B0); PG_MMA(0, 1, At, B1); PG_BAR; PG_SCHED;
            PG_LDA(At, 1, 1); PG_STAGE(PG_SB(1, 0), b3, RB, ldb2); PG_STAGE(PG_SB(1, 1), b3 + hB2, RB, ldb2); PG_STAGE(PG_SA(1, 0), a3, RA, lda2);
            PG_WAIT_V(8); PG_WAIT_L(0); PG_BAR; PG_MMA(1, 0, At, B0); PG_MMA(1, 1, At, B1); PG_BAR; PG_SCHED;
            } else {
            PG_LDB(B0, 0, 0); PG_SCHED; PG_LDA(At, 0, 0); PG_STAGE(PG_SA(1, 1), a1 + hA, RA, lda);
            PG_WAIT_L(8); PG_BAR; PG_WAIT_L(0); PG_MMA(0, 0, At, B0); PG_BAR; PG_SCHED;
            PG_LDB(B1, 0, 1); PG_STAGE(PG_SB(0, 0), b2, RB, ldb2);
            PG_BAR; PG_WAIT_L(0); PG_MMA(0, 1, At, B1); PG_BAR;
            PG_LDA(At, 0, 1); PG_STAGE(PG_SA(0, 0), a2, RA, lda2);
            PG_BAR; PG_WAIT_L(0); PG_MMA(1, 0, At, B0); PG_BAR; PG_SCHED;
            PG_STAGE(PG_SB(0, 1), b2 + hB2, RB, ldb2);
            PG_WAIT_V(6); PG_BAR; PG_MMA(1, 1, At, B1); PG_BAR;
            PG_LDB(B0, 1, 0); PG_SCHED; PG_LDA(At, 1, 0); PG_STAGE(PG_SA(0, 1), a2 + hA2, RA, lda2);
            PG_WAIT_L(8); PG_BAR; PG_WAIT_L(0); PG_MMA(0, 0, At, B0); PG_BAR; PG_SCHED;
            PG_LDB(B1, 1, 1); PG_STAGE(PG_SB(1, 0), b3, RB, ldb2);
            PG_BAR; PG_WAIT_L(0); PG_MMA(0, 1, At, B1); PG_BAR;
            PG_LDA(At, 1, 1); PG_STAGE(PG_SA(1, 0), a3, RA, lda2);
            PG_BAR; PG_WAIT_L(0); PG_MMA(1, 0, At, B0); PG_BAR; PG_SCHED;
            PG_STAGE(PG_SB(1, 1), b3 + hB2, RB, ldb2);
            PG_WAIT_V(6); PG_BAR; PG_MMA(1, 1, At, B1); PG_BAR;
            }
        }
        if constexpr (ALIGN_EPI) { if (wr == 0) PG_BAR; }
        if constexpr (Epi::PREFETCH) { E(acc, cur, wr, wc, fr, fq, par + (ui & 1) * Epi::PAR_BYTES); if (has_next) E.prefetch(nxt, par + ((ui + 1) & 1) * Epi::PAR_BYTES, wid, lane); }
        else E(acc, cur, wr, wc, fr, fq);
        if (!has_next) break;
#pragma unroll
        for (int a = 0; a < 2; ++a)
#pragma unroll
            for (int b = 0; b < 2; ++b)
#pragma unroll
                for (int m = 0; m < 4; ++m)
#pragma unroll
                    for (int n = 0; n < 2; ++n) acc[a][b][m][n] = (f32x4){0.f, 0.f, 0.f, 0.f};
        cur = nxt; cA = nA; cB = nB; lda = nlda; ldb = nldb; nt = cur.nt; ++ui;
        if constexpr (ALIGN_EPI) { if (wr == 1) PG_BAR; }
    }
    PG_WAIT_V(0);
    if constexpr (!ALIGN_EPI) { if (wr == 0) PG_BAR; }
    PG_BAR;
#undef PG_SA
#undef PG_SB
#undef PG_STAGE
#undef PG_LDA
#undef PG_LDB
#undef PG_MMA
#undef PG_WAIT_V
#undef PG_WAIT_L
#undef PG_BAR
#undef PG_SCHED
}

struct DenseOrder {
    const char* A; const char* B; char* C; unsigned lda, ldb, ldc; int csz; int nM, nN, nt, G, c; int gs = 8;
    __device__ __forceinline__ bool next(int i, GUnit& u) const {
        const int nwg = nM * nN; const long L = (long)i * G + c; if (L >= nwg) return false;
        int wgid = (int)L; { const int q = nwg / 8, r = nwg % 8, xcd = wgid % 8, off = wgid / 8; wgid = (xcd < r ? xcd * (q + 1) : r * (q + 1) + (xcd - r) * q) + off; }
        const int nig = gs * nN, gid = wgid / nig, fm = gid * gs, gsz = (nM - fm) < gs ? (nM - fm) : gs;
        const int pm = fm + ((wgid % nig) % gsz), pn = (wgid % nig) / gsz;
        u.A = A + (size_t)pm * 256 * lda; u.B = B + (size_t)pn * 256 * ldb; u.lda = lda; u.ldb = ldb; u.nt = nt;
        u.C = C + ((size_t)pm * 256 * ldc + (size_t)pn * 256) * csz; u.ldc = ldc; u.grow0 = pm * 256; u.gcol0 = pn * 256; u.aux = 0;
        return true;
    }
};
struct DynOrder : DenseOrder {
    unsigned* ctr; volatile LAS unsigned* slot; int wave; int dynr;
    int xloc = 0;
    __device__ __forceinline__ bool next(int i, GUnit& u) const {
        const int nwg = nM * nN, sr = nwg / G - dynr;
        const bool loc = xloc && (nwg % 8 == 0) && (G % 8 == 0);
        const int left = loc ? nwg / 8 - sr * (G / 8) : nwg - sr * G;
        if (i + 1 >= sr && wave == 0) {
            unsigned t = 0u; if (threadIdx.x == 0) t = __hip_atomic_fetch_add(loc ? ctr + 64 * (c & 7) : ctr, 1u, __ATOMIC_RELAXED, __HIP_MEMORY_SCOPE_AGENT);
            t = (unsigned)__builtin_amdgcn_readfirstlane((int)t);
            if (threadIdx.x == 0) slot[(i + 1) & 1] = t;
        }
        long L;
        if (i < sr) L = (long)i * G + c;
        else { const unsigned t = (unsigned)__builtin_amdgcn_readfirstlane((int)slot[i & 1]); if (t >= (unsigned)left) return false; L = loc ? ((long)sr * (G / 8) + t) * 8 + (c & 7) : (long)sr * G + t; }
        int wgid = (int)L; { const int q = nwg / 8, r = nwg % 8, xcd = wgid % 8, off = wgid / 8; wgid = (xcd < r ? xcd * (q + 1) : r * (q + 1) + (xcd - r) * q) + off; }
        const int nig = gs * nN, gid = wgid / nig, fm = gid * gs, gsz = (nM - fm) < gs ? (nM - fm) : gs;
        const int pm = fm + ((wgid % nig) % gsz), pn = (wgid % nig) / gsz;
        u.A = A + (size_t)pm * 256 * lda; u.B = B + (size_t)pn * 256 * ldb; u.lda = lda; u.ldb = ldb; u.nt = nt;
        u.C = C + ((size_t)pm * 256 * ldc + (size_t)pn * 256) * csz; u.ldc = ldc; u.grow0 = pm * 256; u.gcol0 = pn * 256; u.aux = 0;
        return true;
    }
};
}

namespace at {
constexpr int DH = 128, NW = 8, QBLK = 32, KVBLK = 64;
constexpr float SCALE = 0.088388347648318440f;
constexpr float THR = 8.f;
constexpr int LDQ = NQKV, LDK = NQKV, LDO = D;
constexpr size_t SHM_V = KVBLK * DH * 2, SHM_K = KVBLK * DH * 2, SHM_ATTN = 2 * SHM_V + 2 * SHM_K + NW * 64 * 4;
#define KSWZ(row, colB) ((row) * 256 + ((colB) ^ (((row) & 7) << 4)))
#define SBAR() __builtin_amdgcn_sched_barrier(0)
__device__ __forceinline__ int crow(int r, int hi) { return (r & 3) + 8 * (r >> 2) + 4 * hi; }
__device__ __forceinline__ unsigned cvtpk(float lo, float hi) { unsigned r; asm volatile("v_cvt_pk_bf16_f32 %0, %1, %2" : "=v"(r) : "v"(lo), "v"(hi)); return r; }
__device__ __forceinline__ void partialSM(f32x16& p0, f32x16& p1, float& m_reg, float& mn, float& alpha) {
  constexpr float C = SCALE * 1.4426950408889634f;
  float pmax = p0[0]; for (int r = 1; r < 16; ++r) pmax = fmaxf(pmax, p0[r]); for (int r = 0; r < 16; ++r) pmax = fmaxf(pmax, p1[r]);
  { auto rr = __builtin_amdgcn_permlane32_swap(__float_as_uint(pmax), __float_as_uint(pmax), false, false);
    pmax = fmaxf(__uint_as_float(rr[0]), __uint_as_float(rr[1])); }
  if (__builtin_expect(__all(pmax - m_reg <= THR / SCALE), 1)) { mn = m_reg; alpha = 1.f; }
  else { mn = fmaxf(m_reg, pmax); alpha = __builtin_amdgcn_exp2f((m_reg - mn) * C); m_reg = mn; }
  float mnC = -mn * C;
  for (int r = 0; r < 16; ++r) p0[r] = fmaf(p0[r], C, mnC); for (int r = 0; r < 16; ++r) p1[r] = fmaf(p1[r], C, mnC);
  for (int r = 0; r < 16; ++r) p0[r] = __builtin_amdgcn_exp2f(p0[r]);
}
__device__ __forceinline__ void finishSM(f32x16& p0, f32x16& p1, float alpha, float& l_reg, bf16x8& pa0, bf16x8& pa1, bf16x8& pa2, bf16x8& pa3) {
  for (int r = 0; r < 16; ++r) p1[r] = __builtin_amdgcn_exp2f(p1[r]);
  float ps = 0; for (int r = 0; r < 16; ++r) ps += p0[r]; for (int r = 0; r < 16; ++r) ps += p1[r];
  { auto rr = __builtin_amdgcn_permlane32_swap(__float_as_uint(ps), __float_as_uint(ps), false, false);
    ps = __uint_as_float(rr[0]) + __uint_as_float(rr[1]); }
  l_reg = l_reg * alpha + ps;
#define PK4(P, BASE, OUT) do { unsigned a0 = cvtpk(P[BASE + 0], P[BASE + 1]), a1 = cvtpk(P[BASE + 2], P[BASE + 3]);   \
    unsigned b0 = cvtpk(P[BASE + 4], P[BASE + 5]), b1 = cvtpk(P[BASE + 6], P[BASE + 7]);                              \
    auto r0 = __builtin_amdgcn_permlane32_swap(a0, b0, false, false); auto r1 = __builtin_amdgcn_permlane32_swap(a1, b1, false, false); \
    u32x4 w = {r0[0], r1[0], r0[1], r1[1]}; OUT = *reinterpret_cast<bf16x8*>(&w); } while (0)
  PK4(p0, 0, pa0); PK4(p0, 8, pa1); PK4(p1, 0, pa2); PK4(p1, 8, pa3);
#undef PK4
}
__device__ __forceinline__ void qkt(f32x16& p0, f32x16& p1, const bf16_t* Ks, const bf16x8* qr, int r32, int hi) {
  p0 = f32x16{}; p1 = f32x16{};
  for (int d0 = 0; d0 < 8; ++d0) { int cb = (d0 * 16 + hi * 8) * 2;
    bf16x8 b0 = *reinterpret_cast<const bf16x8*>((const char*)Ks + KSWZ(r32, cb));
    bf16x8 b1 = *reinterpret_cast<const bf16x8*>((const char*)Ks + KSWZ(32 + r32, cb));
    p0 = __builtin_amdgcn_mfma_f32_32x32x16_bf16(b0, qr[d0], p0, 0, 0, 0);
    p1 = __builtin_amdgcn_mfma_f32_32x32x16_bf16(b1, qr[d0], p1, 0, 0, 0); }
}
__device__ __forceinline__ void qkt_pipe(f32x16& p0, f32x16& p1, int kbase, const bf16x8* qr) {
  bf16x8 kb[3][2];
#define KRD(slot, d0) do { const int _a = kbase ^ ((d0) << 5); asm volatile("ds_read_b128 %0, %1" : "=&v"(kb[slot][0]) : "v"(_a) : "memory"); \
    asm volatile("ds_read_b128 %0, %1 offset:8192" : "=&v"(kb[slot][1]) : "v"(_a) : "memory"); } while (0)
#define KW(n) do { asm volatile("s_waitcnt lgkmcnt(" #n ")" ::: "memory"); SBAR(); } while (0)
#define KMM(slot, d0, c0, c1) do { p0 = __builtin_amdgcn_mfma_f32_32x32x16_bf16(kb[slot][0], qr[d0], c0, 0, 0, 0); p1 = __builtin_amdgcn_mfma_f32_32x32x16_bf16(kb[slot][1], qr[d0], c1, 0, 0, 0); SBAR(); } while (0)
  const f32x16 z = f32x16{};
  KRD(0, 0); KRD(1, 1); KRD(2, 2);
  __builtin_amdgcn_s_setprio(3);
  KW(4); KMM(0, 0, z, z); KRD(0, 3);
  KW(4); KMM(1, 1, p0, p1); KRD(1, 4);
  KW(4); KMM(2, 2, p0, p1); KRD(2, 5);
  KW(4); KMM(0, 3, p0, p1); KRD(0, 6);
  KW(4); KMM(1, 4, p0, p1); KRD(1, 7);
  KW(4); KMM(2, 5, p0, p1);
  KW(2); KMM(0, 6, p0, p1);
  KW(0); KMM(1, 7, p0, p1);
  __builtin_amdgcn_s_setprio(0);
#undef KRD
#undef KW
#undef KMM
}
__device__ __forceinline__ int v_st(int k, int c) { const int kk = (k & ~0xC) | ((k & 4) << 1) | ((k & 8) >> 1); return ((kk >> 3) * 4 + (c >> 5)) * 512 + ((kk & 7) * 32 + (c & 31)) * 2; }
__device__ __forceinline__ int v_rd_base(int lane) { return ((lane & 3) << 3) | (((lane >> 2) & 3) << 6) | (((lane >> 4) & 1) << 5) | (((lane >> 5) & 1) << 8); }
constexpr int v_rd_off(int d0, int ks, int half) { return d0 * 512 + ks * 4096 + half * 2048; }
template <int OFF> __device__ __forceinline__ s16x4 tr_read(int vb) {
  s16x4 r; asm volatile("ds_read_b64_tr_b16 %0, %1 offset:%2" : "=&v"(r) : "v"(vb), "i"(OFF) : "memory"); return r;
}
template <int D0> __device__ __forceinline__ void pv_one(f32x16& od, int vb, bf16x8 pa0, bf16x8 pa1, bf16x8 pa2, bf16x8 pa3) {
  const s16x4 l0 = tr_read<v_rd_off(D0, 0, 0)>(vb), h0 = tr_read<v_rd_off(D0, 0, 1)>(vb), l1 = tr_read<v_rd_off(D0, 1, 0)>(vb), h1 = tr_read<v_rd_off(D0, 1, 1)>(vb);
  const s16x4 l2 = tr_read<v_rd_off(D0, 2, 0)>(vb), h2 = tr_read<v_rd_off(D0, 2, 1)>(vb), l3 = tr_read<v_rd_off(D0, 3, 0)>(vb), h3 = tr_read<v_rd_off(D0, 3, 1)>(vb);
  asm volatile("s_waitcnt lgkmcnt(0)" ::: "memory"); SBAR();
#define PK(L, H) (bf16x8){L[0], L[1], L[2], L[3], H[0], H[1], H[2], H[3]}
  od = __builtin_amdgcn_mfma_f32_32x32x16_bf16(pa0, PK(l0, h0), od, 0, 0, 0);
  od = __builtin_amdgcn_mfma_f32_32x32x16_bf16(pa1, PK(l1, h1), od, 0, 0, 0);
  od = __builtin_amdgcn_mfma_f32_32x32x16_bf16(pa2, PK(l2, h2), od, 0, 0, 0);
  od = __builtin_amdgcn_mfma_f32_32x32x16_bf16(pa3, PK(l3, h3), od, 0, 0, 0);
#undef PK
}
__device__ __forceinline__ void pv_d0(f32x16* o, int vb, bf16x8 pa0, bf16x8 pa1, bf16x8 pa2, bf16x8 pa3) {
  pv_one<0>(o[0], vb, pa0, pa1, pa2, pa3); pv_one<1>(o[1], vb, pa0, pa1, pa2, pa3); pv_one<2>(o[2], vb, pa0, pa1, pa2, pa3); pv_one<3>(o[3], vb, pa0, pa1, pa2, pa3);
}
#define TRD(dst, D, vb) do { const int _b = (vb) + ((D) >> 2) * 16384; \
    dst[0] = tr_read<v_rd_off((D) & 3, 0, 0)>(_b); dst[1] = tr_read<v_rd_off((D) & 3, 0, 1)>(_b); dst[2] = tr_read<v_rd_off((D) & 3, 1, 0)>(_b); dst[3] = tr_read<v_rd_off((D) & 3, 1, 1)>(_b); \
    dst[4] = tr_read<v_rd_off((D) & 3, 2, 0)>(_b); dst[5] = tr_read<v_rd_off((D) & 3, 2, 1)>(_b); dst[6] = tr_read<v_rd_off((D) & 3, 3, 0)>(_b); dst[7] = tr_read<v_rd_off((D) & 3, 3, 1)>(_b); } while (0)
#define PKV(L, H) (bf16x8){L[0], L[1], L[2], L[3], H[0], H[1], H[2], H[3]}
#define MM4(od, src) do { __builtin_amdgcn_s_setprio(2); od = __builtin_amdgcn_mfma_f32_32x32x16_bf16(pa0, PKV(src[0], src[1]), od, 0, 0, 0); od = __builtin_amdgcn_mfma_f32_32x32x16_bf16(pa1, PKV(src[2], src[3]), od, 0, 0, 0); \
    od = __builtin_amdgcn_mfma_f32_32x32x16_bf16(pa2, PKV(src[4], src[5]), od, 0, 0, 0); od = __builtin_amdgcn_mfma_f32_32x32x16_bf16(pa3, PKV(src[6], src[7]), od, 0, 0, 0); __builtin_amdgcn_s_setprio(0); } while (0)
#define LW(n) do { asm volatile("s_waitcnt lgkmcnt(" #n ")" ::: "memory"); SBAR(); } while (0)
__device__ __forceinline__ void pv8(f32x16* o, int vb, bf16x8 pa0, bf16x8 pa1, bf16x8 pa2, bf16x8 pa3) {
  s16x4 va[8], vq[8];
  TRD(va, 0, vb); TRD(vq, 1, vb);
  LW(8); MM4(o[0], va); SBAR(); TRD(va, 2, vb);
  LW(8); MM4(o[1], vq); SBAR(); TRD(vq, 3, vb);
  LW(8); MM4(o[2], va); SBAR(); TRD(va, 4, vb);
  LW(8); MM4(o[3], vq); SBAR(); TRD(vq, 5, vb);
  LW(8); MM4(o[4], va); SBAR(); TRD(va, 6, vb);
  LW(8); MM4(o[5], vq); SBAR(); TRD(vq, 7, vb);
  LW(8); MM4(o[6], va);
  LW(0); MM4(o[7], vq);
}
#undef TRD
#undef PKV
#undef MM4
#undef LW
constexpr int KB_BYTES = KVBLK * DH * 2  , VB_BYTES = KVBLK * 256 * 2  ;
constexpr int AT_K_OFF = 0, AT_V_OFF = 2 * KB_BYTES, AT_W_OFF = AT_V_OFF + 2 * VB_BYTES, AT_LDS = AT_W_OFF + NW * 64 * 4;
__device__ __forceinline__ void attn256_body(const bf16_t* __restrict__ Qb, const bf16_t* __restrict__ Kh, const bf16_t* __restrict__ Vh, bf16_t* __restrict__ Ob, int seq, char* lds, const int wid) {
  const int tid = tid_opaque(wid), lane = tid & 63, r32 = lane & 31, hi = lane >> 5, grp = wid >> 2;
  LAS char* L = (LAS char*)lds;
  float* ws = (float*)(lds + AT_W_OFF) + wid * 64; float* li_l = ws; float* al_l = ws + 32;
  float m_reg = -1e30f, l_reg = 0; f32x16 o[8]; bf16x8 qr[8];
#pragma unroll
  for (int d = 0; d < 8; ++d) o[d] = f32x16{};
  const bf16_t* Qw = Qb + (long)(wid * QBLK + r32) * LDQ + hi * 8;
#pragma unroll
  for (int d0 = 0; d0 < 8; ++d0) qr[d0] = *reinterpret_cast<const bf16x8*>(Qw + d0 * 16);
  const int wq = wid & 3;
#define DMA_K(j, b) do { const char* _g = (const char*)Kh + (size_t)(j) * (KVBLK * LDK * 2); const int _l = tid_opaque(0); _Pragma("unroll") for (int _i = 0; _i < 4; ++_i) { \
    const int _r = 16 * wq + 4 * _i + (_l >> 4); const unsigned _o = (unsigned)(_r * (LDK * 2) + (((_l & 15) ^ (_r & 7)) << 4)); \
    __builtin_amdgcn_global_load_lds((const unsigned*)(_g + _o), (LAS unsigned*)(L + AT_K_OFF + (b) * KB_BYTES + wq * 4096 + _i * 1024), 16, 0, 0); } } while (0)
#define DMA_V(j, b) do { const char* _g = (const char*)Vh + (size_t)(j) * (KVBLK * LDK * 2); const int _l = tid_opaque(0); _Pragma("unroll") for (int _i = 0; _i < 8; ++_i) { \
    const int _tt = 8 * (wq & 1) + _i, _kk = (_tt >> 1) * 8 + ((_l & 31) >> 2), _k = (_kk & ~0xC) | ((_kk & 4) << 1) | ((_kk & 8) >> 1); \
    const int _c = (2 * (_tt & 1) + (_l >> 5)) * 32 + (_l & 3) * 8; const unsigned _o = (unsigned)(_k * (LDK * 2) + ((wq >> 1) * 128 + _c) * 2); \
    __builtin_amdgcn_global_load_lds((const unsigned*)(_g + _o), (LAS unsigned*)(L + AT_V_OFF + (b) * VB_BYTES + wq * 8192 + _i * 1024), 16, 0, 0); } } while (0)
#define RESC8(a) do { if (__any((a) < 1.f)) { if (hi == 0) al_l[r32] = (a); asm volatile("s_waitcnt lgkmcnt(0)" ::: "memory"); \
    _Pragma("unroll") for (int d = 0; d < 8; ++d) _Pragma("unroll") for (int r = 0; r < 16; ++r) o[d][r] *= al_l[crow(r, hi)]; } } while (0)
  const int vb0 = (int)(uintptr_t)(lds + AT_V_OFF) + v_rd_base(lane);
  const int NT = seq / KVBLK;
  f32x16 p0, p1; float mn, al; bf16x8 pa0, pa1, pa2, pa3;
  asm volatile("s_waitcnt vmcnt(0)" ::: "memory");
  if (grp) DMA_K(0, 0); else DMA_V(0, 0);
  asm volatile("s_waitcnt vmcnt(0)" ::: "memory"); __builtin_amdgcn_s_barrier();
#define QKSM(jq) do { const int kbase = (int)(uintptr_t)(lds + AT_K_OFF) + ((jq) & 1) * KB_BYTES + r32 * 256 + ((hi << 4) ^ ((r32 & 7) << 4)); qkt_pipe(p0, p1, kbase, qr); partialSM(p0, p1, m_reg, mn, al); RESC8(al); \
    finishSM(p0, p1, al, l_reg, pa0, pa1, pa2, pa3); } while (0)
#define PV(jp) do { const int vb = vb0 + ((jp) & 1) * VB_BYTES; pv8(o, vb, pa0, pa1, pa2, pa3); } while (0)
#define VM0_BAR() do { asm volatile("s_waitcnt vmcnt(0)" ::: "memory"); __builtin_amdgcn_s_barrier(); } while (0)
  if (grp == 0) {
    for (int j = 0; j < NT; ++j) {
      QKSM(j); VM0_BAR();
      if (j + 1 < NT) DMA_V(j + 1, (j + 1) & 1);
      PV(j); __builtin_amdgcn_s_barrier();
    }
    VM0_BAR();
  } else {
    for (int j = 0; j < NT; ++j) {
      if (j + 1 < NT) DMA_K(j + 1, (j + 1) & 1);
      if (j > 0) PV(j - 1);
      __builtin_amdgcn_s_barrier();
      QKSM(j); VM0_BAR();
    }
    PV(NT - 1);
    VM0_BAR();
  }
#undef VM0_BAR
#undef QKSM
#undef PV
  if (hi == 0) li_l[r32] = l_reg; asm volatile("s_waitcnt lgkmcnt(0)" ::: "memory");
  float rli[16];
#pragma unroll
  for (int r = 0; r < 16; ++r) rli[r] = __builtin_amdgcn_rcpf(li_l[crow(r, hi)]);
  unsigned* Ow = (unsigned*)Ob + (long)(wid * (QBLK / 2)) * LDO;
#pragma unroll
  for (int r = 0; r < 16; r += 2) { const int prow = crow(r, hi) >> 1;
#pragma unroll
    for (int d0 = 0; d0 < 8; ++d0) Ow[(long)prow * LDO + d0 * 32 + r32] = cvtpk(o[d0][r] * rli[r], o[d0][r + 1] * rli[r + 1]); }
  asm volatile("s_waitcnt vmcnt(0) lgkmcnt(0)" ::: "memory"); __builtin_amdgcn_s_barrier();
#undef DMA_K
#undef DMA_V
#undef RESC8
}
#undef KSWZ
#undef SBAR
}

struct Frame {
    LAS unsigned char* lds; volatile LAS unsigned* MISC; unsigned* ctl;
    int wave, G, bx;
    const float* in[22]; float* out; unsigned char* ws;
};

constexpr int TP_S = 65, TP_BYTES = 64 * TP_S * 4;
template <bool NT>
__device__ __forceinline__ void transpose_item(const float* W, int K, int N, bf16_t* WT, int k0, int n0, int dst_row0, const float* gk, int gmask, float gmul, const float* gn,
                                               LAS float* scr, int lane) {
    const int lr = lane >> 4, lc = (lane & 15) * 4;
    f32x4 v[16];
#pragma unroll
    for (int i = 0; i < 16; ++i) { const GAS f32x4* p = (const GAS f32x4*)(W + (size_t)(k0 + 4 * i + lr) * N + n0 + lc); if constexpr (NT) v[i] = __builtin_nontemporal_load(p); else v[i] = *p; }
    f32x4 ns = {1.f, 1.f, 1.f, 1.f}; if (gn) ns = *(const f32x4*)(gn + n0 + lc);
#pragma unroll
    for (int i = 0; i < 16; ++i) { const int k = 4 * i + lr; const float ks = (gk ? gk[(k0 + k) & gmask] : 1.0f) * gmul;
        const f32x4 x = v[i] * ns * ks; LAS float* p = scr + k * TP_S + lc; p[0] = x.x; p[1] = x.y; p[2] = x.z; p[3] = x.w; }
    LDS_WAIT(); asm volatile("" ::: "memory");
    const int c = lane >> 3, nl = lane & 7;
#pragma unroll
    for (int j = 0; j < 8; ++j) { const int n = 8 * j + nl; const LAS float* sp = scr + (8 * c) * TP_S + n;
        u32x4 o; o.x = cvt_pk_bf16(sp[0 * TP_S], sp[1 * TP_S]); o.y = cvt_pk_bf16(sp[2 * TP_S], sp[3 * TP_S]); o.z = cvt_pk_bf16(sp[4 * TP_S], sp[5 * TP_S]); o.w = cvt_pk_bf16(sp[6 * TP_S], sp[7 * TP_S]);
        *(GAS u32x4*)(WT + (size_t)(dst_row0 + n) * K + k0 + 8 * c) = o; }
    LDS_WAIT(); asm volatile("" ::: "memory");
}
template <class RowMap>
__device__ __forceinline__ void transpose_matrix(const float* W, int K, int N, bf16_t* WT, const float* gk, int gmask, float gmul, const float* gn, RowMap rowmap,
                                                 LAS float* scr, int lane, int gw, int NGW, int& rot) {
    const int nblk = N / 64, nitems = (K / 64) * nblk;
    int first = gw - rot; if (first < 0) first += NGW;
    for (int it = first; it < nitems; it += NGW) { const int kb = it / nblk, nb = it % nblk;
        transpose_item<true>(W, K, N, WT, 64 * kb, 64 * nb, rowmap(64 * nb), gk, gmask, gmul, gn, scr, lane); }
    rot = (rot + nitems) % NGW;
}
struct RowId { __device__ __forceinline__ int operator()(int n0) const { return n0; } };
struct RowUp { __device__ __forceinline__ int operator()(int n0) const { const int up = n0 >= DFF, nn = up ? n0 - DFF : n0; return (nn >> 7) * 256 + up * 128 + (nn & 127); } };

__device__ __forceinline__ void p_wdn_filler(Frame& F, int l, unsigned* ctr) {
    LAS float* scr = (LAS float*)(F.lds + RING_OFF + F.wave * TP_BYTES);
    const int lane = tid_opaque(F.wave) & 63;
    const float* W = F.in[20] + (size_t)l * DFF * D; bf16_t* WT = (bf16_t*)(F.ws + WS_WDN) + (size_t)l * D * DFF;
    constexpr int NBLK = D / 64, PER = 2, NTICK = (DFF / 64) * NBLK / (NWAVES * PER);
    static_assert((DFF / 64) * NBLK % (NWAVES * PER) == 0, "whole tickets");
    for (int k = 0;; ++k) {
        if (threadIdx.x == 0) F.MISC[22 + (k & 1)] = __hip_atomic_fetch_add(ctr, 1u, __ATOMIC_RELAXED, __HIP_MEMORY_SCOPE_AGENT);
        __syncthreads();
        const unsigned t = (unsigned)__builtin_amdgcn_readfirstlane((int)F.MISC[22 + (k & 1)]);
        if (t >= (unsigned)NTICK) break;
#pragma unroll 1
        for (int b = 0; b < PER; ++b) { const int it = ((int)t * PER + b) * NWAVES + F.wave, kb = it / NBLK, nb = it % NBLK;
            transpose_item<false>(W, DFF, D, WT, 64 * kb, 64 * nb, 64 * nb, nullptr, 0, 1.0f, nullptr, scr, lane); }
    }
}

__device__ __forceinline__ void p_prologue(Frame& F) {
    LAS float* scr = (LAS float*)(F.lds + RING_OFF + F.wave * TP_BYTES);
    const int tid = tid_opaque(F.wave), lane = tid & 63; int rot = 0;
    const int gw = F.bx * NWAVES + F.wave, NGW = F.G * NWAVES;
    unsigned char* ws = F.ws;
    {   float* rstd = (float*)(ws + WS_RSTD); bf16_t* xb = (bf16_t*)(ws + WS_XB);
        for (int r = gw; r < M; r += NGW) {
            const float* xrow = (r < MP) ? F.in[0] + (size_t)r * D : F.in[1] + (size_t)(r - MP) * D;
            const GAS f32x4* xr = (const GAS f32x4*)xrow + lane;
            f32x4 v[16]; float s = 0.f;
#pragma unroll
            for (int j = 0; j < 16; ++j) { v[j] = __builtin_nontemporal_load(xr + 64 * j); s += (v[j].x * v[j].x + v[j].y * v[j].y) + (v[j].z * v[j].z + v[j].w * v[j].w); }
            s = wave_sum(s);
            if (lane == 0) rstd[r] = 1.0f / sqrtf(s * (1.0f / D) + NORM_EPS);
            GAS u32x2* o8 = (GAS u32x2*)(xb + (size_t)r * D) + lane;
#pragma unroll
            for (int j = 0; j < 16; ++j) { u32x2 w; w.x = pk2(v[j].x, v[j].y); w.y = pk2(v[j].z, v[j].w); o8[64 * j] = w; }
        }
    }
    transpose_matrix(F.in[3], D, D, (bf16_t*)(ws + WS_WIN), F.in[2], 0xffff, 1.0f, nullptr, RowId(), scr, lane, gw, NGW, rot);
    for (int g = 0; g < 4; ++g)
        transpose_matrix(F.in[4] + (size_t)g * PG * PG, PG, PG, (bf16_t*)(ws + WS_POOLT) + (size_t)g * PG * PG, nullptr, 0, 1.0f, F.in[5] + g * PG, RowId(), scr, lane, gw, NGW, rot);
    transpose_matrix(F.in[7], D, D, (bf16_t*)(ws + WS_WOE), nullptr, 0, 1.0f, nullptr, RowId(), scr, lane, gw, NGW, rot);
    transpose_matrix(F.in[9], D, NQKV, (bf16_t*)(ws + WS_WQKV), F.in[8], 0xffff, 1.0f, nullptr, RowId(), scr, lane, gw, NGW, rot);
    transpose_matrix(F.in[15], D, D, (bf16_t*)(ws + WS_WOO), F.in[14], 255, 1.0f - LAMBDA_INIT, nullptr, RowId(), scr, lane, gw, NGW, rot);
    for (int l = 0; l < 2; ++l) {
        transpose_matrix(F.in[17] + (size_t)l * D * NUP, D, NUP, (bf16_t*)(ws + WS_WUP) + (size_t)l * NUP * D, F.in[16] + l * D, 0xffff, 1.0f, nullptr, RowUp(), scr, lane, gw, NGW, rot);
    }
    for (int which = 0; which < 2; ++which) {
        const int L = which ? LS : LP, Hf = L / 2; bf16_t* dft = (bf16_t*)(ws + (which ? WS_DFTS : WS_DFTP));
        const float inv = 1.0f / (float)L, nrm = 1.0f / sqrtf((float)L);
        const int chunks = Hf / 512, per = Hf * chunks, nitems = 2 * per;
        for (int it = gw; it < nitems; it += NGW) { const int part = it / per, r = it % per, k = r / chunks, t0 = (r % chunks) * 512 + lane * 8; float v[8];
#pragma unroll
            for (int e = 0; e < 8; ++e) { const int idx = (k * (t0 + e) + (part ? 3 * (L >> 2) : 0)) & (L - 1); v[e] = __builtin_amdgcn_cosf((float)idx * inv) * nrm; }
            u32x4 o; o.x = pk2(v[0], v[1]); o.y = pk2(v[2], v[3]); o.z = pk2(v[4], v[5]); o.w = pk2(v[6], v[7]);
            *(GAS u32x4*)(dft + ((size_t)part * Hf + k) * Hf + t0) = o; }
    }
    {   __syncthreads();
        LAS float* tab = (LAS float*)(F.lds + RING_OFF);
        if (tid < 256) tab[tid] = cospif((float)tid * (1.0f / 128.0f));
        __syncthreads();
        bf16_t* gt = (bf16_t*)(ws + WS_GT); const float* fw = F.in[6];
        for (int it = gw; it < 2048; it += NGW) { const int h = it >> 9, c = ((it >> 7) & 3) * 64 + lane, n0 = (it & 127) * 8;
            float ac[8], as[8];
#pragma unroll
            for (int q = 0; q < 8; ++q) { ac[q] = 0.f; as[q] = 0.f; }
#pragma unroll 4
            for (int cp = 0; cp < 256; ++cp) { const float tc = tab[(c * cp) & 255], ts = tab[(c * cp + 192) & 255];
                const float* fr = fw + (size_t)(h * 256 + cp) * FD + n0;
#pragma unroll
                for (int q = 0; q < 8; ++q) { const float f = fr[q]; ac[q] += tc * f; as[q] += ts * f; } }
#pragma unroll
            for (int q = 0; q < 8; ++q) { gt[(size_t)(2 * (n0 + q)) * FD + h * 256 + c] = (bf16_t)f2bf(ac[q] * (1.0f / 16.0f)); gt[(size_t)(2 * (n0 + q) + 1) * FD + h * 256 + c] = (bf16_t)f2bf(as[q] * (1.0f / 16.0f)); }
        }
    }
    {   float* rot = (float*)(ws + WS_ROT);
        for (int i = gw * 64 + lane; i < LP * 16; i += NGW * 64) { const int pos = i >> 4, j = i & 15;
            const float invf = (float)pow(500000.0, -(double)(2 * j) / 32.0); const float ang = (float)pos * invf;
            rot[pos * 32 + j] = (float)cos((double)ang); rot[pos * 32 + 16 + j] = (float)sin((double)ang); }
        if (F.bx == 0 && F.wave == 0) {
            float a = F.in[10][lane] * F.in[11][lane] + F.in[10][lane + 64] * F.in[11][lane + 64];
            float b = F.in[12][lane] * F.in[13][lane] + F.in[12][lane + 64] * F.in[13][lane + 64];
            a = wave_sum(a); b = wave_sum(b);
            if (lane == 0) F.ctl[CW_LAM] = __builtin_bit_cast(unsigned, expf(a) - expf(b) + LAMBDA_INIT);
        }
    }
}

__device__ __forceinline__ void p_finalize_rstd(Frame& F) {
    const float* psum = (const float*)(F.ws + WS_PSUM); float* rstd = (float*)(F.ws + WS_RSTD);
    const int tid = tid_opaque(F.wave);
    for (int r = F.bx * NTHREADS + tid; r < M; r += F.G * NTHREADS) { const f32x4* p = (const f32x4*)(psum + (size_t)r * 64); float s = 0.f;
#pragma unroll
        for (int j = 0; j < 16; ++j) { const f32x4 v = p[j]; s += (v.x + v.y) + (v.z + v.w); }
        rstd[r] = 1.0f / sqrtf(s * (1.0f / D) + NORM_EPS); }
}

__device__ __forceinline__ f32x4 bf4lo(u32x4 w) { return (f32x4){bf2f(w.x & 0xffff), bf2f(w.x >> 16), bf2f(w.y & 0xffff), bf2f(w.y >> 16)}; }
__device__ __forceinline__ f32x4 bf4hi(u32x4 w) { return (f32x4){bf2f(w.z & 0xffff), bf2f(w.z >> 16), bf2f(w.w & 0xffff), bf2f(w.w >> 16)}; }
__device__ __forceinline__ void p_pool(Frame& F) {
    const bf16_t* u = (const bf16_t*)(F.ws + WS_U); bf16_t* pooled = (bf16_t*)(F.ws + WS_POOLED);
    const int gw = F.bx * NWAVES + F.wave, NGW = F.G * NWAVES, lane = tid_opaque(F.wave) & 63;
    for (int it = gw; it < (M / 32) * 6; it += NGW) {
        const int rc = it / 6, cb = it % 6, t0 = rc * 32, col = cb * 512 + lane * 8, h = 1 << (col / PG);
        const int s0 = (t0 < MP) ? 0 : MP + ((t0 - MP) / LS) * LS, s1 = (t0 < MP) ? MP : s0 + LS;
        const bf16_t* up = u + col;
        f32x4 sa = {0.f, 0.f, 0.f, 0.f}, sb = {0.f, 0.f, 0.f, 0.f};
#pragma unroll
        for (int d = -8; d < 8; ++d) { const int sidx = t0 + d; const bool ok = (d >= -h) && (d < h) && (sidx >= s0) && (sidx < s1); const int sc = sidx < s0 ? s0 : (sidx >= s1 ? s1 - 1 : sidx);
            const u32x4 w = *(const u32x4*)(up + (size_t)sc * D); const float mk = ok ? 1.0f : 0.0f; sa += bf4lo(w) * mk; sb += bf4hi(w) * mk; }
#pragma unroll 8
        for (int t = t0; t < t0 + 32; ++t) {
            const int a = (t - h > s0) ? t - h : s0, b = (t + h < s1) ? t + h : s1;
            const int ia = t + h, is = t - h; const float ma = (ia < s1) ? 1.0f : 0.0f, ms = (is >= s0) ? 1.0f : 0.0f;
            const u32x4 wt = *(const u32x4*)(up + (size_t)t * D), wa = *(const u32x4*)(up + (size_t)(ia < s1 ? ia : s1 - 1) * D), wsb = *(const u32x4*)(up + (size_t)(is >= s0 ? is : s0) * D);
            const float inv = 1.0f / (float)(b - a);
            const f32x4 oa = sa * inv - bf4lo(wt), ob = sb * inv - bf4hi(wt);
            u32x4 ow; ow.x = pk2(oa.x, oa.y); ow.y = pk2(oa.z, oa.w); ow.z = pk2(ob.x, ob.y); ow.w = pk2(ob.z, ob.w);
            *(u32x4*)(pooled + (size_t)t * POOL_DIM + col) = ow;
            sa += bf4lo(wa) * ma - bf4lo(wsb) * ms; sb += bf4hi(wa) * ma - bf4hi(wsb) * ms;
        }
    }
}

__device__ __forceinline__ void hr_decode(int hr, int& s, int& t, int& row0, int& L) { if (hr < HP) { s = 0; t = hr; row0 = 0; L = LP; } else { const int j = hr - HP; s = 1 + (j >> 10); t = j & (HS - 1); row0 = MP + (s - 1) * LS; L = LS; } }
__device__ __forceinline__ void bf8_to_f(u32x4 w, f32x4& lo, f32x4& hi) { lo = (f32x4){bf2f(w.x & 0xffff), bf2f(w.x >> 16), bf2f(w.y & 0xffff), bf2f(w.y >> 16)}; hi = (f32x4){bf2f(w.z & 0xffff), bf2f(w.z >> 16), bf2f(w.w & 0xffff), bf2f(w.w >> 16)}; }
__device__ __forceinline__ void p_fold(Frame& F) {
    const bf16_t* u = (const bf16_t*)(F.ws + WS_U); bf16_t* ufp = (bf16_t*)(F.ws + WS_UFP); bf16_t* ufm = (bf16_t*)(F.ws + WS_UFM);
    const int gw = F.bx * NWAVES + F.wave, NGW = F.G * NWAVES, lane = tid_opaque(F.wave) & 63;
    for (int hr = gw; hr < MH; hr += NGW) { int sq, t, row0, L; hr_decode(hr, sq, t, row0, L);
        const bf16_t* pa = u + (size_t)(row0 + t) * D + POOL_DIM + lane * 16; const bf16_t* pb = u + (size_t)(row0 + (t ? L - t : 0)) * D + POOL_DIM + lane * 16;
        const float mk = t ? 1.0f : 0.0f;
#pragma unroll
        for (int q = 0; q < 2; ++q) { f32x4 a0, a1, b0, b1; bf8_to_f(*(const u32x4*)(pa + 8 * q), a0, a1); bf8_to_f(*(const u32x4*)(pb + 8 * q), b0, b1);
            const f32x4 p0 = a0 + b0 * mk, p1 = a1 + b1 * mk, m0 = (a0 - b0) * mk, m1 = (a1 - b1) * mk;
            u32x4 wp, wm; wp.x = pk2(p0.x, p0.y); wp.y = pk2(p0.z, p0.w); wp.z = pk2(p1.x, p1.y); wp.w = pk2(p1.z, p1.w); wm.x = pk2(m0.x, m0.y); wm.y = pk2(m0.z, m0.w); wm.z = pk2(m1.x, m1.y); wm.w = pk2(m1.z, m1.w);
            *(u32x4*)(ufp + (size_t)hr * FD + lane * 16 + 8 * q) = wp; *(u32x4*)(ufm + (size_t)hr * FD + lane * 16 + 8 * q) = wm; }
    }
}
__device__ __forceinline__ void p_ych(Frame& F) {
    const bf16_t* u = (const bf16_t*)(F.ws + WS_U); const bf16_t* gt = (const bf16_t*)(F.ws + WS_GT); float* ych = (float*)(F.ws + WS_YCH);
    const int gw = F.bx * NWAVES + F.wave, NGW = F.G * NWAVES, lane = tid_opaque(F.wave) & 63;
    for (int it = gw; it < 9 * FD; it += NGW) { const int sq = it >> 10, cpp = it & (FD - 1); const int row = sq ? MP + (sq - 1) * LS + HS : HP;
        const bf16_t* g = gt + (size_t)(2 * cpp) * FD + lane * 16; const bf16_t* x = u + (size_t)row * D + POOL_DIM + lane * 16; float a = 0.f;
#pragma unroll
        for (int q = 0; q < 2; ++q) { f32x4 g0, g1, x0, x1; bf8_to_f(*(const u32x4*)(g + 8 * q), g0, g1); bf8_to_f(*(const u32x4*)(x + 8 * q), x0, x1);
            a += (g0.x * x0.x + g0.y * x0.y) + (g0.z * x0.z + g0.w * x0.w) + (g1.x * x1.x + g1.y * x1.y) + (g1.z * x1.z + g1.w * x1.w); }
        a = wave_sum(a); if (lane == 0) ych[it] = a; }
}
__device__ __forceinline__ void p_alt(Frame& F) {
    float* alt = (float*)(F.ws + WS_ALT);
    const int gw = F.bx * NWAVES + F.wave, NGW = F.G * NWAVES, lane = tid_opaque(F.wave) & 63;
    for (int it = gw; it < 9 * FD; it += NGW) { const int sq = it >> 10, cpp = it & (FD - 1); const int Hf = sq ? HS : HP;
        const bf16_t* y = sq ? (const bf16_t*)(F.ws + WS_YFS) + ((size_t)(sq - 1) * 2 * FD + cpp) * HS : (const bf16_t*)(F.ws + WS_YFP) + (size_t)cpp * HP;
        float a = 0.f;
        for (int ch = lane; ch < Hf / 8; ch += 64) { f32x4 v0, v1; bf8_to_f(*(const u32x4*)(y + 8 * ch), v0, v1); a += (v0.x - v0.y) + (v0.z - v0.w) + (v1.x - v1.y) + (v1.z - v1.w); }
        a = wave_sum(a); if (lane == 0) alt[it] = a; }
}
__device__ __forceinline__ void p_unfold(Frame& F) {
    const float* eb = (const float*)(F.ws + WS_EB); const float* ob = (const float*)(F.ws + WS_OB2); const float* ych = (const float*)(F.ws + WS_YCH); const float* alt = (const float*)(F.ws + WS_ALT);
    bf16_t* cat = (bf16_t*)(F.ws + WS_CAT);
    const int gw = F.bx * NWAVES + F.wave, NGW = F.G * NWAVES, lane = tid_opaque(F.wave) & 63;
    constexpr int NROWS = (HP + 1) + NSS * (HS + 1);
    for (int it = gw; it < NROWS; it += NGW) {
        int sq, k; if (it <= HP) { sq = 0; k = it; } else { const int j = it - (HP + 1); sq = 1 + j / (HS + 1); k = j % (HS + 1); }
        const int L = sq ? LS : LP, Hf = L / 2, row0 = sq ? MP + (sq - 1) * LS : 0, hrow0 = sq ? HP + (sq - 1) * HS : 0;
        const float nrm = 1.0f / sqrtf((float)L);
        const float* yc = ych + sq * FD + lane * 16;
        if (k == Hf) { const float* al = alt + sq * FD + lane * 16; bf16_t* o = cat + (size_t)(row0 + Hf) * D + POOL_DIM + lane * 16;
#pragma unroll
            for (int q = 0; q < 4; ++q) { const f32x4 v = (*(const f32x4*)(al + 4 * q) + *(const f32x4*)(yc + 4 * q)) * nrm; u32x2 w; w.x = pk2(v.x, v.y); w.y = pk2(v.z, v.w); *(u32x2*)(o + 4 * q) = w; }
        } else { const float sg = (k & 1) ? -nrm : nrm;
            const float* e = eb + (size_t)(hrow0 + k) * FD + lane * 16; const float* od = ob + (size_t)(hrow0 + k) * FD + lane * 16;
            bf16_t* o1 = cat + (size_t)(row0 + k) * D + POOL_DIM + lane * 16; bf16_t* o2 = cat + (size_t)(row0 + (k ? L - k : 0)) * D + POOL_DIM + lane * 16;
#pragma unroll
            for (int q = 0; q < 4; ++q) { const f32x4 ev = *(const f32x4*)(e + 4 * q) + *(const f32x4*)(yc + 4 * q) * sg, ov = *(const f32x4*)(od + 4 * q);
                const f32x4 f1 = ev - ov, f2 = ev + ov; u32x2 w; w.x = pk2(f1.x, f1.y); w.y = pk2(f1.z, f1.w); *(u32x2*)(o1 + 4 * q) = w;
                if (k) { u32x2 w2; w2.x = pk2(f2.x, f2.y); w2.y = pk2(f2.z, f2.w); *(u32x2*)(o2 + 4 * q) = w2; } }
        }
    }
}

__device__ __forceinline__ void p_fixup(Frame& F, const float* cw, const float* cb) {
    const float* halo = (const float*)(F.ws + WS_HALO); bf16_t* act = (bf16_t*)(F.ws + WS_ACT);
    constexpr int CH = DFF / 4;
    const int tid = tid_opaque(F.wave);
    for (int i = F.bx * NTHREADS + tid; i < (M / 128) * 2 * CH; i += F.G * NTHREADS) {
        const int ch = i % CH, be = i / CH, blk = be >> 1, e = be & 1, c = ch * 4;
        const int t = blk * 128 + (e ? 127 : 0);
        const int s0 = (t < MP) ? 0 : MP + ((t - MP) / LS) * LS, s1 = (t < MP) ? MP : s0 + LS;
        const float* hb = halo + (size_t)blk * 4 * NUP;
        f32x4 a4;
        f32x4 y[2];
#pragma unroll
        for (int bj = 0; bj < 2; ++bj) { const int cc = bj * DFF + c;
            f32x4 xl, xc, xr; const f32x4 z = {0.f, 0.f, 0.f, 0.f};
            if (e == 0) { xl = (t > s0) ? *(const f32x4*)(hb - (size_t)4 * NUP + 3 * NUP + cc) : z; xc = *(const f32x4*)(hb + cc); xr = *(const f32x4*)(hb + NUP + cc); }
            else { xl = *(const f32x4*)(hb + 2 * NUP + cc); xc = *(const f32x4*)(hb + 3 * NUP + cc); xr = (t + 1 < s1) ? *(const f32x4*)(hb + (size_t)4 * NUP + cc) : z; }
            y[bj] = xl * *(const f32x4*)(cw + cc) + xc * *(const f32x4*)(cw + NUP + cc) + xr * *(const f32x4*)(cw + 2 * NUP + cc) + *(const f32x4*)(cb + cc); }
#pragma unroll
        for (int q = 0; q < 4; ++q) { const float g = y[0][q]; a4[q] = g * __builtin_amdgcn_rcpf(1.0f + __expf(-g)) * y[1][q]; }
        u32x2 w; w.x = cvt_pk_bf16(a4[0], a4[1]); w.y = cvt_pk_bf16(a4[2], a4[3]);
        *(u32x2*)(act + (size_t)t * DFF + c) = w;
    }
}

__device__ __forceinline__ void p_combine(Frame& F) {
    const unsigned* oa0 = (const unsigned*)(F.ws + WS_OA); const unsigned* oa1 = oa0 + (size_t)(M / 2) * D; bf16_t* ob = (bf16_t*)(F.ws + WS_OB);
    const float lam = __builtin_bit_cast(float, __hip_atomic_load(F.ctl + CW_LAM, RLX_AGENT));
    const int gw = F.bx * NWAVES + F.wave, NGW = F.G * NWAVES, lane = tid_opaque(F.wave) & 63;
    for (int p = gw; p < M / 2; p += NGW) {
        const u32x4* a = (const u32x4*)(oa0 + (size_t)p * D) + lane; const u32x4* b = (const u32x4*)(oa1 + (size_t)p * D) + lane;
        u32x2* o0 = (u32x2*)(ob + (size_t)(2 * p) * D) + lane; u32x2* o1 = (u32x2*)(ob + (size_t)(2 * p + 1) * D) + lane;
#pragma unroll 8
        for (int h = 0; h < 16; ++h) { const u32x4 wa = a[64 * h], wb = b[64 * h];
            const f32x4 a0 = {bf2f(wa.x & 0xffff), bf2f(wa.y & 0xffff), bf2f(wa.z & 0xffff), bf2f(wa.w & 0xffff)}, a1 = {bf2f(wa.x >> 16), bf2f(wa.y >> 16), bf2f(wa.z >> 16), bf2f(wa.w >> 16)};
            const f32x4 b0 = {bf2f(wb.x & 0xffff), bf2f(wb.y & 0xffff), bf2f(wb.z & 0xffff), bf2f(wb.w & 0xffff)}, b1 = {bf2f(wb.x >> 16), bf2f(wb.y >> 16), bf2f(wb.z >> 16), bf2f(wb.w >> 16)};
            const f32x4 v0 = a0 - b0 * lam, v1 = a1 - b1 * lam;
            float s0 = (v0.x * v0.x + v0.y * v0.y) + (v0.z * v0.z + v0.w * v0.w), s1 = (v1.x * v1.x + v1.y * v1.y) + (v1.z * v1.z + v1.w * v1.w);
#pragma unroll
            for (int of = 1; of < 64; of <<= 1) { s0 += __shfl_xor(s0, of); s1 += __shfl_xor(s1, of); }
            const float r0 = 1.0f / sqrtf(s0 * (1.0f / 256.0f) + SUBLN_EPS), r1 = 1.0f / sqrtf(s1 * (1.0f / 256.0f) + SUBLN_EPS);
            u32x2 w0, w1; w0.x = pk2(v0.x * r0, v0.y * r0); w0.y = pk2(v0.z * r0, v0.w * r0); w1.x = pk2(v1.x * r1, v1.y * r1); w1.y = pk2(v1.z * r1, v1.w * r1);
            o0[64 * h] = w0; o1[64 * h] = w1; }
    }
}

__device__ __forceinline__ void p_final(Frame& F) {
    const float* psum = (const float*)(F.ws + WS_PSUM); const float* fn = F.in[21]; const bf16_t* xb = (const bf16_t*)(F.ws + WS_XB);
    const int gw = F.bx * NWAVES + F.wave, NGW = F.G * NWAVES, lane = tid_opaque(F.wave) & 63;
    for (int r = gw; r < M; r += NGW) {
        const float s = wave_sum(psum[(size_t)r * 64 + lane]); const float rs = 1.0f / sqrtf(s * (1.0f / D) + NORM_EPS);
        const u32x2* x = (const u32x2*)(xb + (size_t)r * D) + lane; f32x4* y = (f32x4*)(F.out + (size_t)r * D) + lane; const f32x4* g = (const f32x4*)fn + lane;
#pragma unroll 8
        for (int j = 0; j < 16; ++j) { const u32x2 w = x[64 * j]; const f32x4 v = {bf2f(w.x & 0xffff), bf2f(w.x >> 16), bf2f(w.y & 0xffff), bf2f(w.y >> 16)}; y[64 * j] = v * rs * g[64 * j]; }
    }
}

struct YFOrder {
    const char* gt; const char* ufp; const char* ufm; char* yfp; char* yfs; int G, c;
    __device__ __forceinline__ bool next(int i, pg::GUnit& un) const {
        const int id = i * G + c; if (id >= 384) return false;
        int part, pm, pn, Hf, hrow0; char* Cb;
        if (id < 128) { part = id >> 6; const int r = id & 63; pm = r & 3; pn = r >> 2; Hf = HP; hrow0 = 0; Cb = yfp + (size_t)part * FD * HP * 2; }
        else { const int j = id - 128, sq = j >> 5, r = j & 31; part = r >> 4; pm = r & 3; pn = (r >> 2) & 3; Hf = HS; hrow0 = HP + sq * HS; Cb = yfs + (size_t)(sq * 2 + part) * FD * HS * 2; }
        un.A = gt + (size_t)part * (FD * 2) + (size_t)pm * 256 * (2 * FD * 2); un.lda = 2 * FD * 2; un.B = (part ? ufm : ufp) + (size_t)(hrow0 + pn * 256) * (FD * 2); un.ldb = FD * 2; un.nt = FD / 64;
        un.C = Cb + ((size_t)pm * 256 * Hf + (size_t)pn * 256) * 2; un.ldc = (unsigned)Hf; un.grow0 = 0; un.gcol0 = 0; un.aux = 0;
        return true;
    }
};
struct EOOrder {
    const char* dftp; const char* dfts; const char* yfp; const char* yfs; char* eb; char* ob; const char* pooled; const char* poolt; char* cat; int G, c;
    __device__ __forceinline__ void eo_unit(int sq, int which, int pm, int pn, pg::GUnit& un) const {
        const int Hf = sq ? HS : HP, hrow0 = sq ? HP + (sq - 1) * HS : 0;
        un.A = (sq ? dfts : dftp) + ((size_t)which * Hf + (size_t)pm * 256) * ((size_t)Hf * 2); un.lda = (unsigned)Hf * 2u;
        un.B = (sq ? yfs + (size_t)((sq - 1) * 2 + which) * FD * HS * 2 : yfp + (size_t)which * FD * HP * 2) + (size_t)pn * 256 * ((size_t)Hf * 2); un.ldb = (unsigned)Hf * 2u; un.nt = Hf / 64;
        un.C = (which ? ob : eb) + ((size_t)(hrow0 + pm * 256) * FD + pn * 256) * 4; un.ldc = FD; un.grow0 = 0; un.gcol0 = 0; un.aux = 1;
    }
    __device__ __forceinline__ void pool_unit(int id, pg::GUnit& un) const {
        const int g = id / 288, r = id % 288, pm = r / 3, pn = r % 3;
        un.A = pooled + ((size_t)pm * 256 * POOL_DIM + g * PG) * 2; un.lda = POOL_DIM * 2; un.B = poolt + ((size_t)g * PG * PG + (size_t)pn * 256 * PG) * 2; un.ldb = PG * 2; un.nt = PG / 64;
        un.C = cat + ((size_t)pm * 256 * D + g * PG + pn * 256) * 2; un.ldc = D; un.grow0 = pm * 256; un.gcol0 = g * PG + pn * 256; un.aux = 0;
    }
    __device__ __forceinline__ bool next(int i, pg::GUnit& un) const {
        if (G == 256) {
            if (c < 128) { if (i == 0) { eo_unit(0, c >> 6, (c & 63) >> 2, c & 3, un); return true; } if (i < 4) { pool_unit(3 * c + (i - 1), un); return true; } return false; }
            const int j = c - 128;
            if (i < 2) { const int id = 2 * j + i, r = id & 31; eo_unit(1 + (id >> 5), r >> 4, (r >> 2) & 3, r & 3, un); return true; }
            if (i < 8) { pool_unit(384 + 6 * j + (i - 2), un); return true; }
            return false;
        }
        const int id = i * G + c;
        if (id < 128) { eo_unit(0, id >> 6, (id & 63) >> 2, id & 3, un); return true; }
        if (id < 384) { const int k = id - 128, r = k & 31; eo_unit(1 + (k >> 5), r >> 4, (r >> 2) & 3, r & 3, un); return true; }
        if (id < 384 + 1152) { pool_unit(id - 384, un); return true; }
        return false;
    }
};

struct Args { const float* in[22]; float* out; unsigned char* ws; int ph_lo, ph_hi; };
constexpr int N_PHASES = 32;

__global__ void __launch_bounds__(NTHREADS, 2) mk_fwd(Args args) {
    extern __shared__ __attribute__((aligned(16))) unsigned char lds[];
    Frame F;
    F.lds = (LAS unsigned char*)lds; F.MISC = (volatile LAS unsigned*)(F.lds + MISC_OFF);
    F.wave = __builtin_amdgcn_readfirstlane((int)threadIdx.x >> 6);
    F.G = gridDim.x; F.bx = blockIdx.x;
#pragma unroll
    for (int i = 0; i < 22; ++i) F.in[i] = args.in[i];
    F.out = args.out; F.ws = args.ws; F.ctl = (unsigned*)(args.ws + WS_CTL);
    unsigned char* ws = args.ws;
    for (int u = threadIdx.x; u < (LDS_BYTES - LDSCTL_OFF) / 4; u += NTHREADS) ((LAS unsigned*)(F.lds + LDSCTL_OFF))[u] = 0u;
    __syncthreads();
    XcdBarrier bar; bar.bar = F.ctl + CW_BAR; bar.x = 0; bar.st = nullptr;
    if (MK_N_LAUNCHES == 1) bar = xcd_barrier_post(F.ctl + CW_BAR, F.MISC + 8);
    const int lo = args.ph_lo, hi = args.ph_hi;
#define IN(k) (lo <= (k) && (k) < hi)
    unsigned long long pr_t0 = 0, pr_span = 0;
#ifndef PROBE_CYC
#define PROBE_CYC 0
#endif
#define PB(k) do { if (PROBE_PH == (k)) pr_t0 = PROBE_CYC ? __builtin_amdgcn_s_memtime() : __builtin_amdgcn_s_memrealtime(); } while (0)
#define PE(k) do { if (PROBE_PH == (k)) pr_span += (PROBE_CYC ? __builtin_amdgcn_s_memtime() / 1 : __builtin_amdgcn_s_memrealtime()) - pr_t0; } while (0)
#define SEAMX(k, kn) do { if (IN(k) && IN(kn)) { if (PROBE_PH == 100 || PROBE_PH == 100 + (k)) pr_t0 = __builtin_amdgcn_s_memrealtime(); xcd_barrier(bar); if (PROBE_PH == 100 || PROBE_PH == 100 + (k)) pr_span += __builtin_amdgcn_s_memrealtime() - pr_t0; } } while (0)
#define SEAM(k) SEAMX(k, (k) + 1)
    LAS unsigned char* ring = F.lds + RING_OFF;
    const int G = F.G, c = F.bx;
    float* rstd = (float*)(ws + WS_RSTD); float* psum = (float*)(ws + WS_PSUM); bf16_t* xb = (bf16_t*)(ws + WS_XB);

    PB(0);
    if (IN(0)) p_prologue(F);
    PE(0);
    SEAM(0);
    PB(1);
    if (IN(1)) { pg::DenseOrder S{(const char*)xb, (const char*)(ws + WS_WIN), (char*)(ws + WS_U), D * 2, D * 2, D, 2, M / 256, D / 256, D / 64, G, c, 4};
        pg::EpiBf16 E{rstd}; pg::gemm_phase<pg::EpiBf16, pg::DenseOrder, true, true>(ring, S, E, F.wave, pr_span); }
    PE(1);
    SEAM(1);
    PB(2);
    if (IN(2)) { p_pool(F); p_fold(F); p_ych(F); }
    PE(2);
    SEAMX(2, 3);
    PB(3);
    if (IN(3)) { YFOrder S{(const char*)(ws + WS_GT), (const char*)(ws + WS_UFP), (const char*)(ws + WS_UFM), (char*)(ws + WS_YFP), (char*)(ws + WS_YFS), G, c};
        pg::EpiBf16 E{nullptr}; pg::gemm_phase<pg::EpiBf16, YFOrder, true, true>(ring, S, E, F.wave, pr_span); }
    PE(3);
    SEAMX(3, 19);
    PB(19);
    if (IN(19)) { p_alt(F);
        EOOrder S{(const char*)(ws + WS_DFTP), (const char*)(ws + WS_DFTS), (const char*)(ws + WS_YFP), (const char*)(ws + WS_YFS), (char*)(ws + WS_EB), (char*)(ws + WS_OB2), (const char*)(ws + WS_POOLED), (const char*)(ws + WS_POOLT), (char*)(ws + WS_CAT), G, c};
        pg::EpiMix E{}; pg::gemm_phase<pg::EpiMix, EOOrder, true, true>(ring, S, E, F.wave, pr_span); }
    PE(19);
    SEAMX(19, 20);
    PB(20);
    if (IN(20)) p_unfold(F);
    PE(20);
    SEAMX(20, 4);
    PB(4);
    if (IN(4)) { pg::DenseOrder S{(const char*)(ws + WS_CAT), (const char*)(ws + WS_WOE), nullptr, D * 2, D * 2, D, 4, M / 256, D / 256, D / 64, G, c, 4};
        pg::EpiResid E{xb, psum}; pg::gemm_phase<pg::EpiResid, pg::DenseOrder, true, true>(ring, S, E, F.wave, pr_span); }
    PE(4);
    SEAM(4);
    PB(5);
    if (IN(5)) p_finalize_rstd(F);
    PE(5);
    SEAM(5);
    PB(6);
    if (IN(6)) { pg::DynOrder S{{(const char*)xb, (const char*)(ws + WS_WUP), nullptr, D * 2, D * 2, 0, 0, M / 256, NUP / 256, D / 64, G, c, 4}, F.ctl + CW_DYN + 1024, F.MISC + 16, F.wave, 1, 1};
        pg::EpiFfnUp E{(bf16_t*)(ws + WS_ACT), (float*)(ws + WS_HALO), rstd, F.in[18], F.in[19]}; pg::gemm_phase<pg::EpiFfnUp, pg::DynOrder, true, true>(ring, S, E, F.wave, pr_span);
        p_wdn_filler(F, 0, F.ctl + CW_DYN + 64 * 2); }
    PE(6);
    SEAM(6);
    PB(7);
    if (IN(7)) p_fixup(F, F.in[18], F.in[19]);
    PE(7);
    SEAM(7);
    PB(8);
    if (IN(8)) { pg::DenseOrder S{(const char*)(ws + WS_ACT), (const char*)(ws + WS_WDN), nullptr, DFF * 2, DFF * 2, D, 4, M / 256, D / 256, DFF / 64, G, c, 4};
        pg::EpiResid E{xb, psum}; pg::gemm_phase<pg::EpiResid, pg::DenseOrder, true, true>(ring, S, E, F.wave, pr_span); }
    PE(8);
    SEAM(8);
    PB(9);
    if (IN(9)) p_finalize_rstd(F);
    PE(9);
    SEAM(9);
    PB(10);
    if (IN(10)) { pg::DenseOrder S{(const char*)xb, (const char*)(ws + WS_WQKV), (char*)(ws + WS_QKV), D * 2, D * 2, NQKV, 2, M / 256, NQKV / 256, D / 64, G, c, 4};
        pg::EpiQkv E{rstd, (const float*)(ws + WS_ROT)}; pg::gemm_phase<pg::EpiQkv, pg::DenseOrder, true, true>(ring, S, E, F.wave, pr_span); }
    PE(10);
    SEAM(10);
    PB(11);
    if (IN(11)) {
        const bf16_t* qkv = (const bf16_t*)(ws + WS_QKV); bf16_t* oa = (bf16_t*)(ws + WS_OA);
        const int nun = 1024 + 2048;
        for (int i = 0;; ++i) {
            int id;
            if (G == 256) { const int x = c & 7, j = c >> 3;
                if (i < 4) id = (4 * x + i) * 32 + j;
                else if (i < 10) { const int p = 32 * x + 4 * (i - 4) + (j >> 3); id = 1024 + p * 8 + (j & 7); }
                else {
                    if (threadIdx.x == 0) F.MISC[20] = __hip_atomic_fetch_add(F.ctl + CW_DYN + 64 * 8, 1u, __ATOMIC_RELAXED, __HIP_MEMORY_SCOPE_AGENT);
                    __syncthreads();
                    const unsigned t = (unsigned)__builtin_amdgcn_readfirstlane((int)F.MISC[20]);
                    __syncthreads();
                    if (t >= 512u) break;
                    const int p = 32 * (int)(t >> 6) + 24 + (int)((t & 63u) >> 3); id = 1024 + p * 8 + (int)(t & 7u);
                }
            } else { id = i * G + c; if (id >= nun) break; }
            int row0, L, hm, qb;
            if (id < 1024) { hm = id >> 5; qb = id & 31; row0 = 0; L = LP; }
            else { const int k = id - 1024, p = k >> 3; qb = k & 7; hm = p & 31; row0 = MP + (p >> 5) * LS; L = LS; }
            const int h = hm >> 1, m = hm & 1;
            const bf16_t* Qb = qkv + (size_t)(row0 + qb * 256) * NQKV + h * 256 + m * 128;
            const bf16_t* Kh = qkv + (size_t)row0 * NQKV + D + h * 256 + m * 128;
            const bf16_t* Vh = qkv + (size_t)row0 * NQKV + 2 * D + h * 256;
            bf16_t* Ob = oa + (size_t)m * M * D + (size_t)(row0 + qb * 256) * D + 2 * (h * 256);
            at::attn256_body(Qb, Kh, Vh, Ob, L, (char*)lds + RING_OFF, F.wave);
        }
    }
    PE(11);
    SEAM(11);
    PB(12);
    if (IN(12)) p_combine(F);
    PE(12);
    SEAM(12);
    PB(13);
    if (IN(13)) { pg::DenseOrder S{(const char*)(ws + WS_OB), (const char*)(ws + WS_WOO), nullptr, D * 2, D * 2, D, 4, M / 256, D / 256, D / 64, G, c, 4};
        pg::EpiResid E{xb, psum}; pg::gemm_phase<pg::EpiResid, pg::DenseOrder, true, true>(ring, S, E, F.wave, pr_span); }
    PE(13);
    SEAM(13);
    PB(14);
    if (IN(14)) p_finalize_rstd(F);
    PE(14);
    SEAM(14);
    PB(15);
    if (IN(15)) { pg::DynOrder S{{(const char*)xb, (const char*)(ws + WS_WUP + (size_t)NUP * D * 2), nullptr, D * 2, D * 2, 0, 0, M / 256, NUP / 256, D / 64, G, c, 4}, F.ctl + CW_DYN + 2048, F.MISC + 18, F.wave, 1, 1};
        pg::EpiFfnUp E{(bf16_t*)(ws + WS_ACT), (float*)(ws + WS_HALO), rstd, F.in[18] + 3 * NUP, F.in[19] + NUP}; pg::gemm_phase<pg::EpiFfnUp, pg::DynOrder, true, true>(ring, S, E, F.wave, pr_span);
        p_wdn_filler(F, 1, F.ctl + CW_DYN + 64 * 3); }
    PE(15);
    SEAM(15);
    PB(16);
    if (IN(16)) p_fixup(F, F.in[18] + 3 * NUP, F.in[19] + NUP);
    PE(16);
    SEAM(16);
    PB(17);
    if (IN(17)) { pg::DenseOrder S{(const char*)(ws + WS_ACT), (const char*)(ws + WS_WDN + (size_t)D * DFF * 2), nullptr, DFF * 2, DFF * 2, D, 4, M / 256, D / 256, DFF / 64, G, c, 4};
        pg::EpiResid E{xb, psum}; pg::gemm_phase<pg::EpiResid, pg::DenseOrder, true, true>(ring, S, E, F.wave, pr_span); }
    PE(17);
    SEAM(17);
    PB(18);
    if (IN(18)) p_final(F);
    PE(18);
    if (PROBE_PH >= 0) { const unsigned long long te = __builtin_amdgcn_s_memrealtime(); while (__builtin_amdgcn_s_memrealtime() - te < (PROBE_CYC ? pr_span / 24 : pr_span)) __builtin_amdgcn_s_sleep(16); }
#undef PB
#undef PE
#undef IN
#undef SEAM
#undef SEAMX
}

extern "C" void kernel_launch(void* const* d_in, const int* in_sizes, int n_in, void* d_out, int out_size, void* d_ws, size_t ws_size, hipStream_t stream) {
    static int grid = 0;
    if (grid == 0) {
        if (n_in != 22 || out_size != M * D || ws_size < WS_END) { fprintf(stderr, "kernel_launch: unexpected shapes: n_in %d out %d ws %zu (need %zu)\n", n_in, out_size, ws_size, (size_t)WS_END); grid = -1; return; }
        int dev = 0, cus = 0, per_cu = 0;
        if (hipGetDevice(&dev) != hipSuccess || hipDeviceGetAttribute(&cus, hipDeviceAttributeMultiprocessorCount, dev) != hipSuccess) { grid = -1; return; }
        if (hipFuncSetAttribute((const void*)mk_fwd, hipFuncAttributeMaxDynamicSharedMemorySize, LDS_BYTES) != hipSuccess) { fprintf(stderr, "kernel_launch: hipFuncSetAttribute failed\n"); grid = -1; return; }
        if (hipOccupancyMaxActiveBlocksPerMultiprocessor(&per_cu, (const void*)mk_fwd, NTHREADS, LDS_BYTES) != hipSuccess || per_cu < 1)
            fprintf(stderr, "kernel_launch: note: occupancy query reports %d workgroups per CU\n", per_cu);
        (void)hipGetLastError();
        grid = cus;
    }
    if (grid < 0) return;
    if (hipMemsetAsync((char*)d_ws + WS_CTL, 0, CTL_ZERO_BYTES, stream) != hipSuccess) { fprintf(stderr, "kernel_launch: memset failed\n"); return; }
    Args a{};
    for (int i = 0; i < 22; ++i) a.in[i] = (const float*)d_in[i];
    a.out = (float*)d_out; a.ws = (unsigned char*)d_ws;
#if MK_N_LAUNCHES == 1
    a.ph_lo = 0; a.ph_hi = N_PHASES;
    hipLaunchKernelGGL(mk_fwd, dim3(grid), dim3(NTHREADS), LDS_BYTES, stream, a);
#else
    { static const int order[21] = {0, 1, 2, 3, 19, 20, 4, 5, 6, 7, 8, 9, 10, 11, 12, 13, 14, 15, 16, 17, 18};
      for (int p = 0; p < 21; ++p) { a.ph_lo = order[p]; a.ph_hi = order[p] + 1; hipLaunchKernelGGL(mk_fwd, dim3(grid), dim3(NTHREADS), LDS_BYTES, stream, a); } }
#endif
    const hipError_t le = hipPeekAtLastError();
    if (le != hipSuccess) fprintf(stderr, "kernel_launch: launch failed: %s\n", hipGetErrorName(le));
}
```

```cpp
#include <hip/hip_runtime.h>
#include <cstdio>
#include <cstdint>

#ifndef MK_N_LAUNCHES
#define MK_N_LAUNCHES 1
#endif

#ifndef PROBE_PH
#define PROBE_PH -1
#endif
#define GAS __attribute__((address_space(1)))
#define LAS __attribute__((address_space(3)))
typedef unsigned short bf16_t;
typedef short bf16x8 __attribute__((ext_vector_type(8)));
typedef short s16x4 __attribute__((ext_vector_type(4)));
typedef float f32x4 __attribute__((ext_vector_type(4)));
typedef float f32x2 __attribute__((ext_vector_type(2)));
typedef float f32x16 __attribute__((ext_vector_type(16)));
typedef unsigned u32x4 __attribute__((ext_vector_type(4)));
typedef unsigned u32x2 __attribute__((ext_vector_type(2)));
typedef GAS unsigned gu32;
#define RLX_AGENT __ATOMIC_RELAXED, __HIP_MEMORY_SCOPE_AGENT
#define LDS_WAIT() asm volatile("s_waitcnt lgkmcnt(0)" ::: "memory")
#define VM_WAIT() asm volatile("s_waitcnt vmcnt(0)" ::: "memory")

constexpr int D = 4096, LP = 8192, NSS = 8, LS = 2048, MP = LP, M = LP + NSS * LS;
constexpr int POOL_DIM = 3072, PG = 768, FD = 1024, FH = 256;
constexpr int DFF = 11008, NUP = 2 * DFF, NQKV = 3 * D;
constexpr float NORM_EPS = 1e-6f, SUBLN_EPS = 1e-5f;
constexpr float LAMBDA_INIT = 0.35550906759096327f;
constexpr int NWAVES = 8, NTHREADS = 512;

constexpr size_t MiB = 1u << 20;
constexpr size_t al256(size_t x) { return (x + 255) / 256 * 256; }
constexpr size_t WS_CTL = 0, CTL_ZERO_BYTES = 65536;
constexpr size_t WS_ROT = WS_CTL + CTL_ZERO_BYTES;
constexpr size_t WS_RSTD = WS_ROT + (size_t)LP * 32 * 4;
constexpr size_t WS_PSUM = WS_RSTD + al256((size_t)M * 4);
constexpr size_t WS_WIN = WS_PSUM + (size_t)M * 64 * 4;
constexpr size_t WS_GT = WS_WIN + (size_t)D * D * 2;
constexpr size_t WS_POOLT = WS_GT + (size_t)2048 * 1024 * 2;
constexpr size_t WS_WOE = WS_POOLT + (size_t)4 * PG * PG * 2;
constexpr size_t WS_WQKV = WS_WOE + (size_t)D * D * 2;
constexpr size_t WS_WOO = WS_WQKV + (size_t)NQKV * D * 2;
constexpr size_t WS_WUP = WS_WOO + (size_t)D * D * 2;
constexpr size_t WS_WDN = WS_WUP + (size_t)2 * NUP * D * 2;
constexpr int HP = LP / 2, HS = LS / 2, MH = M / 2;
constexpr size_t WS_DFTP = WS_WDN + (size_t)2 * D * DFF * 2;
constexpr size_t WS_DFTS = WS_DFTP + (size_t)2 * HP * HP * 2;
constexpr size_t WS_XB = WS_DFTS + (size_t)2 * HS * HS * 2;
constexpr size_t WS_OV = WS_XB + (size_t)M * D * 2;
constexpr size_t WS_U = WS_OV;
constexpr size_t WS_POOLED = WS_U + (size_t)M * D * 2;
constexpr size_t WS_CAT = WS_POOLED + (size_t)M * POOL_DIM * 2;
constexpr size_t WS_UFP = WS_CAT + (size_t)M * D * 2;
constexpr size_t WS_UFM = WS_UFP + (size_t)MH * FD * 2;
constexpr size_t WS_YFP = WS_UFM + (size_t)MH * FD * 2;
constexpr size_t WS_YFS = WS_YFP + (size_t)2 * FD * HP * 2;
constexpr size_t WS_EB = WS_YFS + (size_t)NSS * 2 * FD * HS * 2;
constexpr size_t WS_OB2 = WS_EB + (size_t)MH * FD * 4;
constexpr size_t WS_YCH = WS_OB2 + (size_t)MH * FD * 4;
constexpr size_t WS_ALT = WS_YCH + (size_t)9 * FD * 4;
constexpr size_t WS_OV_END0 = WS_ALT + (size_t)9 * FD * 4;
constexpr size_t WS_ACT = WS_OV;
constexpr size_t WS_HALO = WS_ACT + (size_t)M * DFF * 2;
constexpr size_t WS_OV_END1 = WS_HALO + (size_t)(M / 128) * 4 * NUP * 4;
constexpr size_t WS_QKV = WS_OV;
constexpr size_t WS_OA = WS_QKV + (size_t)M * NQKV * 2;
constexpr size_t WS_OV_END2 = WS_OA + (size_t)2 * M * D * 2;
constexpr size_t WS_OB = WS_QKV;
constexpr size_t WS_END = WS_OV_END2 > WS_OV_END1 ? (WS_OV_END2 > WS_OV_END0 ? WS_OV_END2 : WS_OV_END0) : (WS_OV_END1 > WS_OV_END0 ? WS_OV_END1 : WS_OV_END0);
static_assert(WS_END <= (size_t)4 * 2 * D * NUP * 4, "workspace must fit 4 x the largest input tensor");

constexpr int CW_TMO = 0, CW_LAM = 64  , CW_BAR = 4096, CW_DYN = 8192  ;

constexpr int RING_OFF = 0, RING_BYTES = 131072;
constexpr int LDS_BYTES = 147456;
constexpr int LDSCTL_OFF = LDS_BYTES - 1024, MISC_OFF = LDSCTL_OFF + 320;

__device__ __forceinline__ unsigned f2bf(float f) { unsigned u = __builtin_bit_cast(unsigned, f); return (u + 0x7fffu + ((u >> 16) & 1u)) >> 16; }
__device__ __forceinline__ unsigned pk2(float lo, float hi) { return f2bf(lo) | (f2bf(hi) << 16); }
__device__ __forceinline__ unsigned cvt_pk_bf16(float lo, float hi) { unsigned r; asm volatile("v_cvt_pk_bf16_f32 %0, %1, %2" : "=v"(r) : "v"(lo), "v"(hi)); return r; }
__device__ __forceinline__ float bf2f(unsigned short b) { return __builtin_bit_cast(float, (unsigned)b << 16); }
__device__ __forceinline__ int tid_opaque(int wave) { int l; asm volatile("v_mbcnt_lo_u32_b32 %0, -1, 0\n\tv_mbcnt_hi_u32_b32 %0, -1, %0" : "=v"(l)); return wave * 64 + l; }
__device__ __forceinline__ float wave_sum(float v) {
#pragma unroll
    for (int o = 1; o < 64; o <<= 1) v += __shfl_xor(v, o);
    return v;
}

#define XB_TMO      128
#define XB_XCNT(j)  (256  + 64 * (j))
#define XB_XSUB(j)  (1280 + 64 * (j))
#define XB_XGEN(j)  (2304 + 64 * (j))
#define XB_TOP      3328
#define XB_TOPGEN   3392
#define XCD_BAR_WORDS 3456
#define XB_SPIN_CAP (1u << 18)
__device__ __forceinline__ unsigned xb_ld(unsigned* p)              { return __hip_atomic_load(p, __ATOMIC_RELAXED, __HIP_MEMORY_SCOPE_AGENT); }
__device__ __forceinline__ unsigned xb_add(unsigned* p, unsigned v) { return __hip_atomic_fetch_add(p, v, __ATOMIC_RELAXED, __HIP_MEMORY_SCOPE_AGENT); }
__device__ __forceinline__ unsigned xb_xcc_id() { return (unsigned)__builtin_amdgcn_s_getreg((3 << 11) | 20) & 0xFu; }
#define XB_SPIN(cond, bar) do { unsigned _sp = 0; while (cond) { __builtin_amdgcn_s_sleep(1); \
    if ((++_sp & 255u) == 0u) { if (xb_ld(&(bar)[XB_TMO])) break; if (_sp > XB_SPIN_CAP) { atomicAdd(&(bar)[XB_TMO], 1u); break; } } } } while (0)
struct XcdBarrier { unsigned* bar; unsigned x; volatile LAS unsigned* st; };
__device__ __forceinline__ XcdBarrier xcd_barrier_post(unsigned* bar, volatile LAS unsigned* st) {
    XcdBarrier b; b.bar = bar; b.x = xb_xcc_id(); b.st = st;
    if (threadIdx.x == 0) (void)xb_add(&bar[XB_XCNT(b.x)], 1u);
    return b;
}
__device__ __forceinline__ void xcd_barrier_complete(unsigned* bar, unsigned x, unsigned& nloc, unsigned& nx) {
    const unsigned G = gridDim.x * gridDim.y * gridDim.z;
    unsigned sum, cnt, mine, sp = 0u;
    for (;;) {
        sum = 0u; cnt = 0u; mine = 0u;
#pragma unroll
        for (unsigned j = 0; j < 16; ++j) { const unsigned c = xb_ld(&bar[XB_XCNT(j)]); sum += c; cnt += (c > 0u) ? 1u : 0u; mine = (j == x) ? c : mine; }
        if (sum == G) break;
        __builtin_amdgcn_s_sleep(1);
        if ((++sp & 255u) == 0u) { if (xb_ld(&bar[XB_TMO])) break; if (sp > XB_SPIN_CAP) { atomicAdd(&bar[XB_TMO], 1u); break; } }
    }
    nloc = mine > 0u ? mine : 1u; nx = cnt > 0u ? cnt : 1u;
}
__device__ __forceinline__ void xcd_barrier(const XcdBarrier& b) {
    asm volatile("s_waitcnt vmcnt(0)" ::: "memory");
    __syncthreads();
    if (threadIdx.x == 0) {
        unsigned* bar = b.bar;
        __builtin_amdgcn_s_waitcnt(0);
        unsigned nloc = b.st[0], nx = b.st[1];
        if (nloc == 0u) { xcd_barrier_complete(bar, b.x, nloc, nx); b.st[0] = nloc; b.st[1] = nx; }
        const unsigned old = xb_add(&bar[XB_XSUB(b.x)], 1u);
        const unsigned gen = old / nloc;
        if (old + 1u == (gen + 1u) * nloc) {
            __builtin_amdgcn_fence(__ATOMIC_RELEASE, "agent");
            asm volatile("s_waitcnt vmcnt(0)" ::: "memory");
            const unsigned og = xb_add(&bar[XB_TOP], 1u);
            const unsigned tg = og / nx;
            if (og + 1u == (tg + 1u) * nx) xb_add(&bar[XB_TOPGEN], 1u);
            else XB_SPIN(xb_ld(&bar[XB_TOPGEN]) == tg, bar);
            __builtin_amdgcn_fence(__ATOMIC_ACQUIRE, "agent");
            xb_add(&bar[XB_XGEN(b.x)], 1u);
            asm volatile("s_waitcnt vmcnt(0)" ::: "memory");
        } else {
            XB_SPIN(xb_ld(&bar[XB_XGEN(b.x)]) == gen, bar);
            __builtin_amdgcn_fence(__ATOMIC_ACQUIRE, "agent");
            asm volatile("s_waitcnt vmcnt(0)" ::: "memory");
        }
    }
    __syncthreads();
}

namespace pg {
constexpr int BM = 256, BK = 64, HALF = 128, HTB = HALF * BK * 2, STAGE_BYTES = 8 * HTB;
__host__ __device__ __forceinline__ int lds_byte(int r, int c) { const int st = (r >> 4) * 2 + (c >> 5), rr = r & 15, cc = c & 31, ob = rr * 64 + cc * 2; return st * 1024 + (ob ^ (((ob >> 9) & 1) << 5)); }
__host__ __device__ __forceinline__ void stage_rc(int b, int& R, int& C) { const int st = b / 1024, sb = b % 1024, swz = sb ^ (((sb >> 9) & 1) << 5); R = (st >> 1) * 16 + swz / 64; C = (st & 1) * 32 + (swz % 64) / 2; }
__host__ __device__ __forceinline__ int perm32(int rho) { const int n = rho >> 4, i = rho & 15; return 8 * (i >> 2) + 4 * n + (i & 3); }
__host__ __device__ __forceinline__ int rowperm(int rho) { return (rho >> 6) * 128 + (rho & 15) * 8 + ((rho >> 4) & 3); }

struct GUnit {
    const char* A; const char* B;
    unsigned lda, ldb;
    int nt;
    char* C; unsigned ldc;
    int grow0, gcol0;
    int aux;
};

struct EpiBf16 {
    static constexpr bool PERM = true, ROWPERM = false, PREFETCH = false;
    const float* rstd;
    __device__ __forceinline__ void operator()(f32x4 (&acc)[2][2][4][2], const GUnit& u, int wr, int wc, int fr, int fq) const {
        bf16_t* base = (bf16_t*)u.C + wc * 32 + 8 * fq;
#pragma unroll
        for (int ai = 0; ai < 2; ++ai)
#pragma unroll
            for (int m = 0; m < 4; ++m) {
                const int r = ai * HALF + wr * 64 + m * 16 + fr;
                const float s = rstd ? rstd[u.grow0 + r] : 1.0f;
                bf16_t* rowp = base + (size_t)r * u.ldc;
#pragma unroll
                for (int bj = 0; bj < 2; ++bj) { const f32x4 v0 = acc[ai][bj][m][0] * s, v1 = acc[ai][bj][m][1] * s;
                    u32x4 w; w.x = cvt_pk_bf16(v0[0], v0[1]); w.y = cvt_pk_bf16(v0[2], v0[3]); w.z = cvt_pk_bf16(v1[0], v1[1]); w.w = cvt_pk_bf16(v1[2], v1[3]);
                    *(u32x4*)(rowp + bj * HALF) = w; }
            }
    }
};
struct EpiMix {
    static constexpr bool PERM = true, ROWPERM = false, PREFETCH = false;
    __device__ __forceinline__ void operator()(f32x4 (&acc)[2][2][4][2], const GUnit& u, int wr, int wc, int fr, int fq) const {
        if (u.aux == 0) {
            bf16_t* base = (bf16_t*)u.C + wc * 32 + 8 * fq;
#pragma unroll
            for (int ai = 0; ai < 2; ++ai)
#pragma unroll
                for (int m = 0; m < 4; ++m) { bf16_t* rowp = base + (size_t)(ai * HALF + wr * 64 + m * 16 + fr) * u.ldc;
#pragma unroll
                    for (int bj = 0; bj < 2; ++bj) { const f32x4 v0 = acc[ai][bj][m][0], v1 = acc[ai][bj][m][1];
                        u32x4 w; w.x = cvt_pk_bf16(v0[0], v0[1]); w.y = cvt_pk_bf16(v0[2], v0[3]); w.z = cvt_pk_bf16(v1[0], v1[1]); w.w = cvt_pk_bf16(v1[2], v1[3]);
                        *(u32x4*)(rowp + bj * HALF) = w; } }
        } else {
            float* base = (float*)u.C + wc * 32 + 8 * fq;
#pragma unroll
            for (int ai = 0; ai < 2; ++ai)
#pragma unroll
                for (int m = 0; m < 4; ++m) { float* rowp = base + (size_t)(ai * HALF + wr * 64 + m * 16 + fr) * u.ldc;
#pragma unroll
                    for (int bj = 0; bj < 2; ++bj) { *(f32x4*)(rowp + bj * HALF) = acc[ai][bj][m][0]; *(f32x4*)(rowp + bj * HALF + 4) = acc[ai][bj][m][1]; } }
        }
    }
};
struct EpiResid {
    static constexpr bool PERM = true, ROWPERM = false, PREFETCH = false;
    bf16_t* xb; float* psum;
    __device__ __forceinline__ void operator()(f32x4 (&acc)[2][2][4][2], const GUnit& u, int wr, int wc, int fr, int fq) const {
        const int c0 = u.gcol0 + wc * 32 + 8 * fq;
        bf16_t* base = xb + (size_t)u.grow0 * D + c0;
#pragma unroll
        for (int ai = 0; ai < 2; ++ai) {
            u32x4 old[4][2];
#pragma unroll
            for (int m = 0; m < 4; ++m)
#pragma unroll
                for (int bj = 0; bj < 2; ++bj) old[m][bj] = *(const u32x4*)(base + (size_t)(ai * HALF + wr * 64 + m * 16 + fr) * D + bj * HALF);
#pragma unroll
            for (int m = 0; m < 4; ++m) {
                const int r = ai * HALF + wr * 64 + m * 16 + fr;
                float ss = 0.f;
#pragma unroll
                for (int bj = 0; bj < 2; ++bj) {
                    const u32x4 w0 = old[m][bj];
                    const f32x4 o0 = {bf2f(w0.x & 0xffff), bf2f(w0.x >> 16), bf2f(w0.y & 0xffff), bf2f(w0.y >> 16)}, o1 = {bf2f(w0.z & 0xffff), bf2f(w0.z >> 16), bf2f(w0.w & 0xffff), bf2f(w0.w >> 16)};
                    const f32x4 v0 = acc[ai][bj][m][0] + o0, v1 = acc[ai][bj][m][1] + o1;
                    u32x4 w; w.x = cvt_pk_bf16(v0[0], v0[1]); w.y = cvt_pk_bf16(v0[2], v0[3]); w.z = cvt_pk_bf16(v1[0], v1[1]); w.w = cvt_pk_bf16(v1[2], v1[3]);
                    *(u32x4*)(base + (size_t)r * D + bj * HALF) = w;
                    ss += (v0[0] * v0[0] + v0[1] * v0[1]) + (v0[2] * v0[2] + v0[3] * v0[3]) + (v1[0] * v1[0] + v1[1] * v1[1]) + (v1[2] * v1[2] + v1[3] * v1[3]);
                }
                ss += __shfl_xor(ss, 16); ss += __shfl_xor(ss, 32);
                if (fq == 0) psum[(size_t)(u.grow0 + r) * 64 + (u.gcol0 >> 8) * 4 + wc] = ss;
            }
            asm volatile("" ::: "memory");
        }
    }
};
struct EpiFfnUp {
    static constexpr bool PERM = true, ROWPERM = true, PREFETCH = true;
    bf16_t* act; float* halo; const float* rstd; const float* cw; const float* cb;
    static constexpr int PAR_BYTES = 5120;
    __device__ __forceinline__ void prefetch(const GUnit& u, LAS unsigned char* par, int wid, int lane) const {
        {
            const int t = wid * 64 + lane, row = t >> 1, h = t & 1;
            const f32x4* p = (const f32x4*)(rstd + (size_t)(u.grow0 + row) * 64 + h * 32); float s = 0.f;
#pragma unroll
            for (int j = 0; j < 8; ++j) { const f32x4 v = p[j]; s += (v.x + v.y) + (v.z + v.w); }
            s += __shfl_xor(s, 1);
            if (h == 0) ((LAS float*)par)[row] = 1.0f / sqrtf(s * (1.0f / D) + NORM_EPS);
        }
        if (wid >= 1 && wid < 5) { const int a = 2 * (wid - 1) + (lane >> 5), cg = (u.gcol0 >> 1) + (lane & 31) * 4;
            const float* src = ((a & 3) == 3 ? cb : cw + (size_t)(a & 3) * NUP) + (a >> 2) * DFF + cg;
            __builtin_amdgcn_global_load_lds((const unsigned*)src, (LAS unsigned*)(par + 1024 + (wid - 1) * 1024), 16, 0, 0); }
    }
    __device__ __forceinline__ void operator()(f32x4 (&acc)[2][2][4][2], const GUnit& u, int wr, int wc, int fr, int fq, const LAS unsigned char* par) const {
        const int t0 = u.grow0 + wr * 128 + fr * 8;
        const int c0 = (u.gcol0 >> 1) + wc * 32 + 8 * fq;
        const int cl = wc * 32 + 8 * fq;
        {   const LAS f32x4* rp = (const LAS f32x4*)(par + (wr * 128 + fr * 8) * 4); const f32x4 ra = rp[0], rb = rp[1];
#pragma unroll
            for (int bj = 0; bj < 2; ++bj)
#pragma unroll
                for (int n = 0; n < 2; ++n) {
#pragma unroll
                    for (int m = 0; m < 4; ++m) { acc[0][bj][m][n] *= ra[m]; acc[1][bj][m][n] *= rb[m]; } } }
        const int blk = (u.grow0 >> 7) + wr;
        if (fr == 0 || fr == 15) {
            float* hp = halo + (size_t)blk * 4 * NUP + (fr == 0 ? 0 : 2 * NUP);
#pragma unroll
            for (int bj = 0; bj < 2; ++bj)
#pragma unroll
                for (int n = 0; n < 2; ++n) {
                    const f32x4 e0 = (fr == 0) ? acc[0][bj][0][n] : acc[1][bj][2][n];
                    const f32x4 e1 = (fr == 0) ? acc[0][bj][1][n] : acc[1][bj][3][n];
                    *(f32x4*)(hp + bj * DFF + c0 + 4 * n) = e0; *(f32x4*)(hp + NUP + bj * DFF + c0 + 4 * n) = e1; }
        }
        unsigned pk[8][4];
#pragma unroll
        for (int n = 0; n < 2; ++n) {
            const LAS f32x4* wp = (const LAS f32x4*)(par + 1024 + (cl + 4 * n) * 4);
            const f32x4 g0 = wp[0], g1 = wp[32], g2 = wp[64], gb = wp[96], u0 = wp[128], u1 = wp[160], u2 = wp[192], ub = wp[224];
            f32x4 gm1, gp8, um1, up8;
#pragma unroll
            for (int q = 0; q < 4; ++q) { gm1[q] = __shfl_up(acc[1][0][3][n][q], 1, 16); gp8[q] = __shfl_down(acc[0][0][0][n][q], 1, 16);
                                          um1[q] = __shfl_up(acc[1][1][3][n][q], 1, 16); up8[q] = __shfl_down(acc[0][1][0][n][q], 1, 16); }
#pragma unroll
            for (int j = 0; j < 8; ++j) {
                const f32x4 gl = (j == 0) ? gm1 : acc[(j + 7) >> 2 & 1][0][(j + 7) & 3][n], gc = acc[j >> 2][0][j & 3][n], gr = (j == 7) ? gp8 : acc[((j + 1) >> 2) & 1][0][(j + 1) & 3][n];
                const f32x4 ul = (j == 0) ? um1 : acc[(j + 7) >> 2 & 1][1][(j + 7) & 3][n], uc = acc[j >> 2][1][j & 3][n], ur = (j == 7) ? up8 : acc[((j + 1) >> 2) & 1][1][(j + 1) & 3][n];
                const f32x4 yg = __builtin_elementwise_fma(gr, g2, __builtin_elementwise_fma(gc, g1, __builtin_elementwise_fma(gl, g0, gb)));
                const f32x4 yu = __builtin_elementwise_fma(ur, u2, __builtin_elementwise_fma(uc, u1, __builtin_elementwise_fma(ul, u0, ub)));
                const f32x4 e = yg * (-1.4426950408889634f);
                f32x4 a;
#pragma unroll
                for (int q = 0; q < 4; ++q) a[q] = __builtin_amdgcn_rcpf(1.0f + __builtin_amdgcn_exp2f(e[q]));
                a = a * yg * yu;
                pk[j][2 * n] = cvt_pk_bf16(a[0], a[1]); pk[j][2 * n + 1] = cvt_pk_bf16(a[2], a[3]);
            }
        }
#pragma unroll
        for (int j = 0; j < 8; ++j) {
            const bool edge = (j == 0 && fr == 0) || (j == 7 && fr == 15);
            if (!edge) { u32x4 w; w.x = pk[j][0]; w.y = pk[j][1]; w.z = pk[j][2]; w.w = pk[j][3]; *(u32x4*)(act + (size_t)(t0 + j) * DFF + c0) = w; }
        }
    }
};
struct EpiQkv {
    static constexpr bool PERM = true, ROWPERM = false, PREFETCH = false;
    const float* rstd; const float* rot;
    __device__ __forceinline__ void operator()(f32x4 (&acc)[2][2][4][2], const GUnit& u, int wr, int wc, int fr, int fq) const {
        bf16_t* base = (bf16_t*)u.C + wc * 32 + 8 * fq;
        const bool rotary = (u.gcol0 < 2 * D) && (wc == 0);
#pragma unroll
        for (int ai = 0; ai < 2; ++ai)
#pragma unroll
            for (int m = 0; m < 4; ++m) {
                const int r = ai * HALF + wr * 64 + m * 16 + fr, gr = u.grow0 + r;
                const float s = rstd[gr];
                f32x4 v[2][2];
#pragma unroll
                for (int bj = 0; bj < 2; ++bj)
#pragma unroll
                    for (int n = 0; n < 2; ++n) v[bj][n] = acc[ai][bj][m][n] * s;
                if (rotary) {
                    const int pos = (gr < MP) ? gr : (gr & (LS - 1));
                    const float* rp = rot + (size_t)pos * 32 + 8 * (fq & 1);
                    const float sgn = (fq < 2) ? -1.0f : 1.0f;
#pragma unroll
                    for (int n = 0; n < 2; ++n) { const f32x4 cs = *(const f32x4*)(rp + 4 * n), sn = *(const f32x4*)(rp + 16 + 4 * n);
#pragma unroll
                        for (int bj = 0; bj < 2; ++bj) { f32x4 p;
#pragma unroll
                            for (int q = 0; q < 4; ++q) p[q] = __shfl_xor(v[bj][n][q], 32);
                            v[bj][n] = v[bj][n] * cs + p * (sn * sgn); } }
                }
                bf16_t* rowp = base + (size_t)r * u.ldc;
#pragma unroll
                for (int bj = 0; bj < 2; ++bj) { u32x4 w; w.x = cvt_pk_bf16(v[bj][0][0], v[bj][0][1]); w.y = cvt_pk_bf16(v[bj][0][2], v[bj][0][3]); w.z = cvt_pk_bf16(v[bj][1][0], v[bj][1][1]); w.w = cvt_pk_bf16(v[bj][1][2], v[bj][1][3]);
                    *(u32x4*)(rowp + bj * HALF) = w; }
            }
    }
};

template <class Epi, class Sched, bool ALIGN_EPI, bool SP2>
__device__ __forceinline__ void gemm_phase(LAS unsigned char* lds, const Sched& S, const Epi& E, const int wid, unsigned long long& epi_ticks) {
    const int tid = tid_opaque(wid), lane = tid & 63, wr = wid >> 2, wc = wid & 3, fr = lane & 15, fq = lane >> 4;
    unsigned RA[2], RB[2], C2[2];
#pragma unroll
    for (int i = 0; i < 2; ++i) { int R, C; stage_rc(tid * 16 + i * 8192, R, C);
        RA[i] = (unsigned)(Epi::ROWPERM ? rowperm(R) : R); RB[i] = (unsigned)(Epi::PERM ? ((R & ~31) + perm32(R & 31)) : R); C2[i] = (unsigned)C * 2u; }
    constexpr unsigned HROWS_A = Epi::ROWPERM ? 4u : 128u;
    const size_t kstep = (size_t)(BK * 2);
    const unsigned ldsw = (unsigned)wid * 1024u;
    const int aoff = lds_byte(wr * 64 + fr, fq * 8), boff = lds_byte(wc * 32 + fr, fq * 8);
#define PG_SA(b, h) (((b) * 2 + (h)) * HTB)
#define PG_SB(b, h) ((4 + (b) * 2 + (h)) * HTB)
#define PG_STAGE(bufoff, gbase, R, ld) do { _Pragma("unroll") for (int _i = 0; _i < 2; ++_i) \
        __builtin_amdgcn_global_load_lds((const unsigned*)((gbase) + (size_t)((R)[_i] * (ld) + C2[_i])), (LAS unsigned*)(lds + (bufoff) + ldsw + _i * 8192), 16, 0, 0); } while (0)
#define PG_LDA(dst, b, h) do { _Pragma("unroll") for (int m = 0; m < 4; ++m) _Pragma("unroll") for (int k = 0; k < 2; ++k) dst[m][k] = *(const LAS bf16x8*)(lds + PG_SA(b, h) + aoff + m * 2048 + k * 1024); } while (0)
#define PG_LDB(dst, b, h) do { _Pragma("unroll") for (int n = 0; n < 2; ++n) _Pragma("unroll") for (int k = 0; k < 2; ++k) dst[n][k] = *(const LAS bf16x8*)(lds + PG_SB(b, h) + boff + n * 2048 + k * 1024); } while (0)
#define PG_MMA(ai, bj, At, Bt) do { __builtin_amdgcn_s_setprio(1); _Pragma("unroll") for (int m = 0; m < 4; ++m) _Pragma("unroll") for (int n = 0; n < 2; ++n) _Pragma("unroll") for (int k = 0; k < 2; ++k) \
        acc[ai][bj][m][n] = __builtin_amdgcn_mfma_f32_16x16x32_bf16(Bt[n][k], At[m][k], acc[ai][bj][m][n], 0, 0, 0); __builtin_amdgcn_s_setprio(0); } while (0)
#define PG_WAIT_V(n) asm volatile("s_waitcnt vmcnt(" #n ")" ::: "memory")
#define PG_WAIT_L(n) asm volatile("s_waitcnt lgkmcnt(" #n ")" ::: "memory")
#define PG_BAR __builtin_amdgcn_s_barrier()
#define PG_SCHED __builtin_amdgcn_sched_barrier(0)
    GUnit cur, nxt; int ui = 0;
    if (!S.next(0, cur)) return;
    f32x4 acc[2][2][4][2];
#pragma unroll
    for (int a = 0; a < 2; ++a)
#pragma unroll
        for (int b = 0; b < 2; ++b)
#pragma unroll
            for (int m = 0; m < 4; ++m)
#pragma unroll
                for (int n = 0; n < 2; ++n) acc[a][b][m][n] = (f32x4){0.f, 0.f, 0.f, 0.f};
    bf16x8 At[4][2], B0[2][2], B1[2][2];
    const char* cA = cur.A; const char* cB = cur.B; unsigned lda = cur.lda, ldb = cur.ldb; int nt = cur.nt;
    LAS unsigned char* const par = lds + STAGE_BYTES;
    if constexpr (Epi::PREFETCH) E.prefetch(cur, par, wid, lane);
    {   const size_t hA = (size_t)HROWS_A * lda, hB = (size_t)128 * ldb;
        if constexpr (SP2) {
            PG_STAGE(PG_SB(0, 0), cB, RB, ldb); PG_STAGE(PG_SB(0, 1), cB + hB, RB, ldb); PG_STAGE(PG_SA(0, 0), cA, RA, lda); PG_STAGE(PG_SA(0, 1), cA + hA, RA, lda);
            if (wr == 1) PG_BAR;
            PG_WAIT_V(2); PG_BAR;
            PG_STAGE(PG_SB(1, 0), cB + kstep, RB, ldb); PG_STAGE(PG_SA(1, 0), cA + kstep, RA, lda); PG_STAGE(PG_SB(1, 1), cB + hB + kstep, RB, ldb);
            PG_WAIT_V(6); PG_BAR;
        } else {
            PG_STAGE(PG_SB(0, 0), cB, RB, ldb); PG_STAGE(PG_SA(0, 0), cA, RA, lda); PG_STAGE(PG_SB(0, 1), cB + hB, RB, ldb); PG_STAGE(PG_SA(0, 1), cA + hA, RA, lda);
            if (wr == 1) PG_BAR;
            PG_WAIT_V(4); PG_BAR;
            PG_STAGE(PG_SB(1, 0), cB + kstep, RB, ldb); PG_STAGE(PG_SA(1, 0), cA + kstep, RA, lda); PG_STAGE(PG_SB(1, 1), cB + hB + kstep, RB, ldb);
            PG_WAIT_V(6); PG_BAR;
        }
    }
    for (;;) {
        const bool has_next = S.next(ui + 1, nxt);
        const char* nA = has_next ? nxt.A : cA; const char* nB = has_next ? nxt.B : cB;
        const unsigned nlda = has_next ? nxt.lda : lda, nldb = has_next ? nxt.ldb : ldb;
        const size_t hA = (size_t)HROWS_A * lda, hB = (size_t)128 * ldb;
        for (int t = 0; t < nt; t += 2) {
            const bool last = (t == nt - 2);
            const char* a1 = cA + (size_t)(t + 1) * kstep;
            const char* a2 = last ? nA : cA + (size_t)(t + 2) * kstep; const char* b2 = last ? nB : cB + (size_t)(t + 2) * kstep;
            const unsigned lda2 = last ? nlda : lda, ldb2 = last ? nldb : ldb;
            const size_t hA2 = (size_t)HROWS_A * lda2, hB2 = (size_t)128 * ldb2;
            const char* a3 = a2 + kstep; const char* b3 = b2 + kstep;
            if constexpr (SP2) {
            PG_LDB(B0, 0, 0); PG_LDB(B1, 0, 1); PG_SCHED; PG_LDA(At, 0, 0); PG_STAGE(PG_SA(1, 1), a1 + hA, RA, lda);
            PG_WAIT_V(8); PG_WAIT_L(0); PG_BAR; PG_MMA(0, 0, At, B0); PG_MMA(0, 1, At, B1); PG_BAR; PG_SCHED;
            PG_LDA(At, 0, 1); PG_STAGE(PG_SB(0, 0), b2, RB, ldb2); PG_STAGE(PG_SB(0, 1), b2 + hB2, RB, ldb2); PG_STAGE(PG_SA(0, 0), a2, RA, lda2);
            PG_WAIT_V(8); PG_WAIT_L(0); PG_BAR; PG_MMA(1, 0, At, B0); PG_MMA(1, 1, At, B1); PG_BAR; PG_SCHED;
            PG_LDB(B0, 1, 0); PG_LDB(B1, 1, 1); PG_SCHED; PG_LDA(At, 1, 0); PG_STAGE(PG_SA(0, 1), a2 + hA2, RA, lda2);
            PG_WAIT_V(8); PG_WAIT_L(0); PG_BAR; PG_MMA(0, 0, At, B0); PG_MMA(0, 1, At, B1); PG_BAR; PG_SCHED;
            PG_LDA(At, 1, 1); PG_STAGE(PG_SB(1, 0), b3, RB, ldb2); PG_STAGE(PG_SB(1, 1), b3 + hB2, RB, ldb2); PG_STAGE(PG_SA(1, 0), a3, RA, lda2);
            PG_WAIT_V(8); PG_WAIT_L(0); PG_BAR; PG_MMA(1, 0, At, B0); PG_MMA(1, 1, At, B1); PG_BAR; PG_SCHED;
            } else {
            PG_LDB(B0, 0, 0); PG_SCHED; PG_LDA(At, 0, 0); PG_STAGE(PG_SA(1, 1), a1 + hA, RA, lda);
            PG_WAIT_L(8); PG_BAR; PG_WAIT_L(0); PG_MMA(0, 0, At, B0); PG_BAR; PG_SCHED;
            PG_LDB(B1, 0, 1); PG_STAGE(PG_SB(0, 0), b2, RB, ldb2);
            PG_BAR; PG_WAIT_L(0); PG_MMA(0, 1, At, B1); PG_BAR;
            PG_LDA(At, 0, 1); PG_STAGE(PG_SA(0, 0), a2, RA, lda2);
            PG_BAR; PG_WAIT_L(0); PG_MMA(1, 0, At, B0); PG_BAR; PG_SCHED;
            PG_STAGE(PG_SB(0, 1), b2 + hB2, RB, ldb2);
            PG_WAIT_V(6); PG_BAR; PG_MMA(1, 1, At, B1); PG_BAR;
            PG_LDB(B0, 1, 0); PG_SCHED; PG_LDA(At, 1, 0); PG_STAGE(PG_SA(0, 1), a2 + hA2, RA, lda2);
            PG_WAIT_L(8); PG_BAR; PG_WAIT_L(0); PG_MMA(0, 0, At, B0); PG_BAR; PG_SCHED;
            PG_LDB(B1, 1, 1); PG_STAGE(PG_SB(1, 0), b3, RB, ldb2);
            PG_BAR; PG_WAIT_L(0); PG_MMA(0, 1, At, B1); PG_BAR;
            PG_LDA(At, 1, 1); PG_STAGE(PG_SA(1, 0), a3, RA, lda2);
            PG_BAR; PG_WAIT_L(0); PG_MMA(1, 0, At, B0); PG_BAR; PG_SCHED;
            PG_STAGE(PG_SB(1, 1), b3 + hB2, RB, ldb2);
            PG_WAIT_V(6); PG_BAR; PG_MMA(1, 1, At, B1); PG_BAR;
            }
        }
        if constexpr (ALIGN_EPI) { if (wr == 0) PG_BAR; }
        if constexpr (Epi::PREFETCH) { E(acc, cur, wr, wc, fr, fq, par + (ui & 1) * Epi::PAR_BYTES); if (has_next) E.prefetch(nxt, par + ((ui + 1) & 1) * Epi::PAR_BYTES, wid, lane); }
        else E(acc, cur, wr, wc, fr, fq);
        if (!has_next) break;
#pragma unroll
        for (int a = 0; a < 2; ++a)
#pragma unroll
            for (int b = 0; b < 2; ++b)
#pragma unroll
                for (int m = 0; m < 4; ++m)
#pragma unroll
                    for (int n = 0; n < 2; ++n) acc[a][b][m][n] = (f32x4){0.f, 0.f, 0.f, 0.f};
        cur = nxt; cA = nA; cB = nB; lda = nlda; ldb = nldb; nt = cur.nt; ++ui;
        if constexpr (ALIGN_EPI) { if (wr == 1) PG_BAR; }
    }
    PG_WAIT_V(0);
    if constexpr (!ALIGN_EPI) { if (wr == 0) PG_BAR; }
    PG_BAR;
#undef PG_SA
#undef PG_SB
#undef PG_STAGE
#undef PG_LDA
#undef PG_LDB
#undef PG_MMA
#undef PG_WAIT_V
#undef PG_WAIT_L
#undef PG_BAR
#undef PG_SCHED
}

struct DenseOrder {
    const char* A; const char* B; char* C; unsigned lda, ldb, ldc; int csz; int nM, nN, nt, G, c; int gs = 8;
    __device__ __forceinline__ bool next(int i, GUnit& u) const {
        const int nwg = nM * nN; const long L = (long)i * G + c; if (L >= nwg) return false;
        int wgid = (int)L; { const int q = nwg / 8, r = nwg % 8, xcd = wgid % 8, off = wgid / 8; wgid = (xcd < r ? xcd * (q + 1) : r * (q + 1) + (xcd - r) * q) + off; }
        const int nig = gs * nN, gid = wgid / nig, fm = gid * gs, gsz = (nM - fm) < gs ? (nM - fm) : gs;
        const int pm = fm + ((wgid % nig) % gsz), pn = (wgid % nig) / gsz;
        u.A = A + (size_t)pm * 256 * lda; u.B = B + (size_t)pn * 256 * ldb; u.lda = lda; u.ldb = ldb; u.nt = nt;
        u.C = C + ((size_t)pm * 256 * ldc + (size_t)pn * 256) * csz; u.ldc = ldc; u.grow0 = pm * 256; u.gcol0 = pn * 256; u.aux = 0;
        return true;
    }
};
struct DynOrder : DenseOrder {
    unsigned* ctr; volatile LAS unsigned* slot; int wave; int dynr;
    __device__ __forceinline__ bool next(int i, GUnit& u) const {
        const int nwg = nM * nN, sr = nwg / G - dynr, left = nwg - sr * G;
        if (i + 1 >= sr && wave == 0) {
            unsigned t = 0u; if (threadIdx.x == 0) t = __hip_atomic_fetch_add(ctr, 1u, __ATOMIC_RELAXED, __HIP_MEMORY_SCOPE_AGENT);
            t = (unsigned)__builtin_amdgcn_readfirstlane((int)t);
            if (threadIdx.x == 0) slot[(i + 1) & 1] = t;
        }
        long L;
        if (i < sr) L = (long)i * G + c;
        else { const unsigned t = (unsigned)__builtin_amdgcn_readfirstlane((int)slot[i & 1]); if (t >= (unsigned)left) return false; L = (long)sr * G + t; }
        int wgid = (int)L; { const int q = nwg / 8, r = nwg % 8, xcd = wgid % 8, off = wgid / 8; wgid = (xcd < r ? xcd * (q + 1) : r * (q + 1) + (xcd - r) * q) + off; }
        const int nig = gs * nN, gid = wgid / nig, fm = gid * gs, gsz = (nM - fm) < gs ? (nM - fm) : gs;
        const int pm = fm + ((wgid % nig) % gsz), pn = (wgid % nig) / gsz;
        u.A = A + (size_t)pm * 256 * lda; u.B = B + (size_t)pn * 256 * ldb; u.lda = lda; u.ldb = ldb; u.nt = nt;
        u.C = C + ((size_t)pm * 256 * ldc + (size_t)pn * 256) * csz; u.ldc = ldc; u.grow0 = pm * 256; u.gcol0 = pn * 256; u.aux = 0;
        return true;
    }
};
}

namespace at {
constexpr int DH = 128, NW = 8, QBLK = 32, KVBLK = 64;
constexpr float SCALE = 0.088388347648318440f;
constexpr float THR = 8.f;
constexpr int LDQ = NQKV, LDK = NQKV, LDO = D;
constexpr size_t SHM_V = KVBLK * DH * 2, SHM_K = KVBLK * DH * 2, SHM_ATTN = 2 * SHM_V + 2 * SHM_K + NW * 64 * 4;
#define KSWZ(row, colB) ((row) * 256 + ((colB) ^ (((row) & 7) << 4)))
#define SBAR() __builtin_amdgcn_sched_barrier(0)
__device__ __forceinline__ int crow(int r, int hi) { return (r & 3) + 8 * (r >> 2) + 4 * hi; }
__device__ __forceinline__ unsigned cvtpk(float lo, float hi) { unsigned r; asm volatile("v_cvt_pk_bf16_f32 %0, %1, %2" : "=v"(r) : "v"(lo), "v"(hi)); return r; }
__device__ __forceinline__ void partialSM(f32x16& p0, f32x16& p1, float& m_reg, float& mn, float& alpha) {
  constexpr float C = SCALE * 1.4426950408889634f;
  float pmax = p0[0]; for (int r = 1; r < 16; ++r) pmax = fmaxf(pmax, p0[r]); for (int r = 0; r < 16; ++r) pmax = fmaxf(pmax, p1[r]);
  { auto rr = __builtin_amdgcn_permlane32_swap(__float_as_uint(pmax), __float_as_uint(pmax), false, false);
    pmax = fmaxf(__uint_as_float(rr[0]), __uint_as_float(rr[1])); }
  if (__builtin_expect(__all(pmax - m_reg <= THR / SCALE), 1)) { mn = m_reg; alpha = 1.f; }
  else { mn = fmaxf(m_reg, pmax); alpha = __builtin_amdgcn_exp2f((m_reg - mn) * C); m_reg = mn; }
  float mnC = -mn * C;
  for (int r = 0; r < 16; ++r) p0[r] = fmaf(p0[r], C, mnC); for (int r = 0; r < 16; ++r) p1[r] = fmaf(p1[r], C, mnC);
  for (int r = 0; r < 16; ++r) p0[r] = __builtin_amdgcn_exp2f(p0[r]);
}
__device__ __forceinline__ void finishSM(f32x16& p0, f32x16& p1, float alpha, float& l_reg, bf16x8& pa0, bf16x8& pa1, bf16x8& pa2, bf16x8& pa3) {
  for (int r = 0; r < 16; ++r) p1[r] = __builtin_amdgcn_exp2f(p1[r]);
  float ps = 0; for (int r = 0; r < 16; ++r) ps += p0[r]; for (int r = 0; r < 16; ++r) ps += p1[r];
  { auto rr = __builtin_amdgcn_permlane32_swap(__float_as_uint(ps), __float_as_uint(ps), false, false);
    ps = __uint_as_float(rr[0]) + __uint_as_float(rr[1]); }
  l_reg = l_reg * alpha + ps;
#define PK4(P, BASE, OUT) do { unsigned a0 = cvtpk(P[BASE + 0], P[BASE + 1]), a1 = cvtpk(P[BASE + 2], P[BASE + 3]);   \
    unsigned b0 = cvtpk(P[BASE + 4], P[BASE + 5]), b1 = cvtpk(P[BASE + 6], P[BASE + 7]);                              \
    auto r0 = __builtin_amdgcn_permlane32_swap(a0, b0, false, false); auto r1 = __builtin_amdgcn_permlane32_swap(a1, b1, false, false); \
    u32x4 w = {r0[0], r1[0], r0[1], r1[1]}; OUT = *reinterpret_cast<bf16x8*>(&w); } while (0)
  PK4(p0, 0, pa0); PK4(p0, 8, pa1); PK4(p1, 0, pa2); PK4(p1, 8, pa3);
#undef PK4
}
__device__ __forceinline__ void qkt(f32x16& p0, f32x16& p1, const bf16_t* Ks, const bf16x8* qr, int r32, int hi) {
  p0 = f32x16{}; p1 = f32x16{};
  for (int d0 = 0; d0 < 8; ++d0) { int cb = (d0 * 16 + hi * 8) * 2;
    bf16x8 b0 = *reinterpret_cast<const bf16x8*>((const char*)Ks + KSWZ(r32, cb));
    bf16x8 b1 = *reinterpret_cast<const bf16x8*>((const char*)Ks + KSWZ(32 + r32, cb));
    p0 = __builtin_amdgcn_mfma_f32_32x32x16_bf16(b0, qr[d0], p0, 0, 0, 0);
    p1 = __builtin_amdgcn_mfma_f32_32x32x16_bf16(b1, qr[d0], p1, 0, 0, 0); }
}
__device__ __forceinline__ void qkt_pipe(f32x16& p0, f32x16& p1, int kbase, const bf16x8* qr) {
  bf16x8 kb[3][2];
#define KRD(slot, d0) do { const int _a = kbase ^ ((d0) << 5); asm volatile("ds_read_b128 %0, %1" : "=&v"(kb[slot][0]) : "v"(_a) : "memory"); \
    asm volatile("ds_read_b128 %0, %1 offset:8192" : "=&v"(kb[slot][1]) : "v"(_a) : "memory"); } while (0)
#define KW(n) do { asm volatile("s_waitcnt lgkmcnt(" #n ")" ::: "memory"); SBAR(); } while (0)
#define KMM(slot, d0, c0, c1) do { p0 = __builtin_amdgcn_mfma_f32_32x32x16_bf16(kb[slot][0], qr[d0], c0, 0, 0, 0); p1 = __builtin_amdgcn_mfma_f32_32x32x16_bf16(kb[slot][1], qr[d0], c1, 0, 0, 0); SBAR(); } while (0)
  const f32x16 z = f32x16{};
  KRD(0, 0); KRD(1, 1); KRD(2, 2);
  __builtin_amdgcn_s_setprio(3);
  KW(4); KMM(0, 0, z, z); KRD(0, 3);
  KW(4); KMM(1, 1, p0, p1); KRD(1, 4);
  KW(4); KMM(2, 2, p0, p1); KRD(2, 5);
  KW(4); KMM(0, 3, p0, p1); KRD(0, 6);
  KW(4); KMM(1, 4, p0, p1); KRD(1, 7);
  KW(4); KMM(2, 5, p0, p1);
  KW(2); KMM(0, 6, p0, p1);
  KW(0); KMM(1, 7, p0, p1);
  __builtin_amdgcn_s_setprio(0);
#undef KRD
#undef KW
#undef KMM
}
__device__ __forceinline__ int v_st(int k, int c) { const int kk = (k & ~0xC) | ((k & 4) << 1) | ((k & 8) >> 1); return ((kk >> 3) * 4 + (c >> 5)) * 512 + ((kk & 7) * 32 + (c & 31)) * 2; }
__device__ __forceinline__ int v_rd_base(int lane) { return ((lane & 3) << 3) | (((lane >> 2) & 3) << 6) | (((lane >> 4) & 1) << 5) | (((lane >> 5) & 1) << 8); }
constexpr int v_rd_off(int d0, int ks, int half) { return d0 * 512 + ks * 4096 + half * 2048; }
template <int OFF> __device__ __forceinline__ s16x4 tr_read(int vb) {
  s16x4 r; asm volatile("ds_read_b64_tr_b16 %0, %1 offset:%2" : "=&v"(r) : "v"(vb), "i"(OFF) : "memory"); return r;
}
template <int D0> __device__ __forceinline__ void pv_one(f32x16& od, int vb, bf16x8 pa0, bf16x8 pa1, bf16x8 pa2, bf16x8 pa3) {
  const s16x4 l0 = tr_read<v_rd_off(D0, 0, 0)>(vb), h0 = tr_read<v_rd_off(D0, 0, 1)>(vb), l1 = tr_read<v_rd_off(D0, 1, 0)>(vb), h1 = tr_read<v_rd_off(D0, 1, 1)>(vb);
  const s16x4 l2 = tr_read<v_rd_off(D0, 2, 0)>(vb), h2 = tr_read<v_rd_off(D0, 2, 1)>(vb), l3 = tr_read<v_rd_off(D0, 3, 0)>(vb), h3 = tr_read<v_rd_off(D0, 3, 1)>(vb);
  asm volatile("s_waitcnt lgkmcnt(0)" ::: "memory"); SBAR();
#define PK(L, H) (bf16x8){L[0], L[1], L[2], L[3], H[0], H[1], H[2], H[3]}
  od = __builtin_amdgcn_mfma_f32_32x32x16_bf16(pa0, PK(l0, h0), od, 0, 0, 0);
  od = __builtin_amdgcn_mfma_f32_32x32x16_bf16(pa1, PK(l1, h1), od, 0, 0, 0);
  od = __builtin_amdgcn_mfma_f32_32x32x16_bf16(pa2, PK(l2, h2), od, 0, 0, 0);
  od = __builtin_amdgcn_mfma_f32_32x32x16_bf16(pa3, PK(l3, h3), od, 0, 0, 0);
#undef PK
}
__device__ __forceinline__ void pv_d0(f32x16* o, int vb, bf16x8 pa0, bf16x8 pa1, bf16x8 pa2, bf16x8 pa3) {
  pv_one<0>(o[0], vb, pa0, pa1, pa2, pa3); pv_one<1>(o[1], vb, pa0, pa1, pa2, pa3); pv_one<2>(o[2], vb, pa0, pa1, pa2, pa3); pv_one<3>(o[3], vb, pa0, pa1, pa2, pa3);
}
#define TRD(dst, D, vb) do { const int _b = (vb) + ((D) >> 2) * 16384; \
    dst[0] = tr_read<v_rd_off((D) & 3, 0, 0)>(_b); dst[1] = tr_read<v_rd_off((D) & 3, 0, 1)>(_b); dst[2] = tr_read<v_rd_off((D) & 3, 1, 0)>(_b); dst[3] = tr_read<v_rd_off((D) & 3, 1, 1)>(_b); \
    dst[4] = tr_read<v_rd_off((D) & 3, 2, 0)>(_b); dst[5] = tr_read<v_rd_off((D) & 3, 2, 1)>(_b); dst[6] = tr_read<v_rd_off((D) & 3, 3, 0)>(_b); dst[7] = tr_read<v_rd_off((D) & 3, 3, 1)>(_b); } while (0)
#define PKV(L, H) (bf16x8){L[0], L[1], L[2], L[3], H[0], H[1], H[2], H[3]}
#define MM4(od, src) do { __builtin_amdgcn_s_setprio(2); od = __builtin_amdgcn_mfma_f32_32x32x16_bf16(pa0, PKV(src[0], src[1]), od, 0, 0, 0); od = __builtin_amdgcn_mfma_f32_32x32x16_bf16(pa1, PKV(src[2], src[3]), od, 0, 0, 0); \
    od = __builtin_amdgcn_mfma_f32_32x32x16_bf16(pa2, PKV(src[4], src[5]), od, 0, 0, 0); od = __builtin_amdgcn_mfma_f32_32x32x16_bf16(pa3, PKV(src[6], src[7]), od, 0, 0, 0); __builtin_amdgcn_s_setprio(0); } while (0)
#define LW(n) do { asm volatile("s_waitcnt lgkmcnt(" #n ")" ::: "memory"); SBAR(); } while (0)
__device__ __forceinline__ void pv8(f32x16* o, int vb, bf16x8 pa0, bf16x8 pa1, bf16x8 pa2, bf16x8 pa3) {
  s16x4 va[8], vq[8];
  TRD(va, 0, vb); TRD(vq, 1, vb);
  LW(8); MM4(o[0], va); SBAR(); TRD(va, 2, vb);
  LW(8); MM4(o[1], vq); SBAR(); TRD(vq, 3, vb);
  LW(8); MM4(o[2], va); SBAR(); TRD(va, 4, vb);
  LW(8); MM4(o[3], vq); SBAR(); TRD(vq, 5, vb);
  LW(8); MM4(o[4], va); SBAR(); TRD(va, 6, vb);
  LW(8); MM4(o[5], vq); SBAR(); TRD(vq, 7, vb);
  LW(8); MM4(o[6], va);
  LW(0); MM4(o[7], vq);
}
#undef TRD
#undef PKV
#undef MM4
#undef LW
constexpr int KB_BYTES = KVBLK * DH * 2  , VB_BYTES = KVBLK * 256 * 2  ;
constexpr int AT_K_OFF = 0, AT_V_OFF = 2 * KB_BYTES, AT_W_OFF = AT_V_OFF + 2 * VB_BYTES, AT_LDS = AT_W_OFF + NW * 64 * 4;
__device__ __forceinline__ void attn256_body(const bf16_t* __restrict__ Qb, const bf16_t* __restrict__ Kh, const bf16_t* __restrict__ Vh, bf16_t* __restrict__ Ob, int seq, char* lds, const int wid) {
  const int tid = tid_opaque(wid), lane = tid & 63, r32 = lane & 31, hi = lane >> 5, grp = wid >> 2;
  LAS char* L = (LAS char*)lds;
  float* ws = (float*)(lds + AT_W_OFF) + wid * 64; float* li_l = ws; float* al_l = ws + 32;
  float m_reg = -1e30f, l_reg = 0; f32x16 o[8]; bf16x8 qr[8];
#pragma unroll
  for (int d = 0; d < 8; ++d) o[d] = f32x16{};
  const bf16_t* Qw = Qb + (long)(wid * QBLK + r32) * LDQ + hi * 8;
#pragma unroll
  for (int d0 = 0; d0 < 8; ++d0) qr[d0] = *reinterpret_cast<const bf16x8*>(Qw + d0 * 16);
  const int wq = wid & 3;
#define DMA_K(j, b) do { const char* _g = (const char*)Kh + (size_t)(j) * (KVBLK * LDK * 2); const int _l = tid_opaque(0); _Pragma("unroll") for (int _i = 0; _i < 4; ++_i) { \
    const int _r = 16 * wq + 4 * _i + (_l >> 4); const unsigned _o = (unsigned)(_r * (LDK * 2) + (((_l & 15) ^ (_r & 7)) << 4)); \
    __builtin_amdgcn_global_load_lds((const unsigned*)(_g + _o), (LAS unsigned*)(L + AT_K_OFF + (b) * KB_BYTES + wq * 4096 + _i * 1024), 16, 0, 0); } } while (0)
#define DMA_V(j, b) do { const char* _g = (const char*)Vh + (size_t)(j) * (KVBLK * LDK * 2); const int _l = tid_opaque(0); _Pragma("unroll") for (int _i = 0; _i < 8; ++_i) { \
    const int _tt = 8 * (wq & 1) + _i, _kk = (_tt >> 1) * 8 + ((_l & 31) >> 2), _k = (_kk & ~0xC) | ((_kk & 4) << 1) | ((_kk & 8) >> 1); \
    const int _c = (2 * (_tt & 1) + (_l >> 5)) * 32 + (_l & 3) * 8; const unsigned _o = (unsigned)(_k * (LDK * 2) + ((wq >> 1) * 128 + _c) * 2); \
    __builtin_amdgcn_global_load_lds((const unsigned*)(_g + _o), (LAS unsigned*)(L + AT_V_OFF + (b) * VB_BYTES + wq * 8192 + _i * 1024), 16, 0, 0); } } while (0)
#define RESC8(a) do { if (__any((a) < 1.f)) { if (hi == 0) al_l[r32] = (a); asm volatile("s_waitcnt lgkmcnt(0)" ::: "memory"); \
    _Pragma("unroll") for (int d = 0; d < 8; ++d) _Pragma("unroll") for (int r = 0; r < 16; ++r) o[d][r] *= al_l[crow(r, hi)]; } } while (0)
  const int vb0 = (int)(uintptr_t)(lds + AT_V_OFF) + v_rd_base(lane);
  const int NT = seq / KVBLK;
  f32x16 p0, p1; float mn, al; bf16x8 pa0, pa1, pa2, pa3;
  asm volatile("s_waitcnt vmcnt(0)" ::: "memory");
  if (grp) DMA_K(0, 0); else DMA_V(0, 0);
  asm volatile("s_waitcnt vmcnt(0)" ::: "memory"); __builtin_amdgcn_s_barrier();
#define QKSM(jq) do { const int kbase = (int)(uintptr_t)(lds + AT_K_OFF) + ((jq) & 1) * KB_BYTES + r32 * 256 + ((hi << 4) ^ ((r32 & 7) << 4)); qkt_pipe(p0, p1, kbase, qr); partialSM(p0, p1, m_reg, mn, al); RESC8(al); \
    finishSM(p0, p1, al, l_reg, pa0, pa1, pa2, pa3); } while (0)
#define PV(jp) do { const int vb = vb0 + ((jp) & 1) * VB_BYTES; pv8(o, vb, pa0, pa1, pa2, pa3); } while (0)
#define VM0_BAR() do { asm volatile("s_waitcnt vmcnt(0)" ::: "memory"); __builtin_amdgcn_s_barrier(); } while (0)
  if (grp == 0) {
    for (int j = 0; j < NT; ++j) {
      QKSM(j); VM0_BAR();
      if (j + 1 < NT) DMA_V(j + 1, (j + 1) & 1);
      PV(j); __builtin_amdgcn_s_barrier();
    }
    VM0_BAR();
  } else {
    for (int j = 0; j < NT; ++j) {
      if (j + 1 < NT) DMA_K(j + 1, (j + 1) & 1);
      if (j > 0) PV(j - 1);
      __builtin_amdgcn_s_barrier();
      QKSM(j); VM0_BAR();
    }
    PV(NT - 1);
    VM0_BAR();
  }
#undef VM0_BAR
#undef QKSM
#undef PV
  if (hi == 0) li_l[r32] = l_reg; asm volatile("s_waitcnt lgkmcnt(0)" ::: "memory");
  float rli[16];
#pragma unroll
  for (int r = 0; r < 16; ++r) rli[r] = __builtin_amdgcn_rcpf(li_l[crow(r, hi)]);
  unsigned* Ow = (unsigned*)Ob + (long)(wid * (QBLK / 2)) * LDO;
#pragma unroll
  for (int r = 0; r < 16; r += 2) { const int prow = crow(r, hi) >> 1;
#pragma unroll
    for (int d0 = 0; d0 < 8; ++d0) Ow[(long)prow * LDO + d0 * 32 + r32] = cvtpk(o[d0][r] * rli[r], o[d0][r + 1] * rli[r + 1]); }
  asm volatile("s_waitcnt vmcnt(0) lgkmcnt(0)" ::: "memory"); __builtin_amdgcn_s_barrier();
#undef DMA_K
#undef DMA_V
#undef RESC8
}
#undef KSWZ
#undef SBAR
}

struct Frame {
    LAS unsigned char* lds; volatile LAS unsigned* MISC; unsigned* ctl;
    int wave, G, bx;
    const float* in[22]; float* out; unsigned char* ws;
};

constexpr int TP_S = 65, TP_BYTES = 64 * TP_S * 4;
template <bool NT>
__device__ __forceinline__ void transpose_item(const float* W, int K, int N, bf16_t* WT, int k0, int n0, int dst_row0, const float* gk, int gmask, float gmul, const float* gn,
                                               LAS float* scr, int lane) {
    const int lr = lane >> 4, lc = (lane & 15) * 4;
    f32x4 v[16];
#pragma unroll
    for (int i = 0; i < 16; ++i) { const GAS f32x4* p = (const GAS f32x4*)(W + (size_t)(k0 + 4 * i + lr) * N + n0 + lc); if constexpr (NT) v[i] = __builtin_nontemporal_load(p); else v[i] = *p; }
    f32x4 ns = {1.f, 1.f, 1.f, 1.f}; if (gn) ns = *(const f32x4*)(gn + n0 + lc);
#pragma unroll
    for (int i = 0; i < 16; ++i) { const int k = 4 * i + lr; const float ks = (gk ? gk[(k0 + k) & gmask] : 1.0f) * gmul;
        const f32x4 x = v[i] * ns * ks; LAS float* p = scr + k * TP_S + lc; p[0] = x.x; p[1] = x.y; p[2] = x.z; p[3] = x.w; }
    LDS_WAIT(); asm volatile("" ::: "memory");
    const int c = lane >> 3, nl = lane & 7;
#pragma unroll
    for (int j = 0; j < 8; ++j) { const int n = 8 * j + nl; const LAS float* sp = scr + (8 * c) * TP_S + n;
        u32x4 o; o.x = cvt_pk_bf16(sp[0 * TP_S], sp[1 * TP_S]); o.y = cvt_pk_bf16(sp[2 * TP_S], sp[3 * TP_S]); o.z = cvt_pk_bf16(sp[4 * TP_S], sp[5 * TP_S]); o.w = cvt_pk_bf16(sp[6 * TP_S], sp[7 * TP_S]);
        *(GAS u32x4*)(WT + (size_t)(dst_row0 + n) * K + k0 + 8 * c) = o; }
    LDS_WAIT(); asm volatile("" ::: "memory");
}
template <class RowMap>
__device__ __forceinline__ void transpose_matrix(const float* W, int K, int N, bf16_t* WT, const float* gk, int gmask, float gmul, const float* gn, RowMap rowmap,
                                                 LAS float* scr, int lane, int gw, int NGW, int& rot) {
    const int nblk = N / 64, nitems = (K / 64) * nblk;
    int first = gw - rot; if (first < 0) first += NGW;
    for (int it = first; it < nitems; it += NGW) { const int kb = it / nblk, nb = it % nblk;
        transpose_item<true>(W, K, N, WT, 64 * kb, 64 * nb, rowmap(64 * nb), gk, gmask, gmul, gn, scr, lane); }
    rot = (rot + nitems) % NGW;
}
struct RowId { __device__ __forceinline__ int operator()(int n0) const { return n0; } };
struct RowUp { __device__ __forceinline__ int operator()(int n0) const { const int up = n0 >= DFF, nn = up ? n0 - DFF : n0; return (nn >> 7) * 256 + up * 128 + (nn & 127); } };

__device__ __forceinline__ void p_wdn_filler(Frame& F, int l, unsigned* ctr) {
    LAS float* scr = (LAS float*)(F.lds + RING_OFF + F.wave * TP_BYTES);
    const int lane = tid_opaque(F.wave) & 63;
    const float* W = F.in[20] + (size_t)l * DFF * D; bf16_t* WT = (bf16_t*)(F.ws + WS_WDN) + (size_t)l * D * DFF;
    constexpr int NBLK = D / 64, PER = 2, NTICK = (DFF / 64) * NBLK / (NWAVES * PER);
    static_assert((DFF / 64) * NBLK % (NWAVES * PER) == 0, "whole tickets");
    for (int k = 0;; ++k) {
        if (threadIdx.x == 0) F.MISC[22 + (k & 1)] = __hip_atomic_fetch_add(ctr, 1u, __ATOMIC_RELAXED, __HIP_MEMORY_SCOPE_AGENT);
        __syncthreads();
        const unsigned t = (unsigned)__builtin_amdgcn_readfirstlane((int)F.MISC[22 + (k & 1)]);
        if (t >= (unsigned)NTICK) break;
#pragma unroll 1
        for (int b = 0; b < PER; ++b) { const int it = ((int)t * PER + b) * NWAVES + F.wave, kb = it / NBLK, nb = it % NBLK;
            transpose_item<false>(W, DFF, D, WT, 64 * kb, 64 * nb, 64 * nb, nullptr, 0, 1.0f, nullptr, scr, lane); }
    }
}

__device__ __forceinline__ void p_prologue(Frame& F) {
    LAS float* scr = (LAS float*)(F.lds + RING_OFF + F.wave * TP_BYTES);
    const int tid = tid_opaque(F.wave), lane = tid & 63; int rot = 0;
    const int gw = F.bx * NWAVES + F.wave, NGW = F.G * NWAVES;
    unsigned char* ws = F.ws;
    {   float* rstd = (float*)(ws + WS_RSTD); bf16_t* xb = (bf16_t*)(ws + WS_XB);
        for (int r = gw; r < M; r += NGW) {
            const float* xrow = (r < MP) ? F.in[0] + (size_t)r * D : F.in[1] + (size_t)(r - MP) * D;
            const GAS f32x4* xr = (const GAS f32x4*)xrow + lane;
            f32x4 v[16]; float s = 0.f;
#pragma unroll
            for (int j = 0; j < 16; ++j) { v[j] = __builtin_nontemporal_load(xr + 64 * j); s += (v[j].x * v[j].x + v[j].y * v[j].y) + (v[j].z * v[j].z + v[j].w * v[j].w); }
            s = wave_sum(s);
            if (lane == 0) rstd[r] = 1.0f / sqrtf(s * (1.0f / D) + NORM_EPS);
            GAS u32x2* o8 = (GAS u32x2*)(xb + (size_t)r * D) + lane;
#pragma unroll
            for (int j = 0; j < 16; ++j) { u32x2 w; w.x = pk2(v[j].x, v[j].y); w.y = pk2(v[j].z, v[j].w); o8[64 * j] = w; }
        }
    }
    transpose_matrix(F.in[3], D, D, (bf16_t*)(ws + WS_WIN), F.in[2], 0xffff, 1.0f, nullptr, RowId(), scr, lane, gw, NGW, rot);
    for (int g = 0; g < 4; ++g)
        transpose_matrix(F.in[4] + (size_t)g * PG * PG, PG, PG, (bf16_t*)(ws + WS_POOLT) + (size_t)g * PG * PG, nullptr, 0, 1.0f, F.in[5] + g * PG, RowId(), scr, lane, gw, NGW, rot);
    transpose_matrix(F.in[7], D, D, (bf16_t*)(ws + WS_WOE), nullptr, 0, 1.0f, nullptr, RowId(), scr, lane, gw, NGW, rot);
    transpose_matrix(F.in[9], D, NQKV, (bf16_t*)(ws + WS_WQKV), F.in[8], 0xffff, 1.0f, nullptr, RowId(), scr, lane, gw, NGW, rot);
    transpose_matrix(F.in[15], D, D, (bf16_t*)(ws + WS_WOO), F.in[14], 255, 1.0f - LAMBDA_INIT, nullptr, RowId(), scr, lane, gw, NGW, rot);
    for (int l = 0; l < 2; ++l) {
        transpose_matrix(F.in[17] + (size_t)l * D * NUP, D, NUP, (bf16_t*)(ws + WS_WUP) + (size_t)l * NUP * D, F.in[16] + l * D, 0xffff, 1.0f, nullptr, RowUp(), scr, lane, gw, NGW, rot);
    }
    for (int which = 0; which < 2; ++which) {
        const int L = which ? LS : LP, Hf = L / 2; bf16_t* dft = (bf16_t*)(ws + (which ? WS_DFTS : WS_DFTP));
        const float inv = 1.0f / (float)L, nrm = 1.0f / sqrtf((float)L);
        const int chunks = Hf / 512, per = Hf * chunks, nitems = 2 * per;
        for (int it = gw; it < nitems; it += NGW) { const int part = it / per, r = it % per, k = r / chunks, t0 = (r % chunks) * 512 + lane * 8; float v[8];
#pragma unroll
            for (int e = 0; e < 8; ++e) { const int idx = (k * (t0 + e) + (part ? 3 * (L >> 2) : 0)) & (L - 1); v[e] = __builtin_amdgcn_cosf((float)idx * inv) * nrm; }
            u32x4 o; o.x = pk2(v[0], v[1]); o.y = pk2(v[2], v[3]); o.z = pk2(v[4], v[5]); o.w = pk2(v[6], v[7]);
            *(GAS u32x4*)(dft + ((size_t)part * Hf + k) * Hf + t0) = o; }
    }
    {   __syncthreads();
        LAS float* tab = (LAS float*)(F.lds + RING_OFF);
        if (tid < 256) tab[tid] = cospif((float)tid * (1.0f / 128.0f));
        __syncthreads();
        bf16_t* gt = (bf16_t*)(ws + WS_GT); const float* fw = F.in[6];
        for (int it = gw; it < 2048; it += NGW) { const int h = it >> 9, c = ((it >> 7) & 3) * 64 + lane, n0 = (it & 127) * 8;
            float ac[8], as[8];
#pragma unroll
            for (int q = 0; q < 8; ++q) { ac[q] = 0.f; as[q] = 0.f; }
#pragma unroll 4
            for (int cp = 0; cp < 256; ++cp) { const float tc = tab[(c * cp) & 255], ts = tab[(c * cp + 192) & 255];
                const float* fr = fw + (size_t)(h * 256 + cp) * FD + n0;
#pragma unroll
                for (int q = 0; q < 8; ++q) { const float f = fr[q]; ac[q] += tc * f; as[q] += ts * f; } }
#pragma unroll
            for (int q = 0; q < 8; ++q) { gt[(size_t)(2 * (n0 + q)) * FD + h * 256 + c] = (bf16_t)f2bf(ac[q] * (1.0f / 16.0f)); gt[(size_t)(2 * (n0 + q) + 1) * FD + h * 256 + c] = (bf16_t)f2bf(as[q] * (1.0f / 16.0f)); }
        }
    }
    {   float* rot = (float*)(ws + WS_ROT);
        for (int i = gw * 64 + lane; i < LP * 16; i += NGW * 64) { const int pos = i >> 4, j = i & 15;
            const float invf = (float)pow(500000.0, -(double)(2 * j) / 32.0); const float ang = (float)pos * invf;
            rot[pos * 32 + j] = (float)cos((double)ang); rot[pos * 32 + 16 + j] = (float)sin((double)ang); }
        if (F.bx == 0 && F.wave == 0) {
            float a = F.in[10][lane] * F.in[11][lane] + F.in[10][lane + 64] * F.in[11][lane + 64];
            float b = F.in[12][lane] * F.in[13][lane] + F.in[12][lane + 64] * F.in[13][lane + 64];
            a = wave_sum(a); b = wave_sum(b);
            if (lane == 0) F.ctl[CW_LAM] = __builtin_bit_cast(unsigned, expf(a) - expf(b) + LAMBDA_INIT);
        }
    }
}

__device__ __forceinline__ void p_finalize_rstd(Frame& F) {
    const float* psum = (const float*)(F.ws + WS_PSUM); float* rstd = (float*)(F.ws + WS_RSTD);
    const int tid = tid_opaque(F.wave);
    for (int r = F.bx * NTHREADS + tid; r < M; r += F.G * NTHREADS) { const f32x4* p = (const f32x4*)(psum + (size_t)r * 64); float s = 0.f;
#pragma unroll
        for (int j = 0; j < 16; ++j) { const f32x4 v = p[j]; s += (v.x + v.y) + (v.z + v.w); }
        rstd[r] = 1.0f / sqrtf(s * (1.0f / D) + NORM_EPS); }
}

__device__ __forceinline__ f32x4 bf4lo(u32x4 w) { return (f32x4){bf2f(w.x & 0xffff), bf2f(w.x >> 16), bf2f(w.y & 0xffff), bf2f(w.y >> 16)}; }
__device__ __forceinline__ f32x4 bf4hi(u32x4 w) { return (f32x4){bf2f(w.z & 0xffff), bf2f(w.z >> 16), bf2f(w.w & 0xffff), bf2f(w.w >> 16)}; }
__device__ __forceinline__ void p_pool(Frame& F) {
    const bf16_t* u = (const bf16_t*)(F.ws + WS_U); bf16_t* pooled = (bf16_t*)(F.ws + WS_POOLED);
    const int gw = F.bx * NWAVES + F.wave, NGW = F.G * NWAVES, lane = tid_opaque(F.wave) & 63;
    for (int it = gw; it < (M / 32) * 6; it += NGW) {
        const int rc = it / 6, cb = it % 6, t0 = rc * 32, col = cb * 512 + lane * 8, h = 1 << (col / PG);
        const int s0 = (t0 < MP) ? 0 : MP + ((t0 - MP) / LS) * LS, s1 = (t0 < MP) ? MP : s0 + LS;
        const bf16_t* up = u + col;
        f32x4 sa = {0.f, 0.f, 0.f, 0.f}, sb = {0.f, 0.f, 0.f, 0.f};
#pragma unroll
        for (int d = -8; d < 8; ++d) { const int sidx = t0 + d; const bool ok = (d >= -h) && (d < h) && (sidx >= s0) && (sidx < s1); const int sc = sidx < s0 ? s0 : (sidx >= s1 ? s1 - 1 : sidx);
            const u32x4 w = *(const u32x4*)(up + (size_t)sc * D); const float mk = ok ? 1.0f : 0.0f; sa += bf4lo(w) * mk; sb += bf4hi(w) * mk; }
#pragma unroll 8
        for (int t = t0; t < t0 + 32; ++t) {
            const int a = (t - h > s0) ? t - h : s0, b = (t + h < s1) ? t + h : s1;
            const int ia = t + h, is = t - h; const float ma = (ia < s1) ? 1.0f : 0.0f, ms = (is >= s0) ? 1.0f : 0.0f;
            const u32x4 wt = *(const u32x4*)(up + (size_t)t * D), wa = *(const u32x4*)(up + (size_t)(ia < s1 ? ia : s1 - 1) * D), wsb = *(const u32x4*)(up + (size_t)(is >= s0 ? is : s0) * D);
            const float inv = 1.0f / (float)(b - a);
            const f32x4 oa = sa * inv - bf4lo(wt), ob = sb * inv - bf4hi(wt);
            u32x4 ow; ow.x = pk2(oa.x, oa.y); ow.y = pk2(oa.z, oa.w); ow.z = pk2(ob.x, ob.y); ow.w = pk2(ob.z, ob.w);
            *(u32x4*)(pooled + (size_t)t * POOL_DIM + col) = ow;
            sa += bf4lo(wa) * ma - bf4lo(wsb) * ms; sb += bf4hi(wa) * ma - bf4hi(wsb) * ms;
        }
    }
}

__device__ __forceinline__ void hr_decode(int hr, int& s, int& t, int& row0, int& L) { if (hr < HP) { s = 0; t = hr; row0 = 0; L = LP; } else { const int j = hr - HP; s = 1 + (j >> 10); t = j & (HS - 1); row0 = MP + (s - 1) * LS; L = LS; } }
__device__ __forceinline__ void bf8_to_f(u32x4 w, f32x4& lo, f32x4& hi) { lo = (f32x4){bf2f(w.x & 0xffff), bf2f(w.x >> 16), bf2f(w.y & 0xffff), bf2f(w.y >> 16)}; hi = (f32x4){bf2f(w.z & 0xffff), bf2f(w.z >> 16), bf2f(w.w & 0xffff), bf2f(w.w >> 16)}; }
__device__ __forceinline__ void p_fold(Frame& F) {
    const bf16_t* u = (const bf16_t*)(F.ws + WS_U); bf16_t* ufp = (bf16_t*)(F.ws + WS_UFP); bf16_t* ufm = (bf16_t*)(F.ws + WS_UFM);
    const int gw = F.bx * NWAVES + F.wave, NGW = F.G * NWAVES, lane = tid_opaque(F.wave) & 63;
    for (int hr = gw; hr < MH; hr += NGW) { int sq, t, row0, L; hr_decode(hr, sq, t, row0, L);
        const bf16_t* pa = u + (size_t)(row0 + t) * D + POOL_DIM + lane * 16; const bf16_t* pb = u + (size_t)(row0 + (t ? L - t : 0)) * D + POOL_DIM + lane * 16;
        const float mk = t ? 1.0f : 0.0f;
#pragma unroll
        for (int q = 0; q < 2; ++q) { f32x4 a0, a1, b0, b1; bf8_to_f(*(const u32x4*)(pa + 8 * q), a0, a1); bf8_to_f(*(const u32x4*)(pb + 8 * q), b0, b1);
            const f32x4 p0 = a0 + b0 * mk, p1 = a1 + b1 * mk, m0 = (a0 - b0) * mk, m1 = (a1 - b1) * mk;
            u32x4 wp, wm; wp.x = pk2(p0.x, p0.y); wp.y = pk2(p0.z, p0.w); wp.z = pk2(p1.x, p1.y); wp.w = pk2(p1.z, p1.w); wm.x = pk2(m0.x, m0.y); wm.y = pk2(m0.z, m0.w); wm.z = pk2(m1.x, m1.y); wm.w = pk2(m1.z, m1.w);
            *(u32x4*)(ufp + (size_t)hr * FD + lane * 16 + 8 * q) = wp; *(u32x4*)(ufm + (size_t)hr * FD + lane * 16 + 8 * q) = wm; }
    }
}
__device__ __forceinline__ void p_ych(Frame& F) {
    const bf16_t* u = (const bf16_t*)(F.ws + WS_U); const bf16_t* gt = (const bf16_t*)(F.ws + WS_GT); float* ych = (float*)(F.ws + WS_YCH);
    const int gw = F.bx * NWAVES + F.wave, NGW = F.G * NWAVES, lane = tid_opaque(F.wave) & 63;
    for (int it = gw; it < 9 * FD; it += NGW) { const int sq = it >> 10, cpp = it & (FD - 1); const int row = sq ? MP + (sq - 1) * LS + HS : HP;
        const bf16_t* g = gt + (size_t)(2 * cpp) * FD + lane * 16; const bf16_t* x = u + (size_t)row * D + POOL_DIM + lane * 16; float a = 0.f;
#pragma unroll
        for (int q = 0; q < 2; ++q) { f32x4 g0, g1, x0, x1; bf8_to_f(*(const u32x4*)(g + 8 * q), g0, g1); bf8_to_f(*(const u32x4*)(x + 8 * q), x0, x1);
            a += (g0.x * x0.x + g0.y * x0.y) + (g0.z * x0.z + g0.w * x0.w) + (g1.x * x1.x + g1.y * x1.y) + (g1.z * x1.z + g1.w * x1.w); }
        a = wave_sum(a); if (lane == 0) ych[it] = a; }
}
__device__ __forceinline__ void p_alt(Frame& F) {
    float* alt = (float*)(F.ws + WS_ALT);
    const int gw = F.bx * NWAVES + F.wave, NGW = F.G * NWAVES, lane = tid_opaque(F.wave) & 63;
    for (int it = gw; it < 9 * FD; it += NGW) { const int sq = it >> 10, cpp = it & (FD - 1); const int Hf = sq ? HS : HP;
        const bf16_t* y = sq ? (const bf16_t*)(F.ws + WS_YFS) + ((size_t)(sq - 1) * 2 * FD + cpp) * HS : (const bf16_t*)(F.ws + WS_YFP) + (size_t)cpp * HP;
        float a = 0.f;
        for (int ch = lane; ch < Hf / 8; ch += 64) { f32x4 v0, v1; bf8_to_f(*(const u32x4*)(y + 8 * ch), v0, v1); a += (v0.x - v0.y) + (v0.z - v0.w) + (v1.x - v1.y) + (v1.z - v1.w); }
        a = wave_sum(a); if (lane == 0) alt[it] = a; }
}
__device__ __forceinline__ void p_unfold(Frame& F) {
    const float* eb = (const float*)(F.ws + WS_EB); const float* ob = (const float*)(F.ws + WS_OB2); const float* ych = (const float*)(F.ws + WS_YCH); const float* alt = (const float*)(F.ws + WS_ALT);
    bf16_t* cat = (bf16_t*)(F.ws + WS_CAT);
    const int gw = F.bx * NWAVES + F.wave, NGW = F.G * NWAVES, lane = tid_opaque(F.wave) & 63;
    constexpr int NROWS = (HP + 1) + NSS * (HS + 1);
    for (int it = gw; it < NROWS; it += NGW) {
        int sq, k; if (it <= HP) { sq = 0; k = it; } else { const int j = it - (HP + 1); sq = 1 + j / (HS + 1); k = j % (HS + 1); }
        const int L = sq ? LS : LP, Hf = L / 2, row0 = sq ? MP + (sq - 1) * LS : 0, hrow0 = sq ? HP + (sq - 1) * HS : 0;
        const float nrm = 1.0f / sqrtf((float)L);
        const float* yc = ych + sq * FD + lane * 16;
        if (k == Hf) { const float* al = alt + sq * FD + lane * 16; bf16_t* o = cat + (size_t)(row0 + Hf) * D + POOL_DIM + lane * 16;
#pragma unroll
            for (int q = 0; q < 4; ++q) { const f32x4 v = (*(const f32x4*)(al + 4 * q) + *(const f32x4*)(yc + 4 * q)) * nrm; u32x2 w; w.x = pk2(v.x, v.y); w.y = pk2(v.z, v.w); *(u32x2*)(o + 4 * q) = w; }
        } else { const float sg = (k & 1) ? -nrm : nrm;
            const float* e = eb + (size_t)(hrow0 + k) * FD + lane * 16; const float* od = ob + (size_t)(hrow0 + k) * FD + lane * 16;
            bf16_t* o1 = cat + (size_t)(row0 + k) * D + POOL_DIM + lane * 16; bf16_t* o2 = cat + (size_t)(row0 + (k ? L - k : 0)) * D + POOL_DIM + lane * 16;
#pragma unroll
            for (int q = 0; q < 4; ++q) { const f32x4 ev = *(const f32x4*)(e + 4 * q) + *(const f32x4*)(yc + 4 * q) * sg, ov = *(const f32x4*)(od + 4 * q);
                const f32x4 f1 = ev - ov, f2 = ev + ov; u32x2 w; w.x = pk2(f1.x, f1.y); w.y = pk2(f1.z, f1.w); *(u32x2*)(o1 + 4 * q) = w;
                if (k) { u32x2 w2; w2.x = pk2(f2.x, f2.y); w2.y = pk2(f2.z, f2.w); *(u32x2*)(o2 + 4 * q) = w2; } }
        }
    }
}

__device__ __forceinline__ void p_fixup(Frame& F, const float* cw, const float* cb) {
    const float* halo = (const float*)(F.ws + WS_HALO); bf16_t* act = (bf16_t*)(F.ws + WS_ACT);
    constexpr int CH = DFF / 4;
    const int tid = tid_opaque(F.wave);
    for (int i = F.bx * NTHREADS + tid; i < (M / 128) * 2 * CH; i += F.G * NTHREADS) {
        const int ch = i % CH, be = i / CH, blk = be >> 1, e = be & 1, c = ch * 4;
        const int t = blk * 128 + (e ? 127 : 0);
        const int s0 = (t < MP) ? 0 : MP + ((t - MP) / LS) * LS, s1 = (t < MP) ? MP : s0 + LS;
        const float* hb = halo + (size_t)blk * 4 * NUP;
        f32x4 a4;
        f32x4 y[2];
#pragma unroll
        for (int bj = 0; bj < 2; ++bj) { const int cc = bj * DFF + c;
            f32x4 xl, xc, xr; const f32x4 z = {0.f, 0.f, 0.f, 0.f};
            if (e == 0) { xl = (t > s0) ? *(const f32x4*)(hb - (size_t)4 * NUP + 3 * NUP + cc) : z; xc = *(const f32x4*)(hb + cc); xr = *(const f32x4*)(hb + NUP + cc); }
            else { xl = *(const f32x4*)(hb + 2 * NUP + cc); xc = *(const f32x4*)(hb + 3 * NUP + cc); xr = (t + 1 < s1) ? *(const f32x4*)(hb + (size_t)4 * NUP + cc) : z; }
            y[bj] = xl * *(const f32x4*)(cw + cc) + xc * *(const f32x4*)(cw + NUP + cc) + xr * *(const f32x4*)(cw + 2 * NUP + cc) + *(const f32x4*)(cb + cc); }
#pragma unroll
        for (int q = 0; q < 4; ++q) { const float g = y[0][q]; a4[q] = g * __builtin_amdgcn_rcpf(1.0f + __expf(-g)) * y[1][q]; }
        u32x2 w; w.x = cvt_pk_bf16(a4[0], a4[1]); w.y = cvt_pk_bf16(a4[2], a4[3]);
        *(u32x2*)(act + (size_t)t * DFF + c) = w;
    }
}

__device__ __forceinline__ void p_combine(Frame& F) {
    const unsigned* oa0 = (const unsigned*)(F.ws + WS_OA); const unsigned* oa1 = oa0 + (size_t)(M / 2) * D; bf16_t* ob = (bf16_t*)(F.ws + WS_OB);
    const float lam = __builtin_bit_cast(float, __hip_atomic_load(F.ctl + CW_LAM, RLX_AGENT));
    const int gw = F.bx * NWAVES + F.wave, NGW = F.G * NWAVES, lane = tid_opaque(F.wave) & 63;
    for (int p = gw; p < M / 2; p += NGW) {
        const u32x4* a = (const u32x4*)(oa0 + (size_t)p * D) + lane; const u32x4* b = (const u32x4*)(oa1 + (size_t)p * D) + lane;
        u32x2* o0 = (u32x2*)(ob + (size_t)(2 * p) * D) + lane; u32x2* o1 = (u32x2*)(ob + (size_t)(2 * p + 1) * D) + lane;
#pragma unroll 8
        for (int h = 0; h < 16; ++h) { const u32x4 wa = a[64 * h], wb = b[64 * h];
            const f32x4 a0 = {bf2f(wa.x & 0xffff), bf2f(wa.y & 0xffff), bf2f(wa.z & 0xffff), bf2f(wa.w & 0xffff)}, a1 = {bf2f(wa.x >> 16), bf2f(wa.y >> 16), bf2f(wa.z >> 16), bf2f(wa.w >> 16)};
            const f32x4 b0 = {bf2f(wb.x & 0xffff), bf2f(wb.y & 0xffff), bf2f(wb.z & 0xffff), bf2f(wb.w & 0xffff)}, b1 = {bf2f(wb.x >> 16), bf2f(wb.y >> 16), bf2f(wb.z >> 16), bf2f(wb.w >> 16)};
            const f32x4 v0 = a0 - b0 * lam, v1 = a1 - b1 * lam;
            float s0 = (v0.x * v0.x + v0.y * v0.y) + (v0.z * v0.z + v0.w * v0.w), s1 = (v1.x * v1.x + v1.y * v1.y) + (v1.z * v1.z + v1.w * v1.w);
#pragma unroll
            for (int of = 1; of < 64; of <<= 1) { s0 += __shfl_xor(s0, of); s1 += __shfl_xor(s1, of); }
            const float r0 = 1.0f / sqrtf(s0 * (1.0f / 256.0f) + SUBLN_EPS), r1 = 1.0f / sqrtf(s1 * (1.0f / 256.0f) + SUBLN_EPS);
            u32x2 w0, w1; w0.x = pk2(v0.x * r0, v0.y * r0); w0.y = pk2(v0.z * r0, v0.w * r0); w1.x = pk2(v1.x * r1, v1.y * r1); w1.y = pk2(v1.z * r1, v1.w * r1);
            o0[64 * h] = w0; o1[64 * h] = w1; }
    }
}

__device__ __forceinline__ void p_final(Frame& F) {
    const float* psum = (const float*)(F.ws + WS_PSUM); const float* fn = F.in[21]; const bf16_t* xb = (const bf16_t*)(F.ws + WS_XB);
    const int gw = F.bx * NWAVES + F.wave, NGW = F.G * NWAVES, lane = tid_opaque(F.wave) & 63;
    for (int r = gw; r < M; r += NGW) {
        const float s = wave_sum(psum[(size_t)r * 64 + lane]); const float rs = 1.0f / sqrtf(s * (1.0f / D) + NORM_EPS);
        const u32x2* x = (const u32x2*)(xb + (size_t)r * D) + lane; f32x4* y = (f32x4*)(F.out + (size_t)r * D) + lane; const f32x4* g = (const f32x4*)fn + lane;
#pragma unroll 8
        for (int j = 0; j < 16; ++j) { const u32x2 w = x[64 * j]; const f32x4 v = {bf2f(w.x & 0xffff), bf2f(w.x >> 16), bf2f(w.y & 0xffff), bf2f(w.y >> 16)}; y[64 * j] = v * rs * g[64 * j]; }
    }
}

struct YFOrder {
    const char* gt; const char* ufp; const char* ufm; char* yfp; char* yfs; int G, c;
    __device__ __forceinline__ bool next(int i, pg::GUnit& un) const {
        const int id = i * G + c; if (id >= 384) return false;
        int part, pm, pn, Hf, hrow0; char* Cb;
        if (id < 128) { part = id >> 6; const int r = id & 63; pm = r & 3; pn = r >> 2; Hf = HP; hrow0 = 0; Cb = yfp + (size_t)part * FD * HP * 2; }
        else { const int j = id - 128, sq = j >> 5, r = j & 31; part = r >> 4; pm = r & 3; pn = (r >> 2) & 3; Hf = HS; hrow0 = HP + sq * HS; Cb = yfs + (size_t)(sq * 2 + part) * FD * HS * 2; }
        un.A = gt + (size_t)part * (FD * 2) + (size_t)pm * 256 * (2 * FD * 2); un.lda = 2 * FD * 2; un.B = (part ? ufm : ufp) + (size_t)(hrow0 + pn * 256) * (FD * 2); un.ldb = FD * 2; un.nt = FD / 64;
        un.C = Cb + ((size_t)pm * 256 * Hf + (size_t)pn * 256) * 2; un.ldc = (unsigned)Hf; un.grow0 = 0; un.gcol0 = 0; un.aux = 0;
        return true;
    }
};
struct EOOrder {
    const char* dftp; const char* dfts; const char* yfp; const char* yfs; char* eb; char* ob; const char* pooled; const char* poolt; char* cat; int G, c;
    __device__ __forceinline__ void eo_unit(int sq, int which, int pm, int pn, pg::GUnit& un) const {
        const int Hf = sq ? HS : HP, hrow0 = sq ? HP + (sq - 1) * HS : 0;
        un.A = (sq ? dfts : dftp) + ((size_t)which * Hf + (size_t)pm * 256) * ((size_t)Hf * 2); un.lda = (unsigned)Hf * 2u;
        un.B = (sq ? yfs + (size_t)((sq - 1) * 2 + which) * FD * HS * 2 : yfp + (size_t)which * FD * HP * 2) + (size_t)pn * 256 * ((size_t)Hf * 2); un.ldb = (unsigned)Hf * 2u; un.nt = Hf / 64;
        un.C = (which ? ob : eb) + ((size_t)(hrow0 + pm * 256) * FD + pn * 256) * 4; un.ldc = FD; un.grow0 = 0; un.gcol0 = 0; un.aux = 1;
    }
    __device__ __forceinline__ void pool_unit(int id, pg::GUnit& un) const {
        const int g = id / 288, r = id % 288, pm = r / 3, pn = r % 3;
        un.A = pooled + ((size_t)pm * 256 * POOL_DIM + g * PG) * 2; un.lda = POOL_DIM * 2; un.B = poolt + ((size_t)g * PG * PG + (size_t)pn * 256 * PG) * 2; un.ldb = PG * 2; un.nt = PG / 64;
        un.C = cat + ((size_t)pm * 256 * D + g * PG + pn * 256) * 2; un.ldc = D; un.grow0 = pm * 256; un.gcol0 = g * PG + pn * 256; un.aux = 0;
    }
    __device__ __forceinline__ bool next(int i, pg::GUnit& un) const {
        if (G == 256) {
            if (c < 128) { if (i == 0) { eo_unit(0, c >> 6, (c & 63) >> 2, c & 3, un); return true; } if (i < 4) { pool_unit(3 * c + (i - 1), un); return true; } return false; }
            const int j = c - 128;
            if (i < 2) { const int id = 2 * j + i, r = id & 31; eo_unit(1 + (id >> 5), r >> 4, (r >> 2) & 3, r & 3, un); return true; }
            if (i < 8) { pool_unit(384 + 6 * j + (i - 2), un); return true; }
            return false;
        }
        const int id = i * G + c;
        if (id < 128) { eo_unit(0, id >> 6, (id & 63) >> 2, id & 3, un); return true; }
        if (id < 384) { const int k = id - 128, r = k & 31; eo_unit(1 + (k >> 5), r >> 4, (r >> 2) & 3, r & 3, un); return true; }
        if (id < 384 + 1152) { pool_unit(id - 384, un); return true; }
        return false;
    }
};

struct Args { const float* in[22]; float* out; unsigned char* ws; int ph_lo, ph_hi; };
constexpr int N_PHASES = 32;

__global__ void __launch_bounds__(NTHREADS, 2) mk_fwd(Args args) {
    extern __shared__ __attribute__((aligned(16))) unsigned char lds[];
    Frame F;
    F.lds = (LAS unsigned char*)lds; F.MISC = (volatile LAS unsigned*)(F.lds + MISC_OFF);
    F.wave = __builtin_amdgcn_readfirstlane((int)threadIdx.x >> 6);
    F.G = gridDim.x; F.bx = blockIdx.x;
#pragma unroll
    for (int i = 0; i < 22; ++i) F.in[i] = args.in[i];
    F.out = args.out; F.ws = args.ws; F.ctl = (unsigned*)(args.ws + WS_CTL);
    unsigned char* ws = args.ws;
    for (int u = threadIdx.x; u < (LDS_BYTES - LDSCTL_OFF) / 4; u += NTHREADS) ((LAS unsigned*)(F.lds + LDSCTL_OFF))[u] = 0u;
    __syncthreads();
    XcdBarrier bar; bar.bar = F.ctl + CW_BAR; bar.x = 0; bar.st = nullptr;
    if (MK_N_LAUNCHES == 1) bar = xcd_barrier_post(F.ctl + CW_BAR, F.MISC + 8);
    const int lo = args.ph_lo, hi = args.ph_hi;
#define IN(k) (lo <= (k) && (k) < hi)
    unsigned long long pr_t0 = 0, pr_span = 0;
#ifndef PROBE_CYC
#define PROBE_CYC 0
#endif
#define PB(k) do { if (PROBE_PH == (k)) pr_t0 = PROBE_CYC ? __builtin_amdgcn_s_memtime() : __builtin_amdgcn_s_memrealtime(); } while (0)
#define PE(k) do { if (PROBE_PH == (k)) pr_span += (PROBE_CYC ? __builtin_amdgcn_s_memtime() / 1 : __builtin_amdgcn_s_memrealtime()) - pr_t0; } while (0)
#define SEAMX(k, kn) do { if (IN(k) && IN(kn)) { if (PROBE_PH == 100 || PROBE_PH == 100 + (k)) pr_t0 = __builtin_amdgcn_s_memrealtime(); xcd_barrier(bar); if (PROBE_PH == 100 || PROBE_PH == 100 + (k)) pr_span += __builtin_amdgcn_s_memrealtime() - pr_t0; } } while (0)
#define SEAM(k) SEAMX(k, (k) + 1)
    LAS unsigned char* ring = F.lds + RING_OFF;
    const int G = F.G, c = F.bx;
    float* rstd = (float*)(ws + WS_RSTD); float* psum = (float*)(ws + WS_PSUM); bf16_t* xb = (bf16_t*)(ws + WS_XB);

    PB(0);
    if (IN(0)) p_prologue(F);
    PE(0);
    SEAM(0);
    PB(1);
    if (IN(1)) { pg::DenseOrder S{(const char*)xb, (const char*)(ws + WS_WIN), (char*)(ws + WS_U), D * 2, D * 2, D, 2, M / 256, D / 256, D / 64, G, c, 4};
        pg::EpiBf16 E{rstd}; pg::gemm_phase<pg::EpiBf16, pg::DenseOrder, true, true>(ring, S, E, F.wave, pr_span); }
    PE(1);
    SEAM(1);
    PB(2);
    if (IN(2)) { p_pool(F); p_fold(F); p_ych(F); }
    PE(2);
    SEAMX(2, 3);
    PB(3);
    if (IN(3)) { YFOrder S{(const char*)(ws + WS_GT), (const char*)(ws + WS_UFP), (const char*)(ws + WS_UFM), (char*)(ws + WS_YFP), (char*)(ws + WS_YFS), G, c};
        pg::EpiBf16 E{nullptr}; pg::gemm_phase<pg::EpiBf16, YFOrder, true, true>(ring, S, E, F.wave, pr_span); }
    PE(3);
    SEAMX(3, 19);
    PB(19);
    if (IN(19)) { p_alt(F);
        EOOrder S{(const char*)(ws + WS_DFTP), (const char*)(ws + WS_DFTS), (const char*)(ws + WS_YFP), (const char*)(ws + WS_YFS), (char*)(ws + WS_EB), (char*)(ws + WS_OB2), (const char*)(ws + WS_POOLED), (const char*)(ws + WS_POOLT), (char*)(ws + WS_CAT), G, c};
        pg::EpiMix E{}; pg::gemm_phase<pg::EpiMix, EOOrder, true, true>(ring, S, E, F.wave, pr_span); }
    PE(19);
    SEAMX(19, 20);
    PB(20);
    if (IN(20)) p_unfold(F);
    PE(20);
    SEAMX(20, 4);
    PB(4);
    if (IN(4)) { pg::DenseOrder S{(const char*)(ws + WS_CAT), (const char*)(ws + WS_WOE), nullptr, D * 2, D * 2, D, 4, M / 256, D / 256, D / 64, G, c, 4};
        pg::EpiResid E{xb, psum}; pg::gemm_phase<pg::EpiResid, pg::DenseOrder, true, true>(ring, S, E, F.wave, pr_span); }
    PE(4);
    SEAM(4);
    PB(5);
    PE(5);
    PB(6);
    if (IN(6)) { pg::DynOrder S{{(const char*)xb, (const char*)(ws + WS_WUP), nullptr, D * 2, D * 2, 0, 0, M / 256, NUP / 256, D / 64, G, c, 4}, F.ctl + CW_DYN, F.MISC + 16, F.wave, 1};
        pg::EpiFfnUp E{(bf16_t*)(ws + WS_ACT), (float*)(ws + WS_HALO), psum, F.in[18], F.in[19]}; pg::gemm_phase<pg::EpiFfnUp, pg::DynOrder, true, true>(ring, S, E, F.wave, pr_span);
        p_wdn_filler(F, 0, F.ctl + CW_DYN + 64 * 2); }
    PE(6);
    SEAM(6);
    PB(7);
    if (IN(7)) p_fixup(F, F.in[18], F.in[19]);
    PE(7);
    SEAM(7);
    PB(8);
    if (IN(8)) { pg::DenseOrder S{(const char*)(ws + WS_ACT), (const char*)(ws + WS_WDN), nullptr, DFF * 2, DFF * 2, D, 4, M / 256, D / 256, DFF / 64, G, c, 4};
        pg::EpiResid E{xb, psum}; pg::gemm_phase<pg::EpiResid, pg::DenseOrder, true, true>(ring, S, E, F.wave, pr_span); }
    PE(8);
    SEAM(8);
    PB(9);
    if (IN(9)) p_finalize_rstd(F);
    PE(9);
    SEAM(9);
    PB(10);
    if (IN(10)) { pg::DenseOrder S{(const char*)xb, (const char*)(ws + WS_WQKV), (char*)(ws + WS_QKV), D * 2, D * 2, NQKV, 2, M / 256, NQKV / 256, D / 64, G, c, 4};
        pg::EpiQkv E{rstd, (const float*)(ws + WS_ROT)}; pg::gemm_phase<pg::EpiQkv, pg::DenseOrder, true, true>(ring, S, E, F.wave, pr_span); }
    PE(10);
    SEAM(10);
    PB(11);
    if (IN(11)) {
        const bf16_t* qkv = (const bf16_t*)(ws + WS_QKV); bf16_t* oa = (bf16_t*)(ws + WS_OA);
        const int nun = 1024 + 2048;
        for (int i = 0;; ++i) {
            int id;
            if (G == 256) { const int x = c & 7, j = c >> 3;
                if (i < 4) id = (4 * x + i) * 32 + j;
                else if (i < 10) { const int p = 32 * x + 4 * (i - 4) + (j >> 3); id = 1024 + p * 8 + (j & 7); }
                else {
                    if (threadIdx.x == 0) F.MISC[20] = __hip_atomic_fetch_add(F.ctl + CW_DYN + 64 * 8, 1u, __ATOMIC_RELAXED, __HIP_MEMORY_SCOPE_AGENT);
                    __syncthreads();
                    const unsigned t = (unsigned)__builtin_amdgcn_readfirstlane((int)F.MISC[20]);
                    __syncthreads();
                    if (t >= 512u) break;
                    const int p = 32 * (int)(t >> 6) + 24 + (int)((t & 63u) >> 3); id = 1024 + p * 8 + (int)(t & 7u);
                }
            } else { id = i * G + c; if (id >= nun) break; }
            int row0, L, hm, qb;
            if (id < 1024) { hm = id >> 5; qb = id & 31; row0 = 0; L = LP; }
            else { const int k = id - 1024, p = k >> 3; qb = k & 7; hm = p & 31; row0 = MP + (p >> 5) * LS; L = LS; }
            const int h = hm >> 1, m = hm & 1;
            const bf16_t* Qb = qkv + (size_t)(row0 + qb * 256) * NQKV + h * 256 + m * 128;
            const bf16_t* Kh = qkv + (size_t)row0 * NQKV + D + h * 256 + m * 128;
            const bf16_t* Vh = qkv + (size_t)row0 * NQKV + 2 * D + h * 256;
            bf16_t* Ob = oa + (size_t)m * M * D + (size_t)(row0 + qb * 256) * D + 2 * (h * 256);
            at::attn256_body(Qb, Kh, Vh, Ob, L, (char*)lds + RING_OFF, F.wave);
        }
    }
    PE(11);
    SEAM(11);
    PB(12);
    if (IN(12)) p_combine(F);
    PE(12);
    SEAM(12);
    PB(13);
    if (IN(13)) { pg::DenseOrder S{(const char*)(ws + WS_OB), (const char*)(ws + WS_WOO), nullptr, D * 2, D * 2, D, 4, M / 256, D / 256, D / 64, G, c, 4};
        pg::EpiResid E{xb, psum}; pg::gemm_phase<pg::EpiResid, pg::DenseOrder, true, true>(ring, S, E, F.wave, pr_span); }
    PE(13);
    SEAM(13);
    PB(14);
    PE(14);
    PB(15);
    if (IN(15)) { pg::DynOrder S{{(const char*)xb, (const char*)(ws + WS_WUP + (size_t)NUP * D * 2), nullptr, D * 2, D * 2, 0, 0, M / 256, NUP / 256, D / 64, G, c, 4}, F.ctl + CW_DYN + 64, F.MISC + 18, F.wave, 1};
        pg::EpiFfnUp E{(bf16_t*)(ws + WS_ACT), (float*)(ws + WS_HALO), psum, F.in[18] + 3 * NUP, F.in[19] + NUP}; pg::gemm_phase<pg::EpiFfnUp, pg::DynOrder, true, true>(ring, S, E, F.wave, pr_span);
        p_wdn_filler(F, 1, F.ctl + CW_DYN + 64 * 3); }
    PE(15);
    SEAM(15);
    PB(16);
    if (IN(16)) p_fixup(F, F.in[18] + 3 * NUP, F.in[19] + NUP);
    PE(16);
    SEAM(16);
    PB(17);
    if (IN(17)) { pg::DenseOrder S{(const char*)(ws + WS_ACT), (const char*)(ws + WS_WDN + (size_t)D * DFF * 2), nullptr, DFF * 2, DFF * 2, D, 4, M / 256, D / 256, DFF / 64, G, c, 4};
        pg::EpiResid E{xb, psum}; pg::gemm_phase<pg::EpiResid, pg::DenseOrder, true, true>(ring, S, E, F.wave, pr_span); }
    PE(17);
    SEAM(17);
    PB(18);
    if (IN(18)) p_final(F);
    PE(18);
    if (PROBE_PH >= 0) { const unsigned long long te = __builtin_amdgcn_s_memrealtime(); while (__builtin_amdgcn_s_memrealtime() - te < (PROBE_CYC ? pr_span / 24 : pr_span)) __builtin_amdgcn_s_sleep(16); }
#undef PB
#undef PE
#undef IN
#undef SEAM
#undef SEAMX
}

extern "C" void kernel_launch(void* const* d_in, const int* in_sizes, int n_in, void* d_out, int out_size, void* d_ws, size_t ws_size, hipStream_t stream) {
    static int grid = 0;
    if (grid == 0) {
        if (n_in != 22 || out_size != M * D || ws_size < WS_END) { fprintf(stderr, "kernel_launch: unexpected shapes: n_in %d out %d ws %zu (need %zu)\n", n_in, out_size, ws_size, (size_t)WS_END); grid = -1; return; }
        int dev = 0, cus = 0, per_cu = 0;
        if (hipGetDevice(&dev) != hipSuccess || hipDeviceGetAttribute(&cus, hipDeviceAttributeMultiprocessorCount, dev) != hipSuccess) { grid = -1; return; }
        if (hipFuncSetAttribute((const void*)mk_fwd, hipFuncAttributeMaxDynamicSharedMemorySize, LDS_BYTES) != hipSuccess) { fprintf(stderr, "kernel_launch: hipFuncSetAttribute failed\n"); grid = -1; return; }
        if (hipOccupancyMaxActiveBlocksPerMultiprocessor(&per_cu, (const void*)mk_fwd, NTHREADS, LDS_BYTES) != hipSuccess || per_cu < 1)
            fprintf(stderr, "kernel_launch: note: occupancy query reports %d workgroups per CU\n", per_cu);
        (void)hipGetLastError();
        grid = cus;
    }
    if (grid < 0) return;
    if (hipMemsetAsync((char*)d_ws + WS_CTL, 0, CTL_ZERO_BYTES, stream) != hipSuccess) { fprintf(stderr, "kernel_launch: memset failed\n"); return; }
    Args a{};
    for (int i = 0; i < 22; ++i) a.in[i] = (const float*)d_in[i];
    a.out = (float*)d_out; a.ws = (unsigned char*)d_ws;
#if MK_N_LAUNCHES == 1
    a.ph_lo = 0; a.ph_hi = N_PHASES;
    hipLaunchKernelGGL(mk_fwd, dim3(grid), dim3(NTHREADS), LDS_BYTES, stream, a);
#else
    { static const int order[21] = {0, 1, 2, 3, 19, 20, 4, 5, 6, 7, 8, 9, 10, 11, 12, 13, 14, 15, 16, 17, 18};
      for (int p = 0; p < 21; ++p) { a.ph_lo = order[p]; a.ph_hi = order[p] + 1; hipLaunchKernelGGL(mk_fwd, dim3(grid), dim3(NTHREADS), LDS_BYTES, stream, a); } }
#endif
    const hipError_t le = hipPeekAtLastError();
    if (le != hipSuccess) fprintf(stderr, "kernel_launch: launch failed: %s\n", hipGetErrorName(le));
}
```

```cpp
#include <hip/hip_runtime.h>
#include <cstdio>
#include <cstdint>

#ifndef MK_N_LAUNCHES
#define MK_N_LAUNCHES 1
#endif

#ifndef PROBE_PH
#define PROBE_PH -1
#endif
#define GAS __attribute__((address_space(1)))
#define LAS __attribute__((address_space(3)))
typedef unsigned short bf16_t;
typedef short bf16x8 __attribute__((ext_vector_type(8)));
typedef short s16x4 __attribute__((ext_vector_type(4)));
typedef float f32x4 __attribute__((ext_vector_type(4)));
typedef float f32x2 __attribute__((ext_vector_type(2)));
typedef float f32x16 __attribute__((ext_vector_type(16)));
typedef unsigned u32x4 __attribute__((ext_vector_type(4)));
typedef unsigned u32x2 __attribute__((ext_vector_type(2)));
typedef GAS unsigned gu32;
#define RLX_AGENT __ATOMIC_RELAXED, __HIP_MEMORY_SCOPE_AGENT
#define LDS_WAIT() asm volatile("s_waitcnt lgkmcnt(0)" ::: "memory")
#define VM_WAIT() asm volatile("s_waitcnt vmcnt(0)" ::: "memory")

constexpr int D = 4096, LP = 8192, NSS = 8, LS = 2048, MP = LP, M = LP + NSS * LS;
constexpr int POOL_DIM = 3072, PG = 768, FD = 1024, FH = 256;
constexpr int DFF = 11008, NUP = 2 * DFF, NQKV = 3 * D;
constexpr float NORM_EPS = 1e-6f, SUBLN_EPS = 1e-5f;
constexpr float LAMBDA_INIT = 0.35550906759096327f;
constexpr int NWAVES = 8, NTHREADS = 512;

constexpr size_t MiB = 1u << 20;
constexpr size_t al256(size_t x) { return (x + 255) / 256 * 256; }
constexpr size_t WS_CTL = 0, CTL_ZERO_BYTES = 65536;
constexpr size_t WS_ROT = WS_CTL + CTL_ZERO_BYTES;
constexpr size_t WS_RSTD = WS_ROT + (size_t)LP * 32 * 4;
constexpr size_t WS_PSUM = WS_RSTD + al256((size_t)M * 4);
constexpr size_t WS_WIN = WS_PSUM + (size_t)M * 64 * 4;
constexpr size_t WS_GT = WS_WIN + (size_t)D * D * 2;
constexpr size_t WS_POOLT = WS_GT + (size_t)2048 * 1024 * 2;
constexpr size_t WS_WOE = WS_POOLT + (size_t)4 * PG * PG * 2;
constexpr size_t WS_WQKV = WS_WOE + (size_t)D * D * 2;
constexpr size_t WS_WOO = WS_WQKV + (size_t)NQKV * D * 2;
constexpr size_t WS_WUP = WS_WOO + (size_t)D * D * 2;
constexpr size_t WS_WDN = WS_WUP + (size_t)2 * NUP * D * 2;
constexpr int HP = LP / 2, HS = LS / 2, MH = M / 2;
constexpr size_t WS_DFTP = WS_WDN + (size_t)2 * D * DFF * 2;
constexpr size_t WS_DFTS = WS_DFTP + (size_t)2 * HP * HP * 2;
constexpr size_t WS_XB = WS_DFTS + (size_t)2 * HS * HS * 2;
constexpr size_t WS_OV = WS_XB + (size_t)M * D * 2;
constexpr size_t WS_U = WS_OV;
constexpr size_t WS_POOLED = WS_U + (size_t)M * D * 2;
constexpr size_t WS_CAT = WS_POOLED + (size_t)M * POOL_DIM * 2;
constexpr size_t WS_UFP = WS_CAT + (size_t)M * D * 2;
constexpr size_t WS_UFM = WS_UFP + (size_t)MH * FD * 2;
constexpr size_t WS_YFP = WS_UFM + (size_t)MH * FD * 2;
constexpr size_t WS_YFS = WS_YFP + (size_t)2 * FD * HP * 2;
constexpr size_t WS_EB = WS_YFS + (size_t)NSS * 2 * FD * HS * 2;
constexpr size_t WS_OB2 = WS_EB + (size_t)MH * FD * 4;
constexpr size_t WS_YCH = WS_OB2 + (size_t)MH * FD * 4;
constexpr size_t WS_ALT = WS_YCH + (size_t)9 * FD * 4;
constexpr size_t WS_OV_END0 = WS_ALT + (size_t)9 * FD * 4;
constexpr size_t WS_ACT = WS_OV;
constexpr size_t WS_HALO = WS_ACT + (size_t)M * DFF * 2;
constexpr size_t WS_OV_END1 = WS_HALO + (size_t)(M / 128) * 4 * NUP * 4;
constexpr size_t WS_QKV = WS_OV;
constexpr size_t WS_OA = WS_QKV + (size_t)M * NQKV * 2;
constexpr size_t WS_OV_END2 = WS_OA + (size_t)2 * M * D * 2;
constexpr size_t WS_OB = WS_QKV;
constexpr size_t WS_END = WS_OV_END2 > WS_OV_END1 ? (WS_OV_END2 > WS_OV_END0 ? WS_OV_END2 : WS_OV_END0) : (WS_OV_END1 > WS_OV_END0 ? WS_OV_END1 : WS_OV_END0);
static_assert(WS_END <= (size_t)4 * 2 * D * NUP * 4, "workspace must fit 4 x the largest input tensor");

constexpr int CW_TMO = 0, CW_LAM = 64  , CW_BAR = 4096, CW_DYN = 8192  ;

constexpr int RING_OFF = 0, RING_BYTES = 131072;
constexpr int LDS_BYTES = 147456;
constexpr int LDSCTL_OFF = LDS_BYTES - 1024, MISC_OFF = LDSCTL_OFF + 320;

__device__ __forceinline__ unsigned f2bf(float f) { unsigned u = __builtin_bit_cast(unsigned, f); return (u + 0x7fffu + ((u >> 16) & 1u)) >> 16; }
__device__ __forceinline__ unsigned pk2(float lo, float hi) { return f2bf(lo) | (f2bf(hi) << 16); }
__device__ __forceinline__ unsigned cvt_pk_bf16(float lo, float hi) { unsigned r; asm volatile("v_cvt_pk_bf16_f32 %0, %1, %2" : "=v"(r) : "v"(lo), "v"(hi)); return r; }
__device__ __forceinline__ float bf2f(unsigned short b) { return __builtin_bit_cast(float, (unsigned)b << 16); }
__device__ __forceinline__ int tid_opaque(int wave) { int l; asm volatile("v_mbcnt_lo_u32_b32 %0, -1, 0\n\tv_mbcnt_hi_u32_b32 %0, -1, %0" : "=v"(l)); return wave * 64 + l; }
__device__ __forceinline__ float wave_sum(float v) {
#pragma unroll
    for (int o = 1; o < 64; o <<= 1) v += __shfl_xor(v, o);
    return v;
}

#define XB_TMO      128
#define XB_XCNT(j)  (256  + 64 * (j))
#define XB_XSUB(j)  (1280 + 64 * (j))
#define XB_XGEN(j)  (2304 + 64 * (j))
#define XB_TOP      3328
#define XB_TOPGEN   3392
#define XCD_BAR_WORDS 3456
#define XB_SPIN_CAP (1u << 18)
__device__ __forceinline__ unsigned xb_ld(unsigned* p)              { return __hip_atomic_load(p, __ATOMIC_RELAXED, __HIP_MEMORY_SCOPE_AGENT); }
__device__ __forceinline__ unsigned xb_add(unsigned* p, unsigned v) { return __hip_atomic_fetch_add(p, v, __ATOMIC_RELAXED, __HIP_MEMORY_SCOPE_AGENT); }
__device__ __forceinline__ unsigned xb_xcc_id() { return (unsigned)__builtin_amdgcn_s_getreg((3 << 11) | 20) & 0xFu; }
#define XB_SPIN(cond, bar) do { unsigned _sp = 0; while (cond) { __builtin_amdgcn_s_sleep(1); \
    if ((++_sp & 255u) == 0u) { if (xb_ld(&(bar)[XB_TMO])) break; if (_sp > XB_SPIN_CAP) { atomicAdd(&(bar)[XB_TMO], 1u); break; } } } } while (0)
struct XcdBarrier { unsigned* bar; unsigned x; volatile LAS unsigned* st; };
__device__ __forceinline__ XcdBarrier xcd_barrier_post(unsigned* bar, volatile LAS unsigned* st) {
    XcdBarrier b; b.bar = bar; b.x = xb_xcc_id(); b.st = st;
    if (threadIdx.x == 0) (void)xb_add(&bar[XB_XCNT(b.x)], 1u);
    return b;
}
__device__ __forceinline__ void xcd_barrier_complete(unsigned* bar, unsigned x, unsigned& nloc, unsigned& nx) {
    const unsigned G = gridDim.x * gridDim.y * gridDim.z;
    unsigned sum, cnt, mine, sp = 0u;
    for (;;) {
        sum = 0u; cnt = 0u; mine = 0u;
#pragma unroll
        for (unsigned j = 0; j < 16; ++j) { const unsigned c = xb_ld(&bar[XB_XCNT(j)]); sum += c; cnt += (c > 0u) ? 1u : 0u; mine = (j == x) ? c : mine; }
        if (sum == G) break;
        __builtin_amdgcn_s_sleep(1);
        if ((++sp & 255u) == 0u) { if (xb_ld(&bar[XB_TMO])) break; if (sp > XB_SPIN_CAP) { atomicAdd(&bar[XB_TMO], 1u); break; } }
    }
    nloc = mine > 0u ? mine : 1u; nx = cnt > 0u ? cnt : 1u;
}
__device__ __forceinline__ void xcd_barrier(const XcdBarrier& b) {
    asm volatile("s_waitcnt vmcnt(0)" ::: "memory");
    __syncthreads();
    if (threadIdx.x == 0) {
        unsigned* bar = b.bar;
        __builtin_amdgcn_s_waitcnt(0);
        unsigned nloc = b.st[0], nx = b.st[1];
        if (nloc == 0u) { xcd_barrier_complete(bar, b.x, nloc, nx); b.st[0] = nloc; b.st[1] = nx; }
        const unsigned old = xb_add(&bar[XB_XSUB(b.x)], 1u);
        const unsigned gen = old / nloc;
        if (old + 1u == (gen + 1u) * nloc) {
            __builtin_amdgcn_fence(__ATOMIC_RELEASE, "agent");
            asm volatile("s_waitcnt vmcnt(0)" ::: "memory");
            const unsigned og = xb_add(&bar[XB_TOP], 1u);
            const unsigned tg = og / nx;
            if (og + 1u == (tg + 1u) * nx) xb_add(&bar[XB_TOPGEN], 1u);
            else XB_SPIN(xb_ld(&bar[XB_TOPGEN]) == tg, bar);
            __builtin_amdgcn_fence(__ATOMIC_ACQUIRE, "agent");
            xb_add(&bar[XB_XGEN(b.x)], 1u);
            asm volatile("s_waitcnt vmcnt(0)" ::: "memory");
        } else {
            XB_SPIN(xb_ld(&bar[XB_XGEN(b.x)]) == gen, bar);
            __builtin_amdgcn_fence(__ATOMIC_ACQUIRE, "agent");
            asm volatile("s_waitcnt vmcnt(0)" ::: "memory");
        }
    }
    __syncthreads();
}

namespace pg {
constexpr int BM = 256, BK = 64, HALF = 128, HTB = HALF * BK * 2, STAGE_BYTES = 8 * HTB;
__host__ __device__ __forceinline__ int lds_byte(int r, int c) { const int st = (r >> 4) * 2 + (c >> 5), rr = r & 15, cc = c & 31, ob = rr * 64 + cc * 2; return st * 1024 + (ob ^ (((ob >> 9) & 1) << 5)); }
__host__ __device__ __forceinline__ void stage_rc(int b, int& R, int& C) { const int st = b / 1024, sb = b % 1024, swz = sb ^ (((sb >> 9) & 1) << 5); R = (st >> 1) * 16 + swz / 64; C = (st & 1) * 32 + (swz % 64) / 2; }
__host__ __device__ __forceinline__ int perm32(int rho) { const int n = rho >> 4, i = rho & 15; return 8 * (i >> 2) + 4 * n + (i & 3); }
__host__ __device__ __forceinline__ int rowperm(int rho) { return (rho >> 6) * 128 + (rho & 15) * 8 + ((rho >> 4) & 3); }

struct GUnit {
    const char* A; const char* B;
    unsigned lda, ldb;
    int nt;
    char* C; unsigned ldc;
    int grow0, gcol0;
    int aux;
};

struct EpiBf16 {
    static constexpr bool PERM = true, ROWPERM = false, PREFETCH = false;
    const float* rstd;
    __device__ __forceinline__ void operator()(f32x4 (&acc)[2][2][4][2], const GUnit& u, int wr, int wc, int fr, int fq) const {
        bf16_t* base = (bf16_t*)u.C + wc * 32 + 8 * fq;
#pragma unroll
        for (int ai = 0; ai < 2; ++ai)
#pragma unroll
            for (int m = 0; m < 4; ++m) {
                const int r = ai * HALF + wr * 64 + m * 16 + fr;
                const float s = rstd ? rstd[u.grow0 + r] : 1.0f;
                bf16_t* rowp = base + (size_t)r * u.ldc;
#pragma unroll
                for (int bj = 0; bj < 2; ++bj) { const f32x4 v0 = acc[ai][bj][m][0] * s, v1 = acc[ai][bj][m][1] * s;
                    u32x4 w; w.x = cvt_pk_bf16(v0[0], v0[1]); w.y = cvt_pk_bf16(v0[2], v0[3]); w.z = cvt_pk_bf16(v1[0], v1[1]); w.w = cvt_pk_bf16(v1[2], v1[3]);
                    *(u32x4*)(rowp + bj * HALF) = w; }
            }
    }
};
struct EpiMix {
    static constexpr bool PERM = true, ROWPERM = false, PREFETCH = false;
    __device__ __forceinline__ void operator()(f32x4 (&acc)[2][2][4][2], const GUnit& u, int wr, int wc, int fr, int fq) const {
        if (u.aux == 0) {
            bf16_t* base = (bf16_t*)u.C + wc * 32 + 8 * fq;
#pragma unroll
            for (int ai = 0; ai < 2; ++ai)
#pragma unroll
                for (int m = 0; m < 4; ++m) { bf16_t* rowp = base + (size_t)(ai * HALF + wr * 64 + m * 16 + fr) * u.ldc;
#pragma unroll
                    for (int bj = 0; bj < 2; ++bj) { const f32x4 v0 = acc[ai][bj][m][0], v1 = acc[ai][bj][m][1];
                        u32x4 w; w.x = cvt_pk_bf16(v0[0], v0[1]); w.y = cvt_pk_bf16(v0[2], v0[3]); w.z = cvt_pk_bf16(v1[0], v1[1]); w.w = cvt_pk_bf16(v1[2], v1[3]);
                        *(u32x4*)(rowp + bj * HALF) = w; } }
        } else {
            float* base = (float*)u.C + wc * 32 + 8 * fq;
#pragma unroll
            for (int ai = 0; ai < 2; ++ai)
#pragma unroll
                for (int m = 0; m < 4; ++m) { float* rowp = base + (size_t)(ai * HALF + wr * 64 + m * 16 + fr) * u.ldc;
#pragma unroll
                    for (int bj = 0; bj < 2; ++bj) { *(f32x4*)(rowp + bj * HALF) = acc[ai][bj][m][0]; *(f32x4*)(rowp + bj * HALF + 4) = acc[ai][bj][m][1]; } }
        }
    }
};
struct EpiResid {
    static constexpr bool PERM = true, ROWPERM = false, PREFETCH = false;
    bf16_t* xb; float* psum;
    __device__ __forceinline__ void operator()(f32x4 (&acc)[2][2][4][2], const GUnit& u, int wr, int wc, int fr, int fq) const {
        const int c0 = u.gcol0 + wc * 32 + 8 * fq;
        bf16_t* base = xb + (size_t)u.grow0 * D + c0;
#pragma unroll
        for (int ai = 0; ai < 2; ++ai) {
            u32x4 old[4][2];
#pragma unroll
            for (int m = 0; m < 4; ++m)
#pragma unroll
                for (int bj = 0; bj < 2; ++bj) old[m][bj] = *(const u32x4*)(base + (size_t)(ai * HALF + wr * 64 + m * 16 + fr) * D + bj * HALF);
#pragma unroll
            for (int m = 0; m < 4; ++m) {
                const int r = ai * HALF + wr * 64 + m * 16 + fr;
                float ss = 0.f;
#pragma unroll
                for (int bj = 0; bj < 2; ++bj) {
                    const u32x4 w0 = old[m][bj];
                    const f32x4 o0 = {bf2f(w0.x & 0xffff), bf2f(w0.x >> 16), bf2f(w0.y & 0xffff), bf2f(w0.y >> 16)}, o1 = {bf2f(w0.z & 0xffff), bf2f(w0.z >> 16), bf2f(w0.w & 0xffff), bf2f(w0.w >> 16)};
                    const f32x4 v0 = acc[ai][bj][m][0] + o0, v1 = acc[ai][bj][m][1] + o1;
                    u32x4 w; w.x = cvt_pk_bf16(v0[0], v0[1]); w.y = cvt_pk_bf16(v0[2], v0[3]); w.z = cvt_pk_bf16(v1[0], v1[1]); w.w = cvt_pk_bf16(v1[2], v1[3]);
                    *(u32x4*)(base + (size_t)r * D + bj * HALF) = w;
                    ss += (v0[0] * v0[0] + v0[1] * v0[1]) + (v0[2] * v0[2] + v0[3] * v0[3]) + (v1[0] * v1[0] + v1[1] * v1[1]) + (v1[2] * v1[2] + v1[3] * v1[3]);
                }
                ss += __shfl_xor(ss, 16); ss += __shfl_xor(ss, 32);
                if (fq == 0) psum[(size_t)(u.grow0 + r) * 64 + (u.gcol0 >> 8) * 4 + wc] = ss;
            }
            asm volatile("" ::: "memory");
        }
    }
};
struct EpiFfnUp {
    static constexpr bool PERM = true, ROWPERM = true, PREFETCH = true;
    bf16_t* act; float* halo; const float* rstd; const float* cw; const float* cb;
    static constexpr int PAR_BYTES = 5120;
    __device__ __forceinline__ void prefetch(const GUnit& u, LAS unsigned char* par, int wid, int lane) const {
        if (wid == 0) __builtin_amdgcn_global_load_lds((const unsigned*)(rstd + u.grow0 + lane * 4), (LAS unsigned*)(par), 16, 0, 0);
        else if (wid < 5) { const int a = 2 * (wid - 1) + (lane >> 5), cg = (u.gcol0 >> 1) + (lane & 31) * 4;
            const float* src = ((a & 3) == 3 ? cb : cw + (size_t)(a & 3) * NUP) + (a >> 2) * DFF + cg;
            __builtin_amdgcn_global_load_lds((const unsigned*)src, (LAS unsigned*)(par + 1024 + (wid - 1) * 1024), 16, 0, 0); }
    }
    __device__ __forceinline__ void operator()(f32x4 (&acc)[2][2][4][2], const GUnit& u, int wr, int wc, int fr, int fq, const LAS unsigned char* par) const {
        const int t0 = u.grow0 + wr * 128 + fr * 8;
        const int c0 = (u.gcol0 >> 1) + wc * 32 + 8 * fq;
        const int cl = wc * 32 + 8 * fq;
        {   const LAS f32x4* rp = (const LAS f32x4*)(par + (wr * 128 + fr * 8) * 4); const f32x4 ra = rp[0], rb = rp[1];
#pragma unroll
            for (int bj = 0; bj < 2; ++bj)
#pragma unroll
                for (int n = 0; n < 2; ++n) {
#pragma unroll
                    for (int m = 0; m < 4; ++m) { acc[0][bj][m][n] *= ra[m]; acc[1][bj][m][n] *= rb[m]; } } }
        const int blk = (u.grow0 >> 7) + wr;
        if (fr == 0 || fr == 15) {
            float* hp = halo + (size_t)blk * 4 * NUP + (fr == 0 ? 0 : 2 * NUP);
#pragma unroll
            for (int bj = 0; bj < 2; ++bj)
#pragma unroll
                for (int n = 0; n < 2; ++n) {
                    const f32x4 e0 = (fr == 0) ? acc[0][bj][0][n] : acc[1][bj][2][n];
                    const f32x4 e1 = (fr == 0) ? acc[0][bj][1][n] : acc[1][bj][3][n];
                    *(f32x4*)(hp + bj * DFF + c0 + 4 * n) = e0; *(f32x4*)(hp + NUP + bj * DFF + c0 + 4 * n) = e1; }
        }
        unsigned pk[8][4];
#pragma unroll
        for (int n = 0; n < 2; ++n) {
            const LAS f32x4* wp = (const LAS f32x4*)(par + 1024 + (cl + 4 * n) * 4);
            const f32x4 g0 = wp[0], g1 = wp[32], g2 = wp[64], gb = wp[96], u0 = wp[128], u1 = wp[160], u2 = wp[192], ub = wp[224];
            f32x4 gm1, gp8, um1, up8;
#pragma unroll
            for (int q = 0; q < 4; ++q) { gm1[q] = __shfl_up(acc[1][0][3][n][q], 1, 16); gp8[q] = __shfl_down(acc[0][0][0][n][q], 1, 16);
                                          um1[q] = __shfl_up(acc[1][1][3][n][q], 1, 16); up8[q] = __shfl_down(acc[0][1][0][n][q], 1, 16); }
#pragma unroll
            for (int j = 0; j < 8; ++j) {
                const f32x4 gl = (j == 0) ? gm1 : acc[(j + 7) >> 2 & 1][0][(j + 7) & 3][n], gc = acc[j >> 2][0][j & 3][n], gr = (j == 7) ? gp8 : acc[((j + 1) >> 2) & 1][0][(j + 1) & 3][n];
                const f32x4 ul = (j == 0) ? um1 : acc[(j + 7) >> 2 & 1][1][(j + 7) & 3][n], uc = acc[j >> 2][1][j & 3][n], ur = (j == 7) ? up8 : acc[((j + 1) >> 2) & 1][1][(j + 1) & 3][n];
                const f32x4 yg = __builtin_elementwise_fma(gr, g2, __builtin_elementwise_fma(gc, g1, __builtin_elementwise_fma(gl, g0, gb)));
                const f32x4 yu = __builtin_elementwise_fma(ur, u2, __builtin_elementwise_fma(uc, u1, __builtin_elementwise_fma(ul, u0, ub)));
                const f32x4 e = yg * (-1.4426950408889634f);
                f32x4 a;
#pragma unroll
                for (int q = 0; q < 4; ++q) a[q] = __builtin_amdgcn_rcpf(1.0f + __builtin_amdgcn_exp2f(e[q]));
                a = a * yg * yu;
                pk[j][2 * n] = cvt_pk_bf16(a[0], a[1]); pk[j][2 * n + 1] = cvt_pk_bf16(a[2], a[3]);
            }
        }
#pragma unroll
        for (int j = 0; j < 8; ++j) {
            const bool edge = (j == 0 && fr == 0) || (j == 7 && fr == 15);
            if (!edge) { u32x4 w; w.x = pk[j][0]; w.y = pk[j][1]; w.z = pk[j][2]; w.w = pk[j][3]; *(u32x4*)(act + (size_t)(t0 + j) * DFF + c0) = w; }
        }
    }
};
struct EpiQkv {
    static constexpr bool PERM = true, ROWPERM = false, PREFETCH = false;
    const float* rstd; const float* rot;
    __device__ __forceinline__ void operator()(f32x4 (&acc)[2][2][4][2], const GUnit& u, int wr, int wc, int fr, int fq) const {
        bf16_t* base = (bf16_t*)u.C + wc * 32 + 8 * fq;
        const bool rotary = (u.gcol0 < 2 * D) && (wc == 0);
#pragma unroll
        for (int ai = 0; ai < 2; ++ai)
#pragma unroll
            for (int m = 0; m < 4; ++m) {
                const int r = ai * HALF + wr * 64 + m * 16 + fr, gr = u.grow0 + r;
                const float s = rstd[gr];
                f32x4 v[2][2];
#pragma unroll
                for (int bj = 0; bj < 2; ++bj)
#pragma unroll
                    for (int n = 0; n < 2; ++n) v[bj][n] = acc[ai][bj][m][n] * s;
                if (rotary) {
                    const int pos = (gr < MP) ? gr : (gr & (LS - 1));
                    const float* rp = rot + (size_t)pos * 32 + 8 * (fq & 1);
                    const float sgn = (fq < 2) ? -1.0f : 1.0f;
#pragma unroll
                    for (int n = 0; n < 2; ++n) { const f32x4 cs = *(const f32x4*)(rp + 4 * n), sn = *(const f32x4*)(rp + 16 + 4 * n);
#pragma unroll
                        for (int bj = 0; bj < 2; ++bj) { f32x4 p;
#pragma unroll
                            for (int q = 0; q < 4; ++q) p[q] = __shfl_xor(v[bj][n][q], 32);
                            v[bj][n] = v[bj][n] * cs + p * (sn * sgn); } }
                }
                bf16_t* rowp = base + (size_t)r * u.ldc;
#pragma unroll
                for (int bj = 0; bj < 2; ++bj) { u32x4 w; w.x = cvt_pk_bf16(v[bj][0][0], v[bj][0][1]); w.y = cvt_pk_bf16(v[bj][0][2], v[bj][0][3]); w.z = cvt_pk_bf16(v[bj][1][0], v[bj][1][1]); w.w = cvt_pk_bf16(v[bj][1][2], v[bj][1][3]);
                    *(u32x4*)(rowp + bj * HALF) = w; }
            }
    }
};

template <class Epi, class Sched, bool ALIGN_EPI, bool SP2>
__device__ __forceinline__ void gemm_phase(LAS unsigned char* lds, const Sched& S, const Epi& E, const int wid, unsigned long long& epi_ticks) {
    const int tid = tid_opaque(wid), lane = tid & 63, wr = wid >> 2, wc = wid & 3, fr = lane & 15, fq = lane >> 4;
    unsigned RA[2], RB[2], C2[2];
#pragma unroll
    for (int i = 0; i < 2; ++i) { int R, C; stage_rc(tid * 16 + i * 8192, R, C);
        RA[i] = (unsigned)(Epi::ROWPERM ? rowperm(R) : R); RB[i] = (unsigned)(Epi::PERM ? ((R & ~31) + perm32(R & 31)) : R); C2[i] = (unsigned)C * 2u; }
    constexpr unsigned HROWS_A = Epi::ROWPERM ? 4u : 128u;
    const size_t kstep = (size_t)(BK * 2);
    const unsigned ldsw = (unsigned)wid * 1024u;
    const int aoff = lds_byte(wr * 64 + fr, fq * 8), boff = lds_byte(wc * 32 + fr, fq * 8);
#define PG_SA(b, h) (((b) * 2 + (h)) * HTB)
#define PG_SB(b, h) ((4 + (b) * 2 + (h)) * HTB)
#define PG_STAGE(bufoff, gbase, R, ld) do { _Pragma("unroll") for (int _i = 0; _i < 2; ++_i) \
        __builtin_amdgcn_global_load_lds((const unsigned*)((gbase) + (size_t)((R)[_i] * (ld) + C2[_i])), (LAS unsigned*)(lds + (bufoff) + ldsw + _i * 8192), 16, 0, 0); } while (0)
#define PG_LDA(dst, b, h) do { _Pragma("unroll") for (int m = 0; m < 4; ++m) _Pragma("unroll") for (int k = 0; k < 2; ++k) dst[m][k] = *(const LAS bf16x8*)(lds + PG_SA(b, h) + aoff + m * 2048 + k * 1024); } while (0)
#define PG_LDB(dst, b, h) do { _Pragma("unroll") for (int n = 0; n < 2; ++n) _Pragma("unroll") for (int k = 0; k < 2; ++k) dst[n][k] = *(const LAS bf16x8*)(lds + PG_SB(b, h) + boff + n * 2048 + k * 1024); } while (0)
#define PG_MMA(ai, bj, At, Bt) do { __builtin_amdgcn_s_setprio(1); _Pragma("unroll") for (int m = 0; m < 4; ++m) _Pragma("unroll") for (int n = 0; n < 2; ++n) _Pragma("unroll") for (int k = 0; k < 2; ++k) \
        acc[ai][bj][m][n] = __builtin_amdgcn_mfma_f32_16x16x32_bf16(Bt[n][k], At[m][k], acc[ai][bj][m][n], 0, 0, 0); __builtin_amdgcn_s_setprio(0); } while (0)
#define PG_WAIT_V(n) asm volatile("s_waitcnt vmcnt(" #n ")" ::: "memory")
#define PG_WAIT_L(n) asm volatile("s_waitcnt lgkmcnt(" #n ")" ::: "memory")
#define PG_BAR __builtin_amdgcn_s_barrier()
#define PG_SCHED __builtin_amdgcn_sched_barrier(0)
    GUnit cur, nxt; int ui = 0;
    if (!S.next(0, cur)) return;
    f32x4 acc[2][2][4][2];
#pragma unroll
    for (int a = 0; a < 2; ++a)
#pragma unroll
        for (int b = 0; b < 2; ++b)
#pragma unroll
            for (int m = 0; m < 4; ++m)
#pragma unroll
                for (int n = 0; n < 2; ++n) acc[a][b][m][n] = (f32x4){0.f, 0.f, 0.f, 0.f};
    bf16x8 At[4][2], B0[2][2], B1[2][2];
    const char* cA = cur.A; const char* cB = cur.B; unsigned lda = cur.lda, ldb = cur.ldb; int nt = cur.nt;
    LAS unsigned char* const par = lds + STAGE_BYTES;
    if constexpr (Epi::PREFETCH) E.prefetch(cur, par, wid, lane);
    {   const size_t hA = (size_t)HROWS_A * lda, hB = (size_t)128 * ldb;
        if constexpr (SP2) {
            PG_STAGE(PG_SB(0, 0), cB, RB, ldb); PG_STAGE(PG_SB(0, 1), cB + hB, RB, ldb); PG_STAGE(PG_SA(0, 0), cA, RA, lda); PG_STAGE(PG_SA(0, 1), cA + hA, RA, lda);
            if (wr == 1) PG_BAR;
            PG_WAIT_V(2); PG_BAR;
            PG_STAGE(PG_SB(1, 0), cB + kstep, RB, ldb); PG_STAGE(PG_SA(1, 0), cA + kstep, RA, lda); PG_STAGE(PG_SB(1, 1), cB + hB + kstep, RB, ldb);
            PG_WAIT_V(6); PG_BAR;
        } else {
            PG_STAGE(PG_SB(0, 0), cB, RB, ldb); PG_STAGE(PG_SA(0, 0), cA, RA, lda); PG_STAGE(PG_SB(0, 1), cB + hB, RB, ldb); PG_STAGE(PG_SA(0, 1), cA + hA, RA, lda);
            if (wr == 1) PG_BAR;
            PG_WAIT_V(4); PG_BAR;
            PG_STAGE(PG_SB(1, 0), cB + kstep, RB, ldb); PG_STAGE(PG_SA(1, 0), cA + kstep, RA, lda); PG_STAGE(PG_SB(1, 1), cB + hB + kstep, RB, ldb);
            PG_WAIT_V(6); PG_BAR;
        }
    }
    for (;;) {
        const bool has_next = S.next(ui + 1, nxt);
        const char* nA = has_next ? nxt.A : cA; const char* nB = has_next ? nxt.B : cB;
        const unsigned nlda = has_next ? nxt.lda : lda, nldb = has_next ? nxt.ldb : ldb;
        const size_t hA = (size_t)HROWS_A * lda, hB = (size_t)128 * ldb;
        for (int t = 0; t < nt; t += 2) {
            const bool last = (t == nt - 2);
            const char* a1 = cA + (size_t)(t + 1) * kstep;
            const char* a2 = last ? nA : cA + (size_t)(t + 2) * kstep; const char* b2 = last ? nB : cB + (size_t)(t + 2) * kstep;
            const unsigned lda2 = last ? nlda : lda, ldb2 = last ? nldb : ldb;
            const size_t hA2 = (size_t)HROWS_A * lda2, hB2 = (size_t)128 * ldb2;
            const char* a3 = a2 + kstep; const char* b3 = b2 + kstep;
            if constexpr (SP2) {
            PG_LDB(B0, 0, 0); PG_LDB(B1, 0, 1); PG_SCHED; PG_LDA(At, 0, 0); PG_STAGE(PG_SA(1, 1), a1 + hA, RA, lda);
            PG_WAIT_V(8); PG_WAIT_L(0); PG_BAR; PG_MMA(0, 0, At, B0); PG_MMA(0, 1, At, B1); PG_BAR; PG_SCHED;
            PG_LDA(At, 0, 1); PG_STAGE(PG_SB(0, 0), b2, RB, ldb2); PG_STAGE(PG_SB(0, 1), b2 + hB2, RB, ldb2); PG_STAGE(PG_SA(0, 0), a2, RA, lda2);
            PG_WAIT_V(8); PG_WAIT_L(0); PG_BAR; PG_MMA(1, 0, At, B0); PG_MMA(1, 1, At, B1); PG_BAR; PG_SCHED;
            PG_LDB(B0, 1, 0); PG_LDB(B1, 1, 1); PG_SCHED; PG_LDA(At, 1, 0); PG_STAGE(PG_SA(0, 1), a2 + hA2, RA, lda2);
            PG_WAIT_V(8); PG_WAIT_L(0); PG_BAR; PG_MMA(0, 0, At, B0); PG_MMA(0, 1, At, B1); PG_BAR; PG_SCHED;
            PG_LDA(At, 1, 1); PG_STAGE(PG_SB(1, 0), b3, RB, ldb2); PG_STAGE(PG_SB(1, 1), b3 + hB2, RB, ldb2); PG_STAGE(PG_SA(1, 0), a3, RA, lda2);
            PG_WAIT_V(8); PG_WAIT_L(0); PG_BAR; PG_MMA(1, 0, At, B0); PG_MMA(1, 1, At, B1); PG_BAR; PG_SCHED;
            } else {
            PG_LDB(B0, 0, 0); PG_SCHED; PG_LDA(At, 0, 0); PG_STAGE(PG_SA(1, 1), a1 + hA, RA, lda);
            PG_WAIT_L(8); PG_BAR; PG_WAIT_L(0); PG_MMA(0, 0, At, B0); PG_BAR; PG_SCHED;
            PG_LDB(B1, 0, 1); PG_STAGE(PG_SB(0, 0), b2, RB, ldb2);
            PG_BAR; PG_WAIT_L(0); PG_MMA(0, 1, At, B1); PG_BAR;
            PG_LDA(At, 0, 1); PG_STAGE(PG_SA(0, 0), a2, RA, lda2);
            PG_BAR; PG_WAIT_L(0); PG_MMA(1, 0, At, B0); PG_BAR; PG_SCHED;
            PG_STAGE(PG_SB(0, 1), b2 + hB2, RB, ldb2);
            PG_WAIT_V(6); PG_BAR; PG_MMA(1, 1, At, B1); PG_BAR;
            PG_LDB(B0, 1, 0); PG_SCHED; PG_LDA(At, 1, 0); PG_STAGE(PG_SA(0, 1), a2 + hA2, RA, lda2);
            PG_WAIT_L(8); PG_BAR; PG_WAIT_L(0); PG_MMA(0, 0, At, B0); PG_BAR; PG_SCHED;
            PG_LDB(B1, 1, 1); PG_STAGE(PG_SB(1, 0), b3, RB, ldb2);
            PG_BAR; PG_WAIT_L(0); PG_MMA(0, 1, At, B1); PG_BAR;
            PG_LDA(At, 1, 1); PG_STAGE(PG_SA(1, 0), a3, RA, lda2);
            PG_BAR; PG_WAIT_L(0); PG_MMA(1, 0, At, B0); PG_BAR; PG_SCHED;
            PG_STAGE(PG_SB(1, 1), b3 + hB2, RB, ldb2);
            PG_WAIT_V(6); PG_BAR; PG_MMA(1, 1, At, B1); PG_BAR;
            }
        }
        if constexpr (ALIGN_EPI) { if (wr == 0) PG_BAR; }
        if constexpr (Epi::PREFETCH) { E(acc, cur, wr, wc, fr, fq, par + (ui & 1) * Epi::PAR_BYTES); if (has_next) E.prefetch(nxt, par + ((ui + 1) & 1) * Epi::PAR_BYTES, wid, lane); }
        else E(acc, cur, wr, wc, fr, fq);
        if (!has_next) break;
#pragma unroll
        for (int a = 0; a < 2; ++a)
#pragma unroll
            for (int b = 0; b < 2; ++b)
#pragma unroll
                for (int m = 0; m < 4; ++m)
#pragma unroll
                    for (int n = 0; n < 2; ++n) acc[a][b][m][n] = (f32x4){0.f, 0.f, 0.f, 0.f};
        cur = nxt; cA = nA; cB = nB; lda = nlda; ldb = nldb; nt = cur.nt; ++ui;
        if constexpr (ALIGN_EPI) { if (wr == 1) PG_BAR; }
    }
    PG_WAIT_V(0);
    if constexpr (!ALIGN_EPI) { if (wr == 0) PG_BAR; }
    PG_BAR;
#undef PG_SA
#undef PG_SB
#undef PG_STAGE
#undef PG_LDA
#undef PG_LDB
#undef PG_MMA
#undef PG_WAIT_V
#undef PG_WAIT_L
#undef PG_BAR
#undef PG_SCHED
}

struct DenseOrder {
    const char* A; const char* B; char* C; unsigned lda, ldb, ldc; int csz; int nM, nN, nt, G, c; int gs = 8;
    __device__ __forceinline__ bool next(int i, GUnit& u) const {
        const int nwg = nM * nN; const long L = (long)i * G + c; if (L >= nwg) return false;
        int wgid = (int)L; { const int q = nwg / 8, r = nwg % 8, xcd = wgid % 8, off = wgid / 8; wgid = (xcd < r ? xcd * (q + 1) : r * (q + 1) + (xcd - r) * q) + off; }
        const int nig = gs * nN, gid = wgid / nig, fm = gid * gs, gsz = (nM - fm) < gs ? (nM - fm) : gs;
        const int pm = fm + ((wgid % nig) % gsz), pn = (wgid % nig) / gsz;
        u.A = A + (size_t)pm * 256 * lda; u.B = B + (size_t)pn * 256 * ldb; u.lda = lda; u.ldb = ldb; u.nt = nt;
        u.C = C + ((size_t)pm * 256 * ldc + (size_t)pn * 256) * csz; u.ldc = ldc; u.grow0 = pm * 256; u.gcol0 = pn * 256; u.aux = 0;
        return true;
    }
};
struct DynOrder : DenseOrder {
    unsigned* ctr; volatile LAS unsigned* slot; int wave; int dynr;
    __device__ __forceinline__ bool next(int i, GUnit& u) const {
        const int nwg = nM * nN, sr = nwg / G - dynr, left = nwg - sr * G;
        if (i + 1 >= sr && wave == 0) {
            unsigned t = 0u; if (threadIdx.x == 0) t = __hip_atomic_fetch_add(ctr, 1u, __ATOMIC_RELAXED, __HIP_MEMORY_SCOPE_AGENT);
            t = (unsigned)__builtin_amdgcn_readfirstlane((int)t);
            if (threadIdx.x == 0) slot[(i + 1) & 1] = t;
        }
        long L;
        if (i < sr) L = (long)i * G + c;
        else { const unsigned t = (unsigned)__builtin_amdgcn_readfirstlane((int)slot[i & 1]); if (t >= (unsigned)left) return false; L = (long)sr * G + t; }
        int wgid = (int)L; { const int q = nwg / 8, r = nwg % 8, xcd = wgid % 8, off = wgid / 8; wgid = (xcd < r ? xcd * (q + 1) : r * (q + 1) + (xcd - r) * q) + off; }
        const int nig = gs * nN, gid = wgid / nig, fm = gid * gs, gsz = (nM - fm) < gs ? (nM - fm) : gs;
        const int pm = fm + ((wgid % nig) % gsz), pn = (wgid % nig) / gsz;
        u.A = A + (size_t)pm * 256 * lda; u.B = B + (size_t)pn * 256 * ldb; u.lda = lda; u.ldb = ldb; u.nt = nt;
        u.C = C + ((size_t)pm * 256 * ldc + (size_t)pn * 256) * csz; u.ldc = ldc; u.grow0 = pm * 256; u.gcol0 = pn * 256; u.aux = 0;
        return true;
    }
};
}

namespace at {
constexpr int DH = 128, NW = 8, QBLK = 32, KVBLK = 64;
constexpr float SCALE = 0.088388347648318440f;
constexpr float THR = 8.f;
constexpr int LDQ = NQKV, LDK = NQKV, LDO = D;
constexpr size_t SHM_V = KVBLK * DH * 2, SHM_K = KVBLK * DH * 2, SHM_ATTN = 2 * SHM_V + 2 * SHM_K + NW * 64 * 4;
#define KSWZ(row, colB) ((row) * 256 + ((colB) ^ (((row) & 7) << 4)))
#define SBAR() __builtin_amdgcn_sched_barrier(0)
__device__ __forceinline__ int crow(int r, int hi) { return (r & 3) + 8 * (r >> 2) + 4 * hi; }
__device__ __forceinline__ unsigned cvtpk(float lo, float hi) { unsigned r; asm volatile("v_cvt_pk_bf16_f32 %0, %1, %2" : "=v"(r) : "v"(lo), "v"(hi)); return r; }
__device__ __forceinline__ void partialSM(f32x16& p0, f32x16& p1, float& m_reg, float& mn, float& alpha) {
  constexpr float C = SCALE * 1.4426950408889634f;
  float pmax = p0[0]; for (int r = 1; r < 16; ++r) pmax = fmaxf(pmax, p0[r]); for (int r = 0; r < 16; ++r) pmax = fmaxf(pmax, p1[r]);
  { auto rr = __builtin_amdgcn_permlane32_swap(__float_as_uint(pmax), __float_as_uint(pmax), false, false);
    pmax = fmaxf(__uint_as_float(rr[0]), __uint_as_float(rr[1])); }
  if (__builtin_expect(__all(pmax - m_reg <= THR / SCALE), 1)) { mn = m_reg; alpha = 1.f; }
  else { mn = fmaxf(m_reg, pmax); alpha = __builtin_amdgcn_exp2f((m_reg - mn) * C); m_reg = mn; }
  float mnC = -mn * C;
  for (int r = 0; r < 16; ++r) p0[r] = fmaf(p0[r], C, mnC); for (int r = 0; r < 16; ++r) p1[r] = fmaf(p1[r], C, mnC);
  for (int r = 0; r < 16; ++r) p0[r] = __builtin_amdgcn_exp2f(p0[r]);
}
__device__ __forceinline__ void finishSM(f32x16& p0, f32x16& p1, float alpha, float& l_reg, bf16x8& pa0, bf16x8& pa1, bf16x8& pa2, bf16x8& pa3) {
  for (int r = 0; r < 16; ++r) p1[r] = __builtin_amdgcn_exp2f(p1[r]);
  float ps = 0; for (int r = 0; r < 16; ++r) ps += p0[r]; for (int r = 0; r < 16; ++r) ps += p1[r];
  { auto rr = __builtin_amdgcn_permlane32_swap(__float_as_uint(ps), __float_as_uint(ps), false, false);
    ps = __uint_as_float(rr[0]) + __uint_as_float(rr[1]); }
  l_reg = l_reg * alpha + ps;
#define PK4(P, BASE, OUT) do { unsigned a0 = cvtpk(P[BASE + 0], P[BASE + 1]), a1 = cvtpk(P[BASE + 2], P[BASE + 3]);   \
    unsigned b0 = cvtpk(P[BASE + 4], P[BASE + 5]), b1 = cvtpk(P[BASE + 6], P[BASE + 7]);                              \
    auto r0 = __builtin_amdgcn_permlane32_swap(a0, b0, false, false); auto r1 = __builtin_amdgcn_permlane32_swap(a1, b1, false, false); \
    u32x4 w = {r0[0], r1[0], r0[1], r1[1]}; OUT = *reinterpret_cast<bf16x8*>(&w); } while (0)
  PK4(p0, 0, pa0); PK4(p0, 8, pa1); PK4(p1, 0, pa2); PK4(p1, 8, pa3);
#undef PK4
}
__device__ __forceinline__ void qkt(f32x16& p0, f32x16& p1, const bf16_t* Ks, const bf16x8* qr, int r32, int hi) {
  p0 = f32x16{}; p1 = f32x16{};
  for (int d0 = 0; d0 < 8; ++d0) { int cb = (d0 * 16 + hi * 8) * 2;
    bf16x8 b0 = *reinterpret_cast<const bf16x8*>((const char*)Ks + KSWZ(r32, cb));
    bf16x8 b1 = *reinterpret_cast<const bf16x8*>((const char*)Ks + KSWZ(32 + r32, cb));
    p0 = __builtin_amdgcn_mfma_f32_32x32x16_bf16(b0, qr[d0], p0, 0, 0, 0);
    p1 = __builtin_amdgcn_mfma_f32_32x32x16_bf16(b1, qr[d0], p1, 0, 0, 0); }
}
__device__ __forceinline__ void qkt_pipe(f32x16& p0, f32x16& p1, int kbase, const bf16x8* qr) {
  bf16x8 kb[3][2];
#define KRD(slot, d0) do { const int _a = kbase ^ ((d0) << 5); asm volatile("ds_read_b128 %0, %1" : "=&v"(kb[slot][0]) : "v"(_a) : "memory"); \
    asm volatile("ds_read_b128 %0, %1 offset:8192" : "=&v"(kb[slot][1]) : "v"(_a) : "memory"); } while (0)
#define KW(n) do { asm volatile("s_waitcnt lgkmcnt(" #n ")" ::: "memory"); SBAR(); } while (0)
#define KMM(slot, d0, c0, c1) do { p0 = __builtin_amdgcn_mfma_f32_32x32x16_bf16(kb[slot][0], qr[d0], c0, 0, 0, 0); p1 = __builtin_amdgcn_mfma_f32_32x32x16_bf16(kb[slot][1], qr[d0], c1, 0, 0, 0); SBAR(); } while (0)
  const f32x16 z = f32x16{};
  KRD(0, 0); KRD(1, 1); KRD(2, 2);
  __builtin_amdgcn_s_setprio(3);
  KW(4); KMM(0, 0, z, z); KRD(0, 3);
  KW(4); KMM(1, 1, p0, p1); KRD(1, 4);
  KW(4); KMM(2, 2, p0, p1); KRD(2, 5);
  KW(4); KMM(0, 3, p0, p1); KRD(0, 6);
  KW(4); KMM(1, 4, p0, p1); KRD(1, 7);
  KW(4); KMM(2, 5, p0, p1);
  KW(2); KMM(0, 6, p0, p1);
  KW(0); KMM(1, 7, p0, p1);
  __builtin_amdgcn_s_setprio(0);
#undef KRD
#undef KW
#undef KMM
}
__device__ __forceinline__ int v_st(int k, int c) { const int kk = (k & ~0xC) | ((k & 4) << 1) | ((k & 8) >> 1); return ((kk >> 3) * 4 + (c >> 5)) * 512 + ((kk & 7) * 32 + (c & 31)) * 2; }
__device__ __forceinline__ int v_rd_base(int lane) { return ((lane & 3) << 3) | (((lane >> 2) & 3) << 6) | (((lane >> 4) & 1) << 5) | (((lane >> 5) & 1) << 8); }
constexpr int v_rd_off(int d0, int ks, int half) { return d0 * 512 + ks * 4096 + half * 2048; }
template <int OFF> __device__ __forceinline__ s16x4 tr_read(int vb) {
  s16x4 r; asm volatile("ds_read_b64_tr_b16 %0, %1 offset:%2" : "=&v"(r) : "v"(vb), "i"(OFF) : "memory"); return r;
}
template <int D0> __device__ __forceinline__ void pv_one(f32x16& od, int vb, bf16x8 pa0, bf16x8 pa1, bf16x8 pa2, bf16x8 pa3) {
  const s16x4 l0 = tr_read<v_rd_off(D0, 0, 0)>(vb), h0 = tr_read<v_rd_off(D0, 0, 1)>(vb), l1 = tr_read<v_rd_off(D0, 1, 0)>(vb), h1 = tr_read<v_rd_off(D0, 1, 1)>(vb);
  const s16x4 l2 = tr_read<v_rd_off(D0, 2, 0)>(vb), h2 = tr_read<v_rd_off(D0, 2, 1)>(vb), l3 = tr_read<v_rd_off(D0, 3, 0)>(vb), h3 = tr_read<v_rd_off(D0, 3, 1)>(vb);
  asm volatile("s_waitcnt lgkmcnt(0)" ::: "memory"); SBAR();
#define PK(L, H) (bf16x8){L[0], L[1], L[2], L[3], H[0], H[1], H[2], H[3]}
  od = __builtin_amdgcn_mfma_f32_32x32x16_bf16(pa0, PK(l0, h0), od, 0, 0, 0);
  od = __builtin_amdgcn_mfma_f32_32x32x16_bf16(pa1, PK(l1, h1), od, 0, 0, 0);
  od = __builtin_amdgcn_mfma_f32_32x32x16_bf16(pa2, PK(l2, h2), od, 0, 0, 0);
  od = __builtin_amdgcn_mfma_f32_32x32x16_bf16(pa3, PK(l3, h3), od, 0, 0, 0);
#undef PK
}
__device__ __forceinline__ void pv_d0(f32x16* o, int vb, bf16x8 pa0, bf16x8 pa1, bf16x8 pa2, bf16x8 pa3) {
  pv_one<0>(o[0], vb, pa0, pa1, pa2, pa3); pv_one<1>(o[1], vb, pa0, pa1, pa2, pa3); pv_one<2>(o[2], vb, pa0, pa1, pa2, pa3); pv_one<3>(o[3], vb, pa0, pa1, pa2, pa3);
}
#define TRD(dst, D, vb) do { const int _b = (vb) + ((D) >> 2) * 16384; \
    dst[0] = tr_read<v_rd_off((D) & 3, 0, 0)>(_b); dst[1] = tr_read<v_rd_off((D) & 3, 0, 1)>(_b); dst[2] = tr_read<v_rd_off((D) & 3, 1, 0)>(_b); dst[3] = tr_read<v_rd_off((D) & 3, 1, 1)>(_b); \
    dst[4] = tr_read<v_rd_off((D) & 3, 2, 0)>(_b); dst[5] = tr_read<v_rd_off((D) & 3, 2, 1)>(_b); dst[6] = tr_read<v_rd_off((D) & 3, 3, 0)>(_b); dst[7] = tr_read<v_rd_off((D) & 3, 3, 1)>(_b); } while (0)
#define PKV(L, H) (bf16x8){L[0], L[1], L[2], L[3], H[0], H[1], H[2], H[3]}
#define MM4(od, src) do { __builtin_amdgcn_s_setprio(2); od = __builtin_amdgcn_mfma_f32_32x32x16_bf16(pa0, PKV(src[0], src[1]), od, 0, 0, 0); od = __builtin_amdgcn_mfma_f32_32x32x16_bf16(pa1, PKV(src[2], src[3]), od, 0, 0, 0); \
    od = __builtin_amdgcn_mfma_f32_32x32x16_bf16(pa2, PKV(src[4], src[5]), od, 0, 0, 0); od = __builtin_amdgcn_mfma_f32_32x32x16_bf16(pa3, PKV(src[6], src[7]), od, 0, 0, 0); __builtin_amdgcn_s_setprio(0); } while (0)
#define LW(n) do { asm volatile("s_waitcnt lgkmcnt(" #n ")" ::: "memory"); SBAR(); } while (0)
__device__ __forceinline__ void pv8(f32x16* o, int vb, bf16x8 pa0, bf16x8 pa1, bf16x8 pa2, bf16x8 pa3) {
  s16x4 va[8], vq[8];
  TRD(va, 0, vb); TRD(vq, 1, vb);
  LW(8); MM4(o[0], va); SBAR(); TRD(va, 2, vb);
  LW(8); MM4(o[1], vq); SBAR(); TRD(vq, 3, vb);
  LW(8); MM4(o[2], va); SBAR(); TRD(va, 4, vb);
  LW(8); MM4(o[3], vq); SBAR(); TRD(vq, 5, vb);
  LW(8); MM4(o[4], va); SBAR(); TRD(va, 6, vb);
  LW(8); MM4(o[5], vq); SBAR(); TRD(vq, 7, vb);
  LW(8); MM4(o[6], va);
  LW(0); MM4(o[7], vq);
}
#undef TRD
#undef PKV
#undef MM4
#undef LW
constexpr int KB_BYTES = KVBLK * DH * 2  , VB_BYTES = KVBLK * 256 * 2  ;
constexpr int AT_K_OFF = 0, AT_V_OFF = 2 * KB_BYTES, AT_W_OFF = AT_V_OFF + 2 * VB_BYTES, AT_LDS = AT_W_OFF + NW * 64 * 4;
__device__ __forceinline__ void attn256_body(const bf16_t* __restrict__ Qb, const bf16_t* __restrict__ Kh, const bf16_t* __restrict__ Vh, bf16_t* __restrict__ Ob, int seq, char* lds, const int wid) {
  const int tid = tid_opaque(wid), lane = tid & 63, r32 = lane & 31, hi = lane >> 5, grp = wid >> 2;
  LAS char* L = (LAS char*)lds;
  float* ws = (float*)(lds + AT_W_OFF) + wid * 64; float* li_l = ws; float* al_l = ws + 32;
  float m_reg = -1e30f, l_reg = 0; f32x16 o[8]; bf16x8 qr[8];
#pragma unroll
  for (int d = 0; d < 8; ++d) o[d] = f32x16{};
  const bf16_t* Qw = Qb + (long)(wid * QBLK + r32) * LDQ + hi * 8;
#pragma unroll
  for (int d0 = 0; d0 < 8; ++d0) qr[d0] = *reinterpret_cast<const bf16x8*>(Qw + d0 * 16);
  const int wq = wid & 3;
#define DMA_K(j, b) do { const char* _g = (const char*)Kh + (size_t)(j) * (KVBLK * LDK * 2); const int _l = tid_opaque(0); _Pragma("unroll") for (int _i = 0; _i < 4; ++_i) { \
    const int _r = 16 * wq + 4 * _i + (_l >> 4); const unsigned _o = (unsigned)(_r * (LDK * 2) + (((_l & 15) ^ (_r & 7)) << 4)); \
    __builtin_amdgcn_global_load_lds((const unsigned*)(_g + _o), (LAS unsigned*)(L + AT_K_OFF + (b) * KB_BYTES + wq * 4096 + _i * 1024), 16, 0, 0); } } while (0)
#define DMA_V(j, b) do { const char* _g = (const char*)Vh + (size_t)(j) * (KVBLK * LDK * 2); const int _l = tid_opaque(0); _Pragma("unroll") for (int _i = 0; _i < 8; ++_i) { \
    const int _tt = 8 * (wq & 1) + _i, _kk = (_tt >> 1) * 8 + ((_l & 31) >> 2), _k = (_kk & ~0xC) | ((_kk & 4) << 1) | ((_kk & 8) >> 1); \
    const int _c = (2 * (_tt & 1) + (_l >> 5)) * 32 + (_l & 3) * 8; const unsigned _o = (unsigned)(_k * (LDK * 2) + ((wq >> 1) * 128 + _c) * 2); \
    __builtin_amdgcn_global_load_lds((const unsigned*)(_g + _o), (LAS unsigned*)(L + AT_V_OFF + (b) * VB_BYTES + wq * 8192 + _i * 1024), 16, 0, 0); } } while (0)
#define RESC8(a) do { if (__any((a) < 1.f)) { if (hi == 0) al_l[r32] = (a); asm volatile("s_waitcnt lgkmcnt(0)" ::: "memory"); \
    _Pragma("unroll") for (int d = 0; d < 8; ++d) _Pragma("unroll") for (int r = 0; r < 16; ++r) o[d][r] *= al_l[crow(r, hi)]; } } while (0)
  const int vb0 = (int)(uintptr_t)(lds + AT_V_OFF) + v_rd_base(lane);
  const int NT = seq / KVBLK;
  f32x16 p0, p1; float mn, al; bf16x8 pa0, pa1, pa2, pa3;
  asm volatile("s_waitcnt vmcnt(0)" ::: "memory");
  if (grp) DMA_K(0, 0); else DMA_V(0, 0);
  asm volatile("s_waitcnt vmcnt(0)" ::: "memory"); __builtin_amdgcn_s_barrier();
#define QKSM(jq) do { const int kbase = (int)(uintptr_t)(lds + AT_K_OFF) + ((jq) & 1) * KB_BYTES + r32 * 256 + ((hi << 4) ^ ((r32 & 7) << 4)); qkt_pipe(p0, p1, kbase, qr); partialSM(p0, p1, m_reg, mn, al); RESC8(al); \
    finishSM(p0, p1, al, l_reg, pa0, pa1, pa2, pa3); } while (0)
#define PV(jp) do { const int vb = vb0 + ((jp) & 1) * VB_BYTES; pv8(o, vb, pa0, pa1, pa2, pa3); } while (0)
#define VM0_BAR() do { asm volatile("s_waitcnt vmcnt(0)" ::: "memory"); __builtin_amdgcn_s_barrier(); } while (0)
  if (grp == 0) {
    for (int j = 0; j < NT; ++j) {
      QKSM(j); VM0_BAR();
      if (j + 1 < NT) DMA_V(j + 1, (j + 1) & 1);
      PV(j); __builtin_amdgcn_s_barrier();
    }
    VM0_BAR();
  } else {
    for (int j = 0; j < NT; ++j) {
      if (j + 1 < NT) DMA_K(j + 1, (j + 1) & 1);
      if (j > 0) PV(j - 1);
      __builtin_amdgcn_s_barrier();
      QKSM(j); VM0_BAR();
    }
    PV(NT - 1);
    VM0_BAR();
  }
#undef VM0_BAR
#undef QKSM
#undef PV
  if (hi == 0) li_l[r32] = l_reg; asm volatile("s_waitcnt lgkmcnt(0)" ::: "memory");
  float rli[16];
#pragma unroll
  for (int r = 0; r < 16; ++r) rli[r] = __builtin_amdgcn_rcpf(li_l[crow(r, hi)]);
  unsigned* Ow = (unsigned*)Ob + (long)(wid * (QBLK / 2)) * LDO;
#pragma unroll
  for (int r = 0; r < 16; r += 2) { const int prow = crow(r, hi) >> 1;
#pragma unroll
    for (int d0 = 0; d0 < 8; ++d0) Ow[(long)prow * LDO + d0 * 32 + r32] = cvtpk(o[d0][r] * rli[r], o[d0][r + 1] * rli[r + 1]); }
  asm volatile("s_waitcnt vmcnt(0) lgkmcnt(0)" ::: "memory"); __builtin_amdgcn_s_barrier();
#undef DMA_K
#undef DMA_V
#undef RESC8
}
#undef KSWZ
#undef SBAR
}

struct Frame {
    LAS unsigned char* lds; volatile LAS unsigned* MISC; unsigned* ctl;
    int wave, G, bx;
    const float* in[22]; float* out; unsigned char* ws;
};

constexpr int TP_S = 65, TP_BYTES = 64 * TP_S * 4;
template <bool NT>
__device__ __forceinline__ void transpose_item(const float* W, int K, int N, bf16_t* WT, int k0, int n0, int dst_row0, const float* gk, int gmask, float gmul, const float* gn,
                                               LAS float* scr, int lane) {
    const int lr = lane >> 4, lc = (lane & 15) * 4;
    f32x4 v[16];
#pragma unroll
    for (int i = 0; i < 16; ++i) { const GAS f32x4* p = (const GAS f32x4*)(W + (size_t)(k0 + 4 * i + lr) * N + n0 + lc); if constexpr (NT) v[i] = __builtin_nontemporal_load(p); else v[i] = *p; }
    f32x4 ns = {1.f, 1.f, 1.f, 1.f}; if (gn) ns = *(const f32x4*)(gn + n0 + lc);
#pragma unroll
    for (int i = 0; i < 16; ++i) { const int k = 4 * i + lr; const float ks = (gk ? gk[(k0 + k) & gmask] : 1.0f) * gmul;
        const f32x4 x = v[i] * ns * ks; LAS float* p = scr + k * TP_S + lc; p[0] = x.x; p[1] = x.y; p[2] = x.z; p[3] = x.w; }
    LDS_WAIT(); asm volatile("" ::: "memory");
    const int c = lane >> 3, nl = lane & 7;
#pragma unroll
    for (int j = 0; j < 8; ++j) { const int n = 8 * j + nl; const LAS float* sp = scr + (8 * c) * TP_S + n;
        u32x4 o; o.x = cvt_pk_bf16(sp[0 * TP_S], sp[1 * TP_S]); o.y = cvt_pk_bf16(sp[2 * TP_S], sp[3 * TP_S]); o.z = cvt_pk_bf16(sp[4 * TP_S], sp[5 * TP_S]); o.w = cvt_pk_bf16(sp[6 * TP_S], sp[7 * TP_S]);
        *(GAS u32x4*)(WT + (size_t)(dst_row0 + n) * K + k0 + 8 * c) = o; }
    LDS_WAIT(); asm volatile("" ::: "memory");
}
template <class RowMap>
__device__ __forceinline__ void transpose_matrix(const float* W, int K, int N, bf16_t* WT, const float* gk, int gmask, float gmul, const float* gn, RowMap rowmap,
                                                 LAS float* scr, int lane, int gw, int NGW, int& rot) {
    const int nblk = N / 64, nitems = (K / 64) * nblk;
    int first = gw - rot; if (first < 0) first += NGW;
    for (int it = first; it < nitems; it += NGW) { const int kb = it / nblk, nb = it % nblk;
        transpose_item<true>(W, K, N, WT, 64 * kb, 64 * nb, rowmap(64 * nb), gk, gmask, gmul, gn, scr, lane); }
    rot = (rot + nitems) % NGW;
}
struct RowId { __device__ __forceinline__ int operator()(int n0) const { return n0; } };
struct RowUp { __device__ __forceinline__ int operator()(int n0) const { const int up = n0 >= DFF, nn = up ? n0 - DFF : n0; return (nn >> 7) * 256 + up * 128 + (nn & 127); } };

__device__ __forceinline__ void p_wdn_filler(Frame& F, int l, unsigned* ctr) {
    LAS float* scr = (LAS float*)(F.lds + RING_OFF + F.wave * TP_BYTES);
    const int lane = tid_opaque(F.wave) & 63;
    const float* W = F.in[20] + (size_t)l * DFF * D; bf16_t* WT = (bf16_t*)(F.ws + WS_WDN) + (size_t)l * D * DFF;
    constexpr int NBLK = D / 64, PER = 2, NTICK = (DFF / 64) * NBLK / (NWAVES * PER);
    static_assert((DFF / 64) * NBLK % (NWAVES * PER) == 0, "whole tickets");
    for (int k = 0;; ++k) {
        if (threadIdx.x == 0) F.MISC[22 + (k & 1)] = __hip_atomic_fetch_add(ctr, 1u, __ATOMIC_RELAXED, __HIP_MEMORY_SCOPE_AGENT);
        __syncthreads();
        const unsigned t = (unsigned)__builtin_amdgcn_readfirstlane((int)F.MISC[22 + (k & 1)]);
        if (t >= (unsigned)NTICK) break;
#pragma unroll 1
        for (int b = 0; b < PER; ++b) { const int it = ((int)t * PER + b) * NWAVES + F.wave, kb = it / NBLK, nb = it % NBLK;
            transpose_item<false>(W, DFF, D, WT, 64 * kb, 64 * nb, 64 * nb, nullptr, 0, 1.0f, nullptr, scr, lane); }
    }
}

__device__ __forceinline__ void p_prologue(Frame& F) {
    LAS float* scr = (LAS float*)(F.lds + RING_OFF + F.wave * TP_BYTES);
    const int tid = tid_opaque(F.wave), lane = tid & 63; int rot = 0;
    const int gw = F.bx * NWAVES + F.wave, NGW = F.G * NWAVES;
    unsigned char* ws = F.ws;
    {   float* rstd = (float*)(ws + WS_RSTD); bf16_t* xb = (bf16_t*)(ws + WS_XB);
        for (int r = gw; r < M; r += NGW) {
            const float* xrow = (r < MP) ? F.in[0] + (size_t)r * D : F.in[1] + (size_t)(r - MP) * D;
            const GAS f32x4* xr = (const GAS f32x4*)xrow + lane;
            f32x4 v[16]; float s = 0.f;
#pragma unroll
            for (int j = 0; j < 16; ++j) { v[j] = __builtin_nontemporal_load(xr + 64 * j); s += (v[j].x * v[j].x + v[j].y * v[j].y) + (v[j].z * v[j].z + v[j].w * v[j].w); }
            s = wave_sum(s);
            if (lane == 0) rstd[r] = 1.0f / sqrtf(s * (1.0f / D) + NORM_EPS);
            GAS u32x2* o8 = (GAS u32x2*)(xb + (size_t)r * D) + lane;
#pragma unroll
            for (int j = 0; j < 16; ++j) { u32x2 w; w.x = pk2(v[j].x, v[j].y); w.y = pk2(v[j].z, v[j].w); o8[64 * j] = w; }
        }
    }
    transpose_matrix(F.in[3], D, D, (bf16_t*)(ws + WS_WIN), F.in[2], 0xffff, 1.0f, nullptr, RowId(), scr, lane, gw, NGW, rot);
    for (int g = 0; g < 4; ++g)
        transpose_matrix(F.in[4] + (size_t)g * PG * PG, PG, PG, (bf16_t*)(ws + WS_POOLT) + (size_t)g * PG * PG, nullptr, 0, 1.0f, F.in[5] + g * PG, RowId(), scr, lane, gw, NGW, rot);
    transpose_matrix(F.in[7], D, D, (bf16_t*)(ws + WS_WOE), nullptr, 0, 1.0f, nullptr, RowId(), scr, lane, gw, NGW, rot);
    transpose_matrix(F.in[9], D, NQKV, (bf16_t*)(ws + WS_WQKV), F.in[8], 0xffff, 1.0f, nullptr, RowId(), scr, lane, gw, NGW, rot);
    transpose_matrix(F.in[15], D, D, (bf16_t*)(ws + WS_WOO), F.in[14], 255, 1.0f - LAMBDA_INIT, nullptr, RowId(), scr, lane, gw, NGW, rot);
    for (int l = 0; l < 2; ++l) {
        transpose_matrix(F.in[17] + (size_t)l * D * NUP, D, NUP, (bf16_t*)(ws + WS_WUP) + (size_t)l * NUP * D, F.in[16] + l * D, 0xffff, 1.0f, nullptr, RowUp(), scr, lane, gw, NGW, rot);
    }
    for (int which = 0; which < 2; ++which) {
        const int L = which ? LS : LP, Hf = L / 2; bf16_t* dft = (bf16_t*)(ws + (which ? WS_DFTS : WS_DFTP));
        const float inv = 1.0f / (float)L, nrm = 1.0f / sqrtf((float)L);
        const int chunks = Hf / 512, per = Hf * chunks, nitems = 2 * per;
        for (int it = gw; it < nitems; it += NGW) { const int part = it / per, r = it % per, k = r / chunks, t0 = (r % chunks) * 512 + lane * 8; float v[8];
#pragma unroll
            for (int e = 0; e < 8; ++e) { const int idx = (k * (t0 + e) + (part ? 3 * (L >> 2) : 0)) & (L - 1); v[e] = __builtin_amdgcn_cosf((float)idx * inv) * nrm; }
            u32x4 o; o.x = pk2(v[0], v[1]); o.y = pk2(v[2], v[3]); o.z = pk2(v[4], v[5]); o.w = pk2(v[6], v[7]);
            *(GAS u32x4*)(dft + ((size_t)part * Hf + k) * Hf + t0) = o; }
    }
    {   __syncthreads();
        LAS float* tab = (LAS float*)(F.lds + RING_OFF);
        if (tid < 256) tab[tid] = cospif((float)tid * (1.0f / 128.0f));
        __syncthreads();
        bf16_t* gt = (bf16_t*)(ws + WS_GT); const float* fw = F.in[6];
        for (int it = gw; it < 2048; it += NGW) { const int h = it >> 9, c = ((it >> 7) & 3) * 64 + lane, n0 = (it & 127) * 8;
            float ac[8], as[8];
#pragma unroll
            for (int q = 0; q < 8; ++q) { ac[q] = 0.f; as[q] = 0.f; }
#pragma unroll 4
            for (int cp = 0; cp < 256; ++cp) { const float tc = tab[(c * cp) & 255], ts = tab[(c * cp + 192) & 255];
                const float* fr = fw + (size_t)(h * 256 + cp) * FD + n0;
#pragma unroll
                for (int q = 0; q < 8; ++q) { const float f = fr[q]; ac[q] += tc * f; as[q] += ts * f; } }
#pragma unroll
            for (int q = 0; q < 8; ++q) { gt[(size_t)(2 * (n0 + q)) * FD + h * 256 + c] = (bf16_t)f2bf(ac[q] * (1.0f / 16.0f)); gt[(size_t)(2 * (n0 + q) + 1) * FD + h * 256 + c] = (bf16_t)f2bf(as[q] * (1.0f / 16.0f)); }
        }
    }
    {   float* rot = (float*)(ws + WS_ROT);
        for (int i = gw * 64 + lane; i < LP * 16; i += NGW * 64) { const int pos = i >> 4, j = i & 15;
            const float invf = (float)pow(500000.0, -(double)(2 * j) / 32.0); const float ang = (float)pos * invf;
            rot[pos * 32 + j] = (float)cos((double)ang); rot[pos * 32 + 16 + j] = (float)sin((double)ang); }
        if (F.bx == 0 && F.wave == 0) {
            float a = F.in[10][lane] * F.in[11][lane] + F.in[10][lane + 64] * F.in[11][lane + 64];
            float b = F.in[12][lane] * F.in[13][lane] + F.in[12][lane + 64] * F.in[13][lane + 64];
            a = wave_sum(a); b = wave_sum(b);
            if (lane == 0) F.ctl[CW_LAM] = __builtin_bit_cast(unsigned, expf(a) - expf(b) + LAMBDA_INIT);
        }
    }
}

__device__ __forceinline__ void p_finalize_rstd(Frame& F) {
    const float* psum = (const float*)(F.ws + WS_PSUM); float* rstd = (float*)(F.ws + WS_RSTD);
    const int tid = tid_opaque(F.wave);
    for (int r = F.bx * NTHREADS + tid; r < M; r += F.G * NTHREADS) { const f32x4* p = (const f32x4*)(psum + (size_t)r * 64); float s = 0.f;
#pragma unroll
        for (int j = 0; j < 16; ++j) { const f32x4 v = p[j]; s += (v.x + v.y) + (v.z + v.w); }
        rstd[r] = 1.0f / sqrtf(s * (1.0f / D) + NORM_EPS); }
}

__device__ __forceinline__ f32x4 bf4lo(u32x4 w) { return (f32x4){bf2f(w.x & 0xffff), bf2f(w.x >> 16), bf2f(w.y & 0xffff), bf2f(w.y >> 16)}; }
__device__ __forceinline__ f32x4 bf4hi(u32x4 w) { return (f32x4){bf2f(w.z & 0xffff), bf2f(w.z >> 16), bf2f(w.w & 0xffff), bf2f(w.w >> 16)}; }
__device__ __forceinline__ void p_pool(Frame& F) {
    const bf16_t* u = (const bf16_t*)(F.ws + WS_U); bf16_t* pooled = (bf16_t*)(F.ws + WS_POOLED);
    const int gw = F.bx * NWAVES + F.wave, NGW = F.G * NWAVES, lane = tid_opaque(F.wave) & 63;
    for (int it = gw; it < (M / 32) * 6; it += NGW) {
        const int rc = it / 6, cb = it % 6, t0 = rc * 32, col = cb * 512 + lane * 8, h = 1 << (col / PG);
        const int s0 = (t0 < MP) ? 0 : MP + ((t0 - MP) / LS) * LS, s1 = (t0 < MP) ? MP : s0 + LS;
        const bf16_t* up = u + col;
        f32x4 sa = {0.f, 0.f, 0.f, 0.f}, sb = {0.f, 0.f, 0.f, 0.f};
#pragma unroll
        for (int d = -8; d < 8; ++d) { const int sidx = t0 + d; const bool ok = (d >= -h) && (d < h) && (sidx >= s0) && (sidx < s1); const int sc = sidx < s0 ? s0 : (sidx >= s1 ? s1 - 1 : sidx);
            const u32x4 w = *(const u32x4*)(up + (size_t)sc * D); const float mk = ok ? 1.0f : 0.0f; sa += bf4lo(w) * mk; sb += bf4hi(w) * mk; }
#pragma unroll 8
        for (int t = t0; t < t0 + 32; ++t) {
            const int a = (t - h > s0) ? t - h : s0, b = (t + h < s1) ? t + h : s1;
            const int ia = t + h, is = t - h; const float ma = (ia < s1) ? 1.0f : 0.0f, ms = (is >= s0) ? 1.0f : 0.0f;
            const u32x4 wt = *(const u32x4*)(up + (size_t)t * D), wa = *(const u32x4*)(up + (size_t)(ia < s1 ? ia : s1 - 1) * D), wsb = *(const u32x4*)(up + (size_t)(is >= s0 ? is : s0) * D);
            const float inv = 1.0f / (float)(b - a);
            const f32x4 oa = sa * inv - bf4lo(wt), ob = sb * inv - bf4hi(wt);
            u32x4 ow; ow.x = pk2(oa.x, oa.y); ow.y = pk2(oa.z, oa.w); ow.z = pk2(ob.x, ob.y); ow.w = pk2(ob.z, ob.w);
            *(u32x4*)(pooled + (size_t)t * POOL_DIM + col) = ow;
            sa += bf4lo(wa) * ma - bf4lo(wsb) * ms; sb += bf4hi(wa) * ma - bf4hi(wsb) * ms;
        }
    }
}

__device__ __forceinline__ void hr_decode(int hr, int& s, int& t, int& row0, int& L) { if (hr < HP) { s = 0; t = hr; row0 = 0; L = LP; } else { const int j = hr - HP; s = 1 + (j >> 10); t = j & (HS - 1); row0 = MP + (s - 1) * LS; L = LS; } }
__device__ __forceinline__ void bf8_to_f(u32x4 w, f32x4& lo, f32x4& hi) { lo = (f32x4){bf2f(w.x & 0xffff), bf2f(w.x >> 16), bf2f(w.y & 0xffff), bf2f(w.y >> 16)}; hi = (f32x4){bf2f(w.z & 0xffff), bf2f(w.z >> 16), bf2f(w.w & 0xffff), bf2f(w.w >> 16)}; }
__device__ __forceinline__ void p_fold(Frame& F) {
    const bf16_t* u = (const bf16_t*)(F.ws + WS_U); bf16_t* ufp = (bf16_t*)(F.ws + WS_UFP); bf16_t* ufm = (bf16_t*)(F.ws + WS_UFM);
    const int gw = F.bx * NWAVES + F.wave, NGW = F.G * NWAVES, lane = tid_opaque(F.wave) & 63;
    for (int hr = gw; hr < MH; hr += NGW) { int sq, t, row0, L; hr_decode(hr, sq, t, row0, L);
        const bf16_t* pa = u + (size_t)(row0 + t) * D + POOL_DIM + lane * 16; const bf16_t* pb = u + (size_t)(row0 + (t ? L - t : 0)) * D + POOL_DIM + lane * 16;
        const float mk = t ? 1.0f : 0.0f;
#pragma unroll
        for (int q = 0; q < 2; ++q) { f32x4 a0, a1, b0, b1; bf8_to_f(*(const u32x4*)(pa + 8 * q), a0, a1); bf8_to_f(*(const u32x4*)(pb + 8 * q), b0, b1);
            const f32x4 p0 = a0 + b0 * mk, p1 = a1 + b1 * mk, m0 = (a0 - b0) * mk, m1 = (a1 - b1) * mk;
            u32x4 wp, wm; wp.x = pk2(p0.x, p0.y); wp.y = pk2(p0.z, p0.w); wp.z = pk2(p1.x, p1.y); wp.w = pk2(p1.z, p1.w); wm.x = pk2(m0.x, m0.y); wm.y = pk2(m0.z, m0.w); wm.z = pk2(m1.x, m1.y); wm.w = pk2(m1.z, m1.w);
            *(u32x4*)(ufp + (size_t)hr * FD + lane * 16 + 8 * q) = wp; *(u32x4*)(ufm + (size_t)hr * FD + lane * 16 + 8 * q) = wm; }
    }
}
__device__ __forceinline__ void p_ych(Frame& F) {
    const bf16_t* u = (const bf16_t*)(F.ws + WS_U); const bf16_t* gt = (const bf16_t*)(F.ws + WS_GT); float* ych = (float*)(F.ws + WS_YCH);
    const int gw = F.bx * NWAVES + F.wave, NGW = F.G * NWAVES, lane = tid_opaque(F.wave) & 63;
    for (int it = gw; it < 9 * FD; it += NGW) { const int sq = it >> 10, cpp = it & (FD - 1); const int row = sq ? MP + (sq - 1) * LS + HS : HP;
        const bf16_t* g = gt + (size_t)(2 * cpp) * FD + lane * 16; const bf16_t* x = u + (size_t)row * D + POOL_DIM + lane * 16; float a = 0.f;
#pragma unroll
        for (int q = 0; q < 2; ++q) { f32x4 g0, g1, x0, x1; bf8_to_f(*(const u32x4*)(g + 8 * q), g0, g1); bf8_to_f(*(const u32x4*)(x + 8 * q), x0, x1);
            a += (g0.x * x0.x + g0.y * x0.y) + (g0.z * x0.z + g0.w * x0.w) + (g1.x * x1.x + g1.y * x1.y) + (g1.z * x1.z + g1.w * x1.w); }
        a = wave_sum(a); if (lane == 0) ych[it] = a; }
}
__device__ __forceinline__ void p_alt(Frame& F) {
    float* alt = (float*)(F.ws + WS_ALT);
    const int gw = F.bx * NWAVES + F.wave, NGW = F.G * NWAVES, lane = tid_opaque(F.wave) & 63;
    for (int it = gw; it < 9 * FD; it += NGW) { const int sq = it >> 10, cpp = it & (FD - 1); const int Hf = sq ? HS : HP;
        const bf16_t* y = sq ? (const bf16_t*)(F.ws + WS_YFS) + ((size_t)(sq - 1) * 2 * FD + cpp) * HS : (const bf16_t*)(F.ws + WS_YFP) + (size_t)cpp * HP;
        float a = 0.f;
        for (int ch = lane; ch < Hf / 8; ch += 64) { f32x4 v0, v1; bf8_to_f(*(const u32x4*)(y + 8 * ch), v0, v1); a += (v0.x - v0.y) + (v0.z - v0.w) + (v1.x - v1.y) + (v1.z - v1.w); }
        a = wave_sum(a); if (lane == 0) alt[it] = a; }
}
__device__ __forceinline__ void p_unfold(Frame& F) {
    const float* eb = (const float*)(F.ws + WS_EB); const float* ob = (const float*)(F.ws + WS_OB2); const float* ych = (const float*)(F.ws + WS_YCH); const float* alt = (const float*)(F.ws + WS_ALT);
    bf16_t* cat = (bf16_t*)(F.ws + WS_CAT);
    const int gw = F.bx * NWAVES + F.wave, NGW = F.G * NWAVES, lane = tid_opaque(F.wave) & 63;
    constexpr int NROWS = (HP + 1) + NSS * (HS + 1);
    for (int it = gw; it < NROWS; it += NGW) {
        int sq, k; if (it <= HP) { sq = 0; k = it; } else { const int j = it - (HP + 1); sq = 1 + j / (HS + 1); k = j % (HS + 1); }
        const int L = sq ? LS : LP, Hf = L / 2, row0 = sq ? MP + (sq - 1) * LS : 0, hrow0 = sq ? HP + (sq - 1) * HS : 0;
        const float nrm = 1.0f / sqrtf((float)L);
        const float* yc = ych + sq * FD + lane * 16;
        if (k == Hf) { const float* al = alt + sq * FD + lane * 16; bf16_t* o = cat + (size_t)(row0 + Hf) * D + POOL_DIM + lane * 16;
#pragma unroll
            for (int q = 0; q < 4; ++q) { const f32x4 v = (*(const f32x4*)(al + 4 * q) + *(const f32x4*)(yc + 4 * q)) * nrm; u32x2 w; w.x = pk2(v.x, v.y); w.y = pk2(v.z, v.w); *(u32x2*)(o + 4 * q) = w; }
        } else { const float sg = (k & 1) ? -nrm : nrm;
            const float* e = eb + (size_t)(hrow0 + k) * FD + lane * 16; const float* od = ob + (size_t)(hrow0 + k) * FD + lane * 16;
            bf16_t* o1 = cat + (size_t)(row0 + k) * D + POOL_DIM + lane * 16; bf16_t* o2 = cat + (size_t)(row0 + (k ? L - k : 0)) * D + POOL_DIM + lane * 16;
#pragma unroll
            for (int q = 0; q < 4; ++q) { const f32x4 ev = *(const f32x4*)(e + 4 * q) + *(const f32x4*)(yc + 4 * q) * sg, ov = *(const f32x4*)(od + 4 * q);
                const f32x4 f1 = ev - ov, f2 = ev + ov; u32x2 w; w.x = pk2(f1.x, f1.y); w.y = pk2(f1.z, f1.w); *(u32x2*)(o1 + 4 * q) = w;
                if (k) { u32x2 w2; w2.x = pk2(f2.x, f2.y); w2.y = pk2(f2.z, f2.w); *(u32x2*)(o2 + 4 * q) = w2; } }
        }
    }
}

__device__ __forceinline__ void p_fixup(Frame& F, const float* cw, const float* cb) {
    const float* halo = (const float*)(F.ws + WS_HALO); bf16_t* act = (bf16_t*)(F.ws + WS_ACT);
    constexpr int CH = DFF / 4;
    const int tid = tid_opaque(F.wave);
    for (int i = F.bx * NTHREADS + tid; i < (M / 128) * 2 * CH; i += F.G * NTHREADS) {
        const int ch = i % CH, be = i / CH, blk = be >> 1, e = be & 1, c = ch * 4;
        const int t = blk * 128 + (e ? 127 : 0);
        const int s0 = (t < MP) ? 0 : MP + ((t - MP) / LS) * LS, s1 = (t < MP) ? MP : s0 + LS;
        const float* hb = halo + (size_t)blk * 4 * NUP;
        f32x4 a4;
        f32x4 y[2];
#pragma unroll
        for (int bj = 0; bj < 2; ++bj) { const int cc = bj * DFF + c;
            f32x4 xl, xc, xr; const f32x4 z = {0.f, 0.f, 0.f, 0.f};
            if (e == 0) { xl = (t > s0) ? *(const f32x4*)(hb - (size_t)4 * NUP + 3 * NUP + cc) : z; xc = *(const f32x4*)(hb + cc); xr = *(const f32x4*)(hb + NUP + cc); }
            else { xl = *(const f32x4*)(hb + 2 * NUP + cc); xc = *(const f32x4*)(hb + 3 * NUP + cc); xr = (t + 1 < s1) ? *(const f32x4*)(hb + (size_t)4 * NUP + cc) : z; }
            y[bj] = xl * *(const f32x4*)(cw + cc) + xc * *(const f32x4*)(cw + NUP + cc) + xr * *(const f32x4*)(cw + 2 * NUP + cc) + *(const f32x4*)(cb + cc); }
#pragma unroll
        for (int q = 0; q < 4; ++q) { const float g = y[0][q]; a4[q] = g * __builtin_amdgcn_rcpf(1.0f + __expf(-g)) * y[1][q]; }
        u32x2 w; w.x = cvt_pk_bf16(a4[0], a4[1]); w.y = cvt_pk_bf16(a4[2], a4[3]);
        *(u32x2*)(act + (size_t)t * DFF + c) = w;
    }
}

__device__ __forceinline__ void p_combine(Frame& F) {
    const unsigned* oa0 = (const unsigned*)(F.ws + WS_OA); const unsigned* oa1 = oa0 + (size_t)(M / 2) * D; bf16_t* ob = (bf16_t*)(F.ws + WS_OB);
    const float lam = __builtin_bit_cast(float, __hip_atomic_load(F.ctl + CW_LAM, RLX_AGENT));
    const int gw = F.bx * NWAVES + F.wave, NGW = F.G * NWAVES, lane = tid_opaque(F.wave) & 63;
    for (int p = gw; p < M / 2; p += NGW) {
        const u32x4* a = (const u32x4*)(oa0 + (size_t)p * D) + lane; const u32x4* b = (const u32x4*)(oa1 + (size_t)p * D) + lane;
        u32x2* o0 = (u32x2*)(ob + (size_t)(2 * p) * D) + lane; u32x2* o1 = (u32x2*)(ob + (size_t)(2 * p + 1) * D) + lane;
#pragma unroll 8
        for (int h = 0; h < 16; ++h) { const u32x4 wa = a[64 * h], wb = b[64 * h];
            const f32x4 a0 = {bf2f(wa.x & 0xffff), bf2f(wa.y & 0xffff), bf2f(wa.z & 0xffff), bf2f(wa.w & 0xffff)}, a1 = {bf2f(wa.x >> 16), bf2f(wa.y >> 16), bf2f(wa.z >> 16), bf2f(wa.w >> 16)};
            const f32x4 b0 = {bf2f(wb.x & 0xffff), bf2f(wb.y & 0xffff), bf2f(wb.z & 0xffff), bf2f(wb.w & 0xffff)}, b1 = {bf2f(wb.x >> 16), bf2f(wb.y >> 16), bf2f(wb.z >> 16), bf2f(wb.w >> 16)};
            const f32x4 v0 = a0 - b0 * lam, v1 = a1 - b1 * lam;
            float s0 = (v0.x * v0.x + v0.y * v0.y) + (v0.z * v0.z + v0.w * v0.w), s1 = (v1.x * v1.x + v1.y * v1.y) + (v1.z * v1.z + v1.w * v1.w);
#pragma unroll
            for (int of = 1; of < 64; of <<= 1) { s0 += __shfl_xor(s0, of); s1 += __shfl_xor(s1, of); }
            const float r0 = 1.0f / sqrtf(s0 * (1.0f / 256.0f) + SUBLN_EPS), r1 = 1.0f / sqrtf(s1 * (1.0f / 256.0f) + SUBLN_EPS);
            u32x2 w0, w1; w0.x = pk2(v0.x * r0, v0.y * r0); w0.y = pk2(v0.z * r0, v0.w * r0); w1.x = pk2(v1.x * r1, v1.y * r1); w1.y = pk2(v1.z * r1, v1.w * r1);
            o0[64 * h] = w0; o1[64 * h] = w1; }
    }
}

__device__ __forceinline__ void p_final(Frame& F) {
    const float* psum = (const float*)(F.ws + WS_PSUM); const float* fn = F.in[21]; const bf16_t* xb = (const bf16_t*)(F.ws + WS_XB);
    const int gw = F.bx * NWAVES + F.wave, NGW = F.G * NWAVES, lane = tid_opaque(F.wave) & 63;
    for (int r = gw; r < M; r += NGW) {
        const float s = wave_sum(psum[(size_t)r * 64 + lane]); const float rs = 1.0f / sqrtf(s * (1.0f / D) + NORM_EPS);
        const u32x2* x = (const u32x2*)(xb + (size_t)r * D) + lane; f32x4* y = (f32x4*)(F.out + (size_t)r * D) + lane; const f32x4* g = (const f32x4*)fn + lane;
#pragma unroll 8
        for (int j = 0; j < 16; ++j) { const u32x2 w = x[64 * j]; const f32x4 v = {bf2f(w.x & 0xffff), bf2f(w.x >> 16), bf2f(w.y & 0xffff), bf2f(w.y >> 16)}; y[64 * j] = v * rs * g[64 * j]; }
    }
}

struct YFOrder {
    const char* gt; const char* ufp; const char* ufm; char* yfp; char* yfs; int G, c;
    __device__ __forceinline__ bool next(int i, pg::GUnit& un) const {
        const int id = i * G + c; if (id >= 384) return false;
        int part, pm, pn, Hf, hrow0; char* Cb;
        if (id < 128) { part = id >> 6; const int r = id & 63; pm = r & 3; pn = r >> 2; Hf = HP; hrow0 = 0; Cb = yfp + (size_t)part * FD * HP * 2; }
        else { const int j = id - 128, sq = j >> 5, r = j & 31; part = r >> 4; pm = r & 3; pn = (r >> 2) & 3; Hf = HS; hrow0 = HP + sq * HS; Cb = yfs + (size_t)(sq * 2 + part) * FD * HS * 2; }
        un.A = gt + (size_t)part * (FD * 2) + (size_t)pm * 256 * (2 * FD * 2); un.lda = 2 * FD * 2; un.B = (part ? ufm : ufp) + (size_t)(hrow0 + pn * 256) * (FD * 2); un.ldb = FD * 2; un.nt = FD / 64;
        un.C = Cb + ((size_t)pm * 256 * Hf + (size_t)pn * 256) * 2; un.ldc = (unsigned)Hf; un.grow0 = 0; un.gcol0 = 0; un.aux = 0;
        return true;
    }
};
struct EOOrder {
    const char* dftp; const char* dfts; const char* yfp; const char* yfs; char* eb; char* ob; const char* pooled; const char* poolt; char* cat; int G, c;
    __device__ __forceinline__ void eo_unit(int sq, int which, int pm, int pn, pg::GUnit& un) const {
        const int Hf = sq ? HS : HP, hrow0 = sq ? HP + (sq - 1) * HS : 0;
        un.A = (sq ? dfts : dftp) + ((size_t)which * Hf + (size_t)pm * 256) * ((size_t)Hf * 2); un.lda = (unsigned)Hf * 2u;
        un.B = (sq ? yfs + (size_t)((sq - 1) * 2 + which) * FD * HS * 2 : yfp + (size_t)which * FD * HP * 2) + (size_t)pn * 256 * ((size_t)Hf * 2); un.ldb = (unsigned)Hf * 2u; un.nt = Hf / 64;
        un.C = (which ? ob : eb) + ((size_t)(hrow0 + pm * 256) * FD + pn * 256) * 4; un.ldc = FD; un.grow0 = 0; un.gcol0 = 0; un.aux = 1;
    }
    __device__ __forceinline__ void pool_unit(int id, pg::GUnit& un) const {
        const int g = id / 288, r = id % 288, pm = r / 3, pn = r % 3;
        un.A = pooled + ((size_t)pm * 256 * POOL_DIM + g * PG) * 2; un.lda = POOL_DIM * 2; un.B = poolt + ((size_t)g * PG * PG + (size_t)pn * 256 * PG) * 2; un.ldb = PG * 2; un.nt = PG / 64;
        un.C = cat + ((size_t)pm * 256 * D + g * PG + pn * 256) * 2; un.ldc = D; un.grow0 = pm * 256; un.gcol0 = g * PG + pn * 256; un.aux = 0;
    }
    __device__ __forceinline__ bool next(int i, pg::GUnit& un) const {
        if (G == 256) {
            if (c < 128) { if (i == 0) { eo_unit(0, c >> 6, (c & 63) >> 2, c & 3, un); return true; } if (i < 4) { pool_unit(3 * c + (i - 1), un); return true; } return false; }
            const int j = c - 128;
            if (i < 2) { const int id = 2 * j + i, r = id & 31; eo_unit(1 + (id >> 5), r >> 4, (r >> 2) & 3, r & 3, un); return true; }
            if (i < 8) { pool_unit(384 + 6 * j + (i - 2), un); return true; }
            return false;
        }
        const int id = i * G + c;
        if (id < 128) { eo_unit(0, id >> 6, (id & 63) >> 2, id & 3, un); return true; }
        if (id < 384) { const int k = id - 128, r = k & 31; eo_unit(1 + (k >> 5), r >> 4, (r >> 2) & 3, r & 3, un); return true; }
        if (id < 384 + 1152) { pool_unit(id - 384, un); return true; }
        return false;
    }
};

struct Args { const float* in[22]; float* out; unsigned char* ws; int ph_lo, ph_hi; };
constexpr int N_PHASES = 32;

__global__ void __launch_bounds__(NTHREADS, 2) mk_fwd(Args args) {
    extern __shared__ __attribute__((aligned(16))) unsigned char lds[];
    Frame F;
    F.lds = (LAS unsigned char*)lds; F.MISC = (volatile LAS unsigned*)(F.lds + MISC_OFF);
    F.wave = __builtin_amdgcn_readfirstlane((int)threadIdx.x >> 6);
    F.G = gridDim.x; F.bx = blockIdx.x;
#pragma unroll
    for (int i = 0; i < 22; ++i) F.in[i] = args.in[i];
    F.out = args.out; F.ws = args.ws; F.ctl = (unsigned*)(args.ws + WS_CTL);
    unsigned char* ws = args.ws;
    for (int u = threadIdx.x; u < (LDS_BYTES - LDSCTL_OFF) / 4; u += NTHREADS) ((LAS unsigned*)(F.lds + LDSCTL_OFF))[u] = 0u;
    __syncthreads();
    XcdBarrier bar; bar.bar = F.ctl + CW_BAR; bar.x = 0; bar.st = nullptr;
    if (MK_N_LAUNCHES == 1) bar = xcd_barrier_post(F.ctl + CW_BAR, F.MISC + 8);
    const int lo = args.ph_lo, hi = args.ph_hi;
#define IN(k) (lo <= (k) && (k) < hi)
    unsigned long long pr_t0 = 0, pr_span = 0;
#ifndef PROBE_CYC
#define PROBE_CYC 0
#endif
#define PB(k) do { if (PROBE_PH == (k)) pr_t0 = PROBE_CYC ? __builtin_amdgcn_s_memtime() : __builtin_amdgcn_s_memrealtime(); } while (0)
#define PE(k) do { if (PROBE_PH == (k)) pr_span += (PROBE_CYC ? __builtin_amdgcn_s_memtime() / 1 : __builtin_amdgcn_s_memrealtime()) - pr_t0; } while (0)
#define SEAMX(k, kn) do { if (IN(k) && IN(kn)) { if (PROBE_PH == 100 || PROBE_PH == 100 + (k)) pr_t0 = __builtin_amdgcn_s_memrealtime(); xcd_barrier(bar); if (PROBE_PH == 100 || PROBE_PH == 100 + (k)) pr_span += __builtin_amdgcn_s_memrealtime() - pr_t0; } } while (0)
#define SEAM(k) SEAMX(k, (k) + 1)
    LAS unsigned char* ring = F.lds + RING_OFF;
    const int G = F.G, c = F.bx;
    float* rstd = (float*)(ws + WS_RSTD); float* psum = (float*)(ws + WS_PSUM); bf16_t* xb = (bf16_t*)(ws + WS_XB);

    PB(0);
    if (IN(0)) p_prologue(F);
    PE(0);
    SEAM(0);
    PB(1);
    if (IN(1)) { pg::DenseOrder S{(const char*)xb, (const char*)(ws + WS_WIN), (char*)(ws + WS_U), D * 2, D * 2, D, 2, M / 256, D / 256, D / 64, G, c, 4};
        pg::EpiBf16 E{rstd}; pg::gemm_phase<pg::EpiBf16, pg::DenseOrder, true, true>(ring, S, E, F.wave, pr_span); }
    PE(1);
    SEAM(1);
    PB(2);
    if (IN(2)) { p_pool(F); p_fold(F); p_ych(F); }
    PE(2);
    SEAMX(2, 3);
    PB(3);
    if (IN(3)) { YFOrder S{(const char*)(ws + WS_GT), (const char*)(ws + WS_UFP), (const char*)(ws + WS_UFM), (char*)(ws + WS_YFP), (char*)(ws + WS_YFS), G, c};
        pg::EpiBf16 E{nullptr}; pg::gemm_phase<pg::EpiBf16, YFOrder, true, true>(ring, S, E, F.wave, pr_span); }
    PE(3);
    SEAMX(3, 19);
    PB(19);
    if (IN(19)) { p_alt(F);
        EOOrder S{(const char*)(ws + WS_DFTP), (const char*)(ws + WS_DFTS), (const char*)(ws + WS_YFP), (const char*)(ws + WS_YFS), (char*)(ws + WS_EB), (char*)(ws + WS_OB2), (const char*)(ws + WS_POOLED), (const char*)(ws + WS_POOLT), (char*)(ws + WS_CAT), G, c};
        pg::EpiMix E{}; pg::gemm_phase<pg::EpiMix, EOOrder, true, true>(ring, S, E, F.wave, pr_span); }
    PE(19);
    SEAMX(19, 20);
    PB(20);
    if (IN(20)) p_unfold(F);
    PE(20);
    SEAMX(20, 4);
    PB(4);
    if (IN(4)) { pg::DenseOrder S{(const char*)(ws + WS_CAT), (const char*)(ws + WS_WOE), nullptr, D * 2, D * 2, D, 4, M / 256, D / 256, D / 64, G, c, 4};
        pg::EpiResid E{xb, psum}; pg::gemm_phase<pg::EpiResid, pg::DenseOrder, true, true>(ring, S, E, F.wave, pr_span); }
    PE(4);
    SEAM(4);
    PB(5);
    if (IN(5)) p_finalize_rstd(F);
    PE(5);
    SEAM(5);
    PB(6);
    if (IN(6)) { pg::DynOrder S{{(const char*)xb, (const char*)(ws + WS_WUP), nullptr, D * 2, D * 2, 0, 0, M / 256, NUP / 256, D / 64, G, c, 4}, F.ctl + CW_DYN, F.MISC + 16, F.wave, 2};
        pg::EpiFfnUp E{(bf16_t*)(ws + WS_ACT), (float*)(ws + WS_HALO), rstd, F.in[18], F.in[19]}; pg::gemm_phase<pg::EpiFfnUp, pg::DynOrder, true, true>(ring, S, E, F.wave, pr_span);
        p_wdn_filler(F, 0, F.ctl + CW_DYN + 64 * 2); }
    PE(6);
    SEAM(6);
    PB(7);
    if (IN(7)) p_fixup(F, F.in[18], F.in[19]);
    PE(7);
    SEAM(7);
    PB(8);
    if (IN(8)) { pg::DenseOrder S{(const char*)(ws + WS_ACT), (const char*)(ws + WS_WDN), nullptr, DFF * 2, DFF * 2, D, 4, M / 256, D / 256, DFF / 64, G, c, 4};
        pg::EpiResid E{xb, psum}; pg::gemm_phase<pg::EpiResid, pg::DenseOrder, true, true>(ring, S, E, F.wave, pr_span); }
    PE(8);
    SEAM(8);
    PB(9);
    if (IN(9)) p_finalize_rstd(F);
    PE(9);
    SEAM(9);
    PB(10);
    if (IN(10)) { pg::DenseOrder S{(const char*)xb, (const char*)(ws + WS_WQKV), (char*)(ws + WS_QKV), D * 2, D * 2, NQKV, 2, M / 256, NQKV / 256, D / 64, G, c, 4};
        pg::EpiQkv E{rstd, (const float*)(ws + WS_ROT)}; pg::gemm_phase<pg::EpiQkv, pg::DenseOrder, true, true>(ring, S, E, F.wave, pr_span); }
    PE(10);
    SEAM(10);
    PB(11);
    if (IN(11)) {
        const bf16_t* qkv = (const bf16_t*)(ws + WS_QKV); bf16_t* oa = (bf16_t*)(ws + WS_OA);
        const int nun = 1024 + 2048;
        for (int i = 0;; ++i) {
            int id;
            if (G == 256) { const int x = c & 7, j = c >> 3;
                if (i < 4) id = (4 * x + i) * 32 + j;
                else if (i < 10) { const int p = 32 * x + 4 * (i - 4) + (j >> 3); id = 1024 + p * 8 + (j & 7); }
                else {
                    if (threadIdx.x == 0) F.MISC[20] = __hip_atomic_fetch_add(F.ctl + CW_DYN + 64 * 8, 1u, __ATOMIC_RELAXED, __HIP_MEMORY_SCOPE_AGENT);
                    __syncthreads();
                    const unsigned t = (unsigned)__builtin_amdgcn_readfirstlane((int)F.MISC[20]);
                    __syncthreads();
                    if (t >= 512u) break;
                    const int p = 32 * (int)(t >> 6) + 24 + (int)((t & 63u) >> 3); id = 1024 + p * 8 + (int)(t & 7u);
                }
            } else { id = i * G + c; if (id >= nun) break; }
            int row0, L, hm, qb;
            if (id < 1024) { hm = id >> 5; qb = id & 31; row0 = 0; L = LP; }
            else { const int k = id - 1024, p = k >> 3; qb = k & 7; hm = p & 31; row0 = MP + (p >> 5) * LS; L = LS; }
            const int h = hm >> 1, m = hm & 1;
            const bf16_t* Qb = qkv + (size_t)(row0 + qb * 256) * NQKV + h * 256 + m * 128;
            const bf16_t* Kh = qkv + (size_t)row0 * NQKV + D + h * 256 + m * 128;
            const bf16_t* Vh = qkv + (size_t)row0 * NQKV + 2 * D + h * 256;
            bf16_t* Ob = oa + (size_t)m * M * D + (size_t)(row0 + qb * 256) * D + 2 * (h * 256);
            at::attn256_body(Qb, Kh, Vh, Ob, L, (char*)lds + RING_OFF, F.wave);
        }
    }
    PE(11);
    SEAM(11);
    PB(12);
    if (IN(12)) p_combine(F);
    PE(12);
    SEAM(12);
    PB(13);
    if (IN(13)) { pg::DenseOrder S{(const char*)(ws + WS_OB), (const char*)(ws + WS_WOO), nullptr, D * 2, D * 2, D, 4, M / 256, D / 256, D / 64, G, c, 4};
        pg::EpiResid E{xb, psum}; pg::gemm_phase<pg::EpiResid, pg::DenseOrder, true, true>(ring, S, E, F.wave, pr_span); }
    PE(13);
    SEAM(13);
    PB(14);
    if (IN(14)) p_finalize_rstd(F);
    PE(14);
    SEAM(14);
    PB(15);
    if (IN(15)) { pg::DynOrder S{{(const char*)xb, (const char*)(ws + WS_WUP + (size_t)NUP * D * 2), nullptr, D * 2, D * 2, 0, 0, M / 256, NUP / 256, D / 64, G, c, 4}, F.ctl + CW_DYN + 64, F.MISC + 18, F.wave, 2};
        pg::EpiFfnUp E{(bf16_t*)(ws + WS_ACT), (float*)(ws + WS_HALO), rstd, F.in[18] + 3 * NUP, F.in[19] + NUP}; pg::gemm_phase<pg::EpiFfnUp, pg::DynOrder, true, true>(ring, S, E, F.wave, pr_span);
        p_wdn_filler(F, 1, F.ctl + CW_DYN + 64 * 3); }
    PE(15);
    SEAM(15);
    PB(16);
    if (IN(16)) p_fixup(F, F.in[18] + 3 * NUP, F.in[19] + NUP);
    PE(16);
    SEAM(16);
    PB(17);
    if (IN(17)) { pg::DenseOrder S{(const char*)(ws + WS_ACT), (const char*)(ws + WS_WDN + (size_t)D * DFF * 2), nullptr, DFF * 2, DFF * 2, D, 4, M / 256, D / 256, DFF / 64, G, c, 4};
        pg::EpiResid E{xb, psum}; pg::gemm_phase<pg::EpiResid, pg::DenseOrder, true, true>(ring, S, E, F.wave, pr_span); }
    PE(17);
    SEAM(17);
    PB(18);
    if (IN(18)) p_final(F);
    PE(18);
    if (PROBE_PH >= 0) { const unsigned long long te = __builtin_amdgcn_s_memrealtime(); while (__builtin_amdgcn_s_memrealtime() - te < (PROBE_CYC ? pr_span / 24 : pr_span)) __builtin_amdgcn_s_sleep(16); }
#undef PB
#undef PE
#undef IN
#undef SEAM
#undef SEAMX
}

extern "C" void kernel_launch(void* const* d_in, const int* in_sizes, int n_in, void* d_out, int out_size, void* d_ws, size_t ws_size, hipStream_t stream) {
    static int grid = 0;
    if (grid == 0) {
        if (n_in != 22 || out_size != M * D || ws_size < WS_END) { fprintf(stderr, "kernel_launch: unexpected shapes: n_in %d out %d ws %zu (need %zu)\n", n_in, out_size, ws_size, (size_t)WS_END); grid = -1; return; }
        int dev = 0, cus = 0, per_cu = 0;
        if (hipGetDevice(&dev) != hipSuccess || hipDeviceGetAttribute(&cus, hipDeviceAttributeMultiprocessorCount, dev) != hipSuccess) { grid = -1; return; }
        if (hipFuncSetAttribute((const void*)mk_fwd, hipFuncAttributeMaxDynamicSharedMemorySize, LDS_BYTES) != hipSuccess) { fprintf(stderr, "kernel_launch: hipFuncSetAttribute failed\n"); grid = -1; return; }
        if (hipOccupancyMaxActiveBlocksPerMultiprocessor(&per_cu, (const void*)mk_fwd, NTHREADS, LDS_BYTES) != hipSuccess || per_cu < 1)
            fprintf(stderr, "kernel_launch: note: occupancy query reports %d workgroups per CU\n", per_cu);
        (void)hipGetLastError();
        grid = cus;
    }
    if (grid < 0) return;
    if (hipMemsetAsync((char*)d_ws + WS_CTL, 0, CTL_ZERO_BYTES, stream) != hipSuccess) { fprintf(stderr, "kernel_launch: memset failed\n"); return; }
    Args a{};
    for (int i = 0; i < 22; ++i) a.in[i] = (const float*)d_in[i];
    a.out = (float*)d_out; a.ws = (unsigned char*)d_ws;
#if MK_N_LAUNCHES == 1
    a.ph_lo = 0; a.ph_hi = N_PHASES;
    hipLaunchKernelGGL(mk_fwd, dim3(grid), dim3(NTHREADS), LDS_BYTES, stream, a);
#else
    { static const int order[21] = {0, 1, 2, 3, 19, 20, 4, 5, 6, 7, 8, 9, 10, 11, 12, 13, 14, 15, 16, 17, 18};
      for (int p = 0; p < 21; ++p) { a.ph_lo = order[p]; a.ph_hi = order[p] + 1; hipLaunchKernelGGL(mk_fwd, dim3(grid), dim3(NTHREADS), LDS_BYTES, stream, a); } }
#endif
    const hipError_t le = hipPeekAtLastError();
    if (le != hipSuccess) fprintf(stderr, "kernel_launch: launch failed: %s\n", hipGetErrorName(le));
}
```

```cpp
#include <hip/hip_runtime.h>
#include <cstdio>
#include <cstdint>

#ifndef MK_N_LAUNCHES
#define MK_N_LAUNCHES 1
#endif

#ifndef PROBE_PH
#define PROBE_PH -1
#endif
#define GAS __attribute__((address_space(1)))
#define LAS __attribute__((address_space(3)))
typedef unsigned short bf16_t;
typedef short bf16x8 __attribute__((ext_vector_type(8)));
typedef short s16x4 __attribute__((ext_vector_type(4)));
typedef float f32x4 __attribute__((ext_vector_type(4)));
typedef float f32x2 __attribute__((ext_vector_type(2)));
typedef float f32x16 __attribute__((ext_vector_type(16)));
typedef unsigned u32x4 __attribute__((ext_vector_type(4)));
typedef unsigned u32x2 __attribute__((ext_vector_type(2)));
typedef GAS unsigned gu32;
#define RLX_AGENT __ATOMIC_RELAXED, __HIP_MEMORY_SCOPE_AGENT
#define LDS_WAIT() asm volatile("s_waitcnt lgkmcnt(0)" ::: "memory")
#define VM_WAIT() asm volatile("s_waitcnt vmcnt(0)" ::: "memory")

constexpr int D = 4096, LP = 8192, NSS = 8, LS = 2048, MP = LP, M = LP + NSS * LS;
constexpr int POOL_DIM = 3072, PG = 768, FD = 1024, FH = 256;
constexpr int DFF = 11008, NUP = 2 * DFF, NQKV = 3 * D;
constexpr float NORM_EPS = 1e-6f, SUBLN_EPS = 1e-5f;
constexpr float LAMBDA_INIT = 0.35550906759096327f;
constexpr int NWAVES = 8, NTHREADS = 512;

constexpr size_t MiB = 1u << 20;
constexpr size_t al256(size_t x) { return (x + 255) / 256 * 256; }
constexpr size_t WS_CTL = 0, CTL_ZERO_BYTES = 65536;
constexpr size_t WS_ROT = WS_CTL + CTL_ZERO_BYTES;
constexpr size_t WS_RSTD = WS_ROT + (size_t)LP * 32 * 4;
constexpr size_t WS_PSUM = WS_RSTD + al256((size_t)M * 4);
constexpr size_t WS_WIN = WS_PSUM + (size_t)M * 64 * 4;
constexpr size_t WS_GT = WS_WIN + (size_t)D * D * 2;
constexpr size_t WS_POOLT = WS_GT + (size_t)2048 * 1024 * 2;
constexpr size_t WS_WOE = WS_POOLT + (size_t)4 * PG * PG * 2;
constexpr size_t WS_WQKV = WS_WOE + (size_t)D * D * 2;
constexpr size_t WS_WOO = WS_WQKV + (size_t)NQKV * D * 2;
constexpr size_t WS_WUP = WS_WOO + (size_t)D * D * 2;
constexpr size_t WS_WDN = WS_WUP + (size_t)2 * NUP * D * 2;
constexpr int HP = LP / 2, HS = LS / 2, MH = M / 2;
constexpr size_t WS_DFTP = WS_WDN + (size_t)2 * D * DFF * 2;
constexpr size_t WS_DFTS = WS_DFTP + (size_t)2 * HP * HP * 2;
constexpr size_t WS_XB = WS_DFTS + (size_t)2 * HS * HS * 2;
constexpr size_t WS_OV = WS_XB + (size_t)M * D * 2;
constexpr size_t WS_U = WS_OV;
constexpr size_t WS_POOLED = WS_U + (size_t)M * D * 2;
constexpr size_t WS_CAT = WS_POOLED + (size_t)M * POOL_DIM * 2;
constexpr size_t WS_UFP = WS_CAT + (size_t)M * D * 2;
constexpr size_t WS_UFM = WS_UFP + (size_t)MH * FD * 2;
constexpr size_t WS_YFP = WS_UFM + (size_t)MH * FD * 2;
constexpr size_t WS_YFS = WS_YFP + (size_t)2 * FD * HP * 2;
constexpr size_t WS_EB = WS_YFS + (size_t)NSS * 2 * FD * HS * 2;
constexpr size_t WS_OB2 = WS_EB + (size_t)MH * FD * 4;
constexpr size_t WS_YCH = WS_OB2 + (size_t)MH * FD * 4;
constexpr size_t WS_ALT = WS_YCH + (size_t)9 * FD * 4;
constexpr size_t WS_OV_END0 = WS_ALT + (size_t)9 * FD * 4;
constexpr size_t WS_ACT = WS_OV;
constexpr size_t WS_HALO = WS_ACT + (size_t)M * DFF * 2;
constexpr size_t WS_OV_END1 = WS_HALO + (size_t)(M / 128) * 4 * NUP * 4;
constexpr size_t WS_QKV = WS_OV;
constexpr size_t WS_OA = WS_QKV + (size_t)M * NQKV * 2;
constexpr size_t WS_OV_END2 = WS_OA + (size_t)2 * M * D * 2;
constexpr size_t WS_OB = WS_QKV;
constexpr size_t WS_END = WS_OV_END2 > WS_OV_END1 ? (WS_OV_END2 > WS_OV_END0 ? WS_OV_END2 : WS_OV_END0) : (WS_OV_END1 > WS_OV_END0 ? WS_OV_END1 : WS_OV_END0);
static_assert(WS_END <= (size_t)4 * 2 * D * NUP * 4, "workspace must fit 4 x the largest input tensor");

constexpr int CW_TMO = 0, CW_LAM = 64  , CW_BAR = 4096, CW_DYN = 8192  ;

constexpr int RING_OFF = 0, RING_BYTES = 131072;
constexpr int LDS_BYTES = 147456;
constexpr int LDSCTL_OFF = LDS_BYTES - 1024, MISC_OFF = LDSCTL_OFF + 320;

__device__ __forceinline__ unsigned f2bf(float f) { unsigned u = __builtin_bit_cast(unsigned, f); return (u + 0x7fffu + ((u >> 16) & 1u)) >> 16; }
__device__ __forceinline__ unsigned pk2(float lo, float hi) { return f2bf(lo) | (f2bf(hi) << 16); }
__device__ __forceinline__ unsigned cvt_pk_bf16(float lo, float hi) { unsigned r; asm volatile("v_cvt_pk_bf16_f32 %0, %1, %2" : "=v"(r) : "v"(lo), "v"(hi)); return r; }
__device__ __forceinline__ float bf2f(unsigned short b) { return __builtin_bit_cast(float, (unsigned)b << 16); }
__device__ __forceinline__ int tid_opaque(int wave) { int l; asm volatile("v_mbcnt_lo_u32_b32 %0, -1, 0\n\tv_mbcnt_hi_u32_b32 %0, -1, %0" : "=v"(l)); return wave * 64 + l; }
__device__ __forceinline__ float wave_sum(float v) {
#pragma unroll
    for (int o = 1; o < 64; o <<= 1) v += __shfl_xor(v, o);
    return v;
}

#define XB_TMO      128
#define XB_XCNT(j)  (256  + 64 * (j))
#define XB_XSUB(j)  (1280 + 64 * (j))
#define XB_XGEN(j)  (2304 + 64 * (j))
#define XB_TOP      3328
#define XB_TOPGEN   3392
#define XCD_BAR_WORDS 3456
#define XB_SPIN_CAP (1u << 18)
__device__ __forceinline__ unsigned xb_ld(unsigned* p)              { return __hip_atomic_load(p, __ATOMIC_RELAXED, __HIP_MEMORY_SCOPE_AGENT); }
__device__ __forceinline__ unsigned xb_add(unsigned* p, unsigned v) { return __hip_atomic_fetch_add(p, v, __ATOMIC_RELAXED, __HIP_MEMORY_SCOPE_AGENT); }
__device__ __forceinline__ unsigned xb_xcc_id() { return (unsigned)__builtin_amdgcn_s_getreg((3 << 11) | 20) & 0xFu; }
#define XB_SPIN(cond, bar) do { unsigned _sp = 0; while (cond) { __builtin_amdgcn_s_sleep(1); \
    if ((++_sp & 255u) == 0u) { if (xb_ld(&(bar)[XB_TMO])) break; if (_sp > XB_SPIN_CAP) { atomicAdd(&(bar)[XB_TMO], 1u); break; } } } } while (0)
struct XcdBarrier { unsigned* bar; unsigned x; volatile LAS unsigned* st; };
__device__ __forceinline__ XcdBarrier xcd_barrier_post(unsigned* bar, volatile LAS unsigned* st) {
    XcdBarrier b; b.bar = bar; b.x = xb_xcc_id(); b.st = st;
    if (threadIdx.x == 0) (void)xb_add(&bar[XB_XCNT(b.x)], 1u);
    return b;
}
__device__ __forceinline__ void xcd_barrier_complete(unsigned* bar, unsigned x, unsigned& nloc, unsigned& nx) {
    const unsigned G = gridDim.x * gridDim.y * gridDim.z;
    unsigned sum, cnt, mine, sp = 0u;
    for (;;) {
        sum = 0u; cnt = 0u; mine = 0u;
#pragma unroll
        for (unsigned j = 0; j < 16; ++j) { const unsigned c = xb_ld(&bar[XB_XCNT(j)]); sum += c; cnt += (c > 0u) ? 1u : 0u; mine = (j == x) ? c : mine; }
        if (sum == G) break;
        __builtin_amdgcn_s_sleep(1);
        if ((++sp & 255u) == 0u) { if (xb_ld(&bar[XB_TMO])) break; if (sp > XB_SPIN_CAP) { atomicAdd(&bar[XB_TMO], 1u); break; } }
    }
    nloc = mine > 0u ? mine : 1u; nx = cnt > 0u ? cnt : 1u;
}
__device__ __forceinline__ void xcd_barrier(const XcdBarrier& b) {
    asm volatile("s_waitcnt vmcnt(0)" ::: "memory");
    __syncthreads();
    if (threadIdx.x == 0) {
        unsigned* bar = b.bar;
        __builtin_amdgcn_s_waitcnt(0);
        unsigned nloc = b.st[0], nx = b.st[1];
        if (nloc == 0u) { xcd_barrier_complete(bar, b.x, nloc, nx); b.st[0] = nloc; b.st[1] = nx; }
        const unsigned old = xb_add(&bar[XB_XSUB(b.x)], 1u);
        const unsigned gen = old / nloc;
        if (old + 1u == (gen + 1u) * nloc) {
            __builtin_amdgcn_fence(__ATOMIC_RELEASE, "agent");
            asm volatile("s_waitcnt vmcnt(0)" ::: "memory");
            const unsigned og = xb_add(&bar[XB_TOP], 1u);
            const unsigned tg = og / nx;
            if (og + 1u == (tg + 1u) * nx) xb_add(&bar[XB_TOPGEN], 1u);
            else XB_SPIN(xb_ld(&bar[XB_TOPGEN]) == tg, bar);
            __builtin_amdgcn_fence(__ATOMIC_ACQUIRE, "agent");
            xb_add(&bar[XB_XGEN(b.x)], 1u);
            asm volatile("s_waitcnt vmcnt(0)" ::: "memory");
        } else {
            XB_SPIN(xb_ld(&bar[XB_XGEN(b.x)]) == gen, bar);
            __builtin_amdgcn_fence(__ATOMIC_ACQUIRE, "agent");
            asm volatile("s_waitcnt vmcnt(0)" ::: "memory");
        }
    }
    __syncthreads();
}

namespace pg {
constexpr int BM = 256, BK = 64, HALF = 128, HTB = HALF * BK * 2, STAGE_BYTES = 8 * HTB;
__host__ __device__ __forceinline__ int lds_byte(int r, int c) { const int st = (r >> 4) * 2 + (c >> 5), rr = r & 15, cc = c & 31, ob = rr * 64 + cc * 2; return st * 1024 + (ob ^ (((ob >> 9) & 1) << 5)); }
__host__ __device__ __forceinline__ void stage_rc(int b, int& R, int& C) { const int st = b / 1024, sb = b % 1024, swz = sb ^ (((sb >> 9) & 1) << 5); R = (st >> 1) * 16 + swz / 64; C = (st & 1) * 32 + (swz % 64) / 2; }
__host__ __device__ __forceinline__ int perm32(int rho) { const int n = rho >> 4, i = rho & 15; return 8 * (i >> 2) + 4 * n + (i & 3); }
__host__ __device__ __forceinline__ int rowperm(int rho) { return (rho >> 6) * 128 + (rho & 15) * 8 + ((rho >> 4) & 3); }

struct GUnit {
    const char* A; const char* B;
    unsigned lda, ldb;
    int nt;
    char* C; unsigned ldc;
    int grow0, gcol0;
    int aux;
};

struct EpiBf16 {
    static constexpr bool PERM = true, ROWPERM = false, PREFETCH = false;
    const float* rstd;
    __device__ __forceinline__ void operator()(f32x4 (&acc)[2][2][4][2], const GUnit& u, int wr, int wc, int fr, int fq) const {
        bf16_t* base = (bf16_t*)u.C + wc * 32 + 8 * fq;
#pragma unroll
        for (int ai = 0; ai < 2; ++ai)
#pragma unroll
            for (int m = 0; m < 4; ++m) {
                const int r = ai * HALF + wr * 64 + m * 16 + fr;
                const float s = rstd ? rstd[u.grow0 + r] : 1.0f;
                bf16_t* rowp = base + (size_t)r * u.ldc;
#pragma unroll
                for (int bj = 0; bj < 2; ++bj) { const f32x4 v0 = acc[ai][bj][m][0] * s, v1 = acc[ai][bj][m][1] * s;
                    u32x4 w; w.x = cvt_pk_bf16(v0[0], v0[1]); w.y = cvt_pk_bf16(v0[2], v0[3]); w.z = cvt_pk_bf16(v1[0], v1[1]); w.w = cvt_pk_bf16(v1[2], v1[3]);
                    *(u32x4*)(rowp + bj * HALF) = w; }
            }
    }
};
struct EpiMix {
    static constexpr bool PERM = true, ROWPERM = false, PREFETCH = false;
    __device__ __forceinline__ void operator()(f32x4 (&acc)[2][2][4][2], const GUnit& u, int wr, int wc, int fr, int fq) const {
        if (u.aux == 0) {
            bf16_t* base = (bf16_t*)u.C + wc * 32 + 8 * fq;
#pragma unroll
            for (int ai = 0; ai < 2; ++ai)
#pragma unroll
                for (int m = 0; m < 4; ++m) { bf16_t* rowp = base + (size_t)(ai * HALF + wr * 64 + m * 16 + fr) * u.ldc;
#pragma unroll
                    for (int bj = 0; bj < 2; ++bj) { const f32x4 v0 = acc[ai][bj][m][0], v1 = acc[ai][bj][m][1];
                        u32x4 w; w.x = cvt_pk_bf16(v0[0], v0[1]); w.y = cvt_pk_bf16(v0[2], v0[3]); w.z = cvt_pk_bf16(v1[0], v1[1]); w.w = cvt_pk_bf16(v1[2], v1[3]);
                        *(u32x4*)(rowp + bj * HALF) = w; } }
        } else {
            float* base = (float*)u.C + wc * 32 + 8 * fq;
#pragma unroll
            for (int ai = 0; ai < 2; ++ai)
#pragma unroll
                for (int m = 0; m < 4; ++m) { float* rowp = base + (size_t)(ai * HALF + wr * 64 + m * 16 + fr) * u.ldc;
#pragma unroll
                    for (int bj = 0; bj < 2; ++bj) { *(f32x4*)(rowp + bj * HALF) = acc[ai][bj][m][0]; *(f32x4*)(rowp + bj * HALF + 4) = acc[ai][bj][m][1]; } }
        }
    }
};
struct EpiResid {
    static constexpr bool PERM = true, ROWPERM = false, PREFETCH = false;
    bf16_t* xb; float* psum;
    __device__ __forceinline__ void operator()(f32x4 (&acc)[2][2][4][2], const GUnit& u, int wr, int wc, int fr, int fq) const {
        const int c0 = u.gcol0 + wc * 32 + 8 * fq;
        bf16_t* base = xb + (size_t)u.grow0 * D + c0;
#pragma unroll
        for (int ai = 0; ai < 2; ++ai) {
            u32x4 old[4][2];
#pragma unroll
            for (int m = 0; m < 4; ++m)
#pragma unroll
                for (int bj = 0; bj < 2; ++bj) old[m][bj] = *(const u32x4*)(base + (size_t)(ai * HALF + wr * 64 + m * 16 + fr) * D + bj * HALF);
#pragma unroll
            for (int m = 0; m < 4; ++m) {
                const int r = ai * HALF + wr * 64 + m * 16 + fr;
                float ss = 0.f;
#pragma unroll
                for (int bj = 0; bj < 2; ++bj) {
                    const u32x4 w0 = old[m][bj];
                    const f32x4 o0 = {bf2f(w0.x & 0xffff), bf2f(w0.x >> 16), bf2f(w0.y & 0xffff), bf2f(w0.y >> 16)}, o1 = {bf2f(w0.z & 0xffff), bf2f(w0.z >> 16), bf2f(w0.w & 0xffff), bf2f(w0.w >> 16)};
                    const f32x4 v0 = acc[ai][bj][m][0] + o0, v1 = acc[ai][bj][m][1] + o1;
                    u32x4 w; w.x = cvt_pk_bf16(v0[0], v0[1]); w.y = cvt_pk_bf16(v0[2], v0[3]); w.z = cvt_pk_bf16(v1[0], v1[1]); w.w = cvt_pk_bf16(v1[2], v1[3]);
                    *(u32x4*)(base + (size_t)r * D + bj * HALF) = w;
                    ss += (v0[0] * v0[0] + v0[1] * v0[1]) + (v0[2] * v0[2] + v0[3] * v0[3]) + (v1[0] * v1[0] + v1[1] * v1[1]) + (v1[2] * v1[2] + v1[3] * v1[3]);
                }
                ss += __shfl_xor(ss, 16); ss += __shfl_xor(ss, 32);
                if (fq == 0) psum[(size_t)(u.grow0 + r) * 64 + (u.gcol0 >> 8) * 4 + wc] = ss;
            }
            asm volatile("" ::: "memory");
        }
    }
};
struct EpiFfnUp {
    static constexpr bool PERM = true, ROWPERM = true, PREFETCH = true;
    bf16_t* act; float* halo; const float* rstd; const float* cw; const float* cb;
    static constexpr int PAR_BYTES = 5120;
    __device__ __forceinline__ void prefetch(const GUnit& u, LAS unsigned char* par, int wid, int lane) const {
        if (wid == 0) __builtin_amdgcn_global_load_lds((const unsigned*)(rstd + u.grow0 + lane * 4), (LAS unsigned*)(par), 16, 0, 0);
        else if (wid < 5) { const int a = 2 * (wid - 1) + (lane >> 5), cg = (u.gcol0 >> 1) + (lane & 31) * 4;
            const float* src = ((a & 3) == 3 ? cb : cw + (size_t)(a & 3) * NUP) + (a >> 2) * DFF + cg;
            __builtin_amdgcn_global_load_lds((const unsigned*)src, (LAS unsigned*)(par + 1024 + (wid - 1) * 1024), 16, 0, 0); }
    }
    __device__ __forceinline__ void operator()(f32x4 (&acc)[2][2][4][2], const GUnit& u, int wr, int wc, int fr, int fq, const LAS unsigned char* par) const {
        const int t0 = u.grow0 + wr * 128 + fr * 8;
        const int c0 = (u.gcol0 >> 1) + wc * 32 + 8 * fq;
        const int cl = wc * 32 + 8 * fq;
        {   const LAS f32x4* rp = (const LAS f32x4*)(par + (wr * 128 + fr * 8) * 4); const f32x4 ra = rp[0], rb = rp[1];
#pragma unroll
            for (int bj = 0; bj < 2; ++bj)
#pragma unroll
                for (int n = 0; n < 2; ++n) {
#pragma unroll
                    for (int m = 0; m < 4; ++m) { acc[0][bj][m][n] *= ra[m]; acc[1][bj][m][n] *= rb[m]; } } }
        const int blk = (u.grow0 >> 7) + wr;
        if (fr == 0 || fr == 15) {
            float* hp = halo + (size_t)blk * 4 * NUP + (fr == 0 ? 0 : 2 * NUP);
#pragma unroll
            for (int bj = 0; bj < 2; ++bj)
#pragma unroll
                for (int n = 0; n < 2; ++n) {
                    const f32x4 e0 = (fr == 0) ? acc[0][bj][0][n] : acc[1][bj][2][n];
                    const f32x4 e1 = (fr == 0) ? acc[0][bj][1][n] : acc[1][bj][3][n];
                    *(f32x4*)(hp + bj * DFF + c0 + 4 * n) = e0; *(f32x4*)(hp + NUP + bj * DFF + c0 + 4 * n) = e1; }
        }
        unsigned pk[8][4];
#pragma unroll
        for (int n = 0; n < 2; ++n) {
            const LAS f32x4* wp = (const LAS f32x4*)(par + 1024 + (cl + 4 * n) * 4);
            const f32x4 g0 = wp[0], g1 = wp[32], g2 = wp[64], gb = wp[96], u0 = wp[128], u1 = wp[160], u2 = wp[192], ub = wp[224];
            f32x4 gm1, gp8, um1, up8;
#pragma unroll
            for (int q = 0; q < 4; ++q) { gm1[q] = __shfl_up(acc[1][0][3][n][q], 1, 16); gp8[q] = __shfl_down(acc[0][0][0][n][q], 1, 16);
                                          um1[q] = __shfl_up(acc[1][1][3][n][q], 1, 16); up8[q] = __shfl_down(acc[0][1][0][n][q], 1, 16); }
#pragma unroll
            for (int j = 0; j < 8; ++j) {
                const f32x4 gl = (j == 0) ? gm1 : acc[(j + 7) >> 2 & 1][0][(j + 7) & 3][n], gc = acc[j >> 2][0][j & 3][n], gr = (j == 7) ? gp8 : acc[((j + 1) >> 2) & 1][0][(j + 1) & 3][n];
                const f32x4 ul = (j == 0) ? um1 : acc[(j + 7) >> 2 & 1][1][(j + 7) & 3][n], uc = acc[j >> 2][1][j & 3][n], ur = (j == 7) ? up8 : acc[((j + 1) >> 2) & 1][1][(j + 1) & 3][n];
                const f32x4 yg = __builtin_elementwise_fma(gr, g2, __builtin_elementwise_fma(gc, g1, __builtin_elementwise_fma(gl, g0, gb)));
                const f32x4 yu = __builtin_elementwise_fma(ur, u2, __builtin_elementwise_fma(uc, u1, __builtin_elementwise_fma(ul, u0, ub)));
                const f32x4 e = yg * (-1.4426950408889634f);
                f32x4 a;
#pragma unroll
                for (int q = 0; q < 4; ++q) a[q] = __builtin_amdgcn_rcpf(1.0f + __builtin_amdgcn_exp2f(e[q]));
                a = a * yg * yu;
                pk[j][2 * n] = cvt_pk_bf16(a[0], a[1]); pk[j][2 * n + 1] = cvt_pk_bf16(a[2], a[3]);
            }
        }
#pragma unroll
        for (int j = 0; j < 8; ++j) {
            const bool edge = (j == 0 && fr == 0) || (j == 7 && fr == 15);
            if (!edge) { u32x4 w; w.x = pk[j][0]; w.y = pk[j][1]; w.z = pk[j][2]; w.w = pk[j][3]; *(u32x4*)(act + (size_t)(t0 + j) * DFF + c0) = w; }
        }
    }
};
struct EpiQkv {
    static constexpr bool PERM = true, ROWPERM = false, PREFETCH = false;
    const float* rstd; const float* rot;
    __device__ __forceinline__ void operator()(f32x4 (&acc)[2][2][4][2], const GUnit& u, int wr, int wc, int fr, int fq) const {
        bf16_t* base = (bf16_t*)u.C + wc * 32 + 8 * fq;
        const bool rotary = (u.gcol0 < 2 * D) && (wc == 0);
#pragma unroll
        for (int ai = 0; ai < 2; ++ai)
#pragma unroll
            for (int m = 0; m < 4; ++m) {
                const int r = ai * HALF + wr * 64 + m * 16 + fr, gr = u.grow0 + r;
                const float s = rstd[gr];
                f32x4 v[2][2];
#pragma unroll
                for (int bj = 0; bj < 2; ++bj)
#pragma unroll
                    for (int n = 0; n < 2; ++n) v[bj][n] = acc[ai][bj][m][n] * s;
                if (rotary) {
                    const int pos = (gr < MP) ? gr : (gr & (LS - 1));
                    const float* rp = rot + (size_t)pos * 32 + 8 * (fq & 1);
                    const float sgn = (fq < 2) ? -1.0f : 1.0f;
#pragma unroll
                    for (int n = 0; n < 2; ++n) { const f32x4 cs = *(const f32x4*)(rp + 4 * n), sn = *(const f32x4*)(rp + 16 + 4 * n);
#pragma unroll
                        for (int bj = 0; bj < 2; ++bj) { f32x4 p;
#pragma unroll
                            for (int q = 0; q < 4; ++q) p[q] = __shfl_xor(v[bj][n][q], 32);
                            v[bj][n] = v[bj][n] * cs + p * (sn * sgn); } }
                }
                bf16_t* rowp = base + (size_t)r * u.ldc;
#pragma unroll
                for (int bj = 0; bj < 2; ++bj) { u32x4 w; w.x = cvt_pk_bf16(v[bj][0][0], v[bj][0][1]); w.y = cvt_pk_bf16(v[bj][0][2], v[bj][0][3]); w.z = cvt_pk_bf16(v[bj][1][0], v[bj][1][1]); w.w = cvt_pk_bf16(v[bj][1][2], v[bj][1][3]);
                    *(u32x4*)(rowp + bj * HALF) = w; }
            }
    }
};

template <class Epi, class Sched, bool ALIGN_EPI, bool SP2>
__device__ __forceinline__ void gemm_phase(LAS unsigned char* lds, const Sched& S, const Epi& E, const int wid, unsigned long long& epi_ticks) {
    const int tid = tid_opaque(wid), lane = tid & 63, wr = wid >> 2, wc = wid & 3, fr = lane & 15, fq = lane >> 4;
    unsigned RA[2], RB[2], C2[2];
#pragma unroll
    for (int i = 0; i < 2; ++i) { int R, C; stage_rc(tid * 16 + i * 8192, R, C);
        RA[i] = (unsigned)(Epi::ROWPERM ? rowperm(R) : R); RB[i] = (unsigned)(Epi::PERM ? ((R & ~31) + perm32(R & 31)) : R); C2[i] = (unsigned)C * 2u; }
    constexpr unsigned HROWS_A = Epi::ROWPERM ? 4u : 128u;
    const size_t kstep = (size_t)(BK * 2);
    const unsigned ldsw = (unsigned)wid * 1024u;
    const int aoff = lds_byte(wr * 64 + fr, fq * 8), boff = lds_byte(wc * 32 + fr, fq * 8);
#define PG_SA(b, h) (((b) * 2 + (h)) * HTB)
#define PG_SB(b, h) ((4 + (b) * 2 + (h)) * HTB)
#define PG_STAGE(bufoff, gbase, R, ld) do { _Pragma("unroll") for (int _i = 0; _i < 2; ++_i) \
        __builtin_amdgcn_global_load_lds((const unsigned*)((gbase) + (size_t)((R)[_i] * (ld) + C2[_i])), (LAS unsigned*)(lds + (bufoff) + ldsw + _i * 8192), 16, 0, 0); } while (0)
#define PG_LDA(dst, b, h) do { _Pragma("unroll") for (int m = 0; m < 4; ++m) _Pragma("unroll") for (int k = 0; k < 2; ++k) dst[m][k] = *(const LAS bf16x8*)(lds + PG_SA(b, h) + aoff + m * 2048 + k * 1024); } while (0)
#define PG_LDB(dst, b, h) do { _Pragma("unroll") for (int n = 0; n < 2; ++n) _Pragma("unroll") for (int k = 0; k < 2; ++k) dst[n][k] = *(const LAS bf16x8*)(lds + PG_SB(b, h) + boff + n * 2048 + k * 1024); } while (0)
#define PG_MMA(ai, bj, At, Bt) do { __builtin_amdgcn_s_setprio(1); _Pragma("unroll") for (int m = 0; m < 4; ++m) _Pragma("unroll") for (int n = 0; n < 2; ++n) _Pragma("unroll") for (int k = 0; k < 2; ++k) \
        acc[ai][bj][m][n] = __builtin_amdgcn_mfma_f32_16x16x32_bf16(Bt[n][k], At[m][k], acc[ai][bj][m][n], 0, 0, 0); __builtin_amdgcn_s_setprio(0); } while (0)
#define PG_WAIT_V(n) asm volatile("s_waitcnt vmcnt(" #n ")" ::: "memory")
#define PG_WAIT_L(n) asm volatile("s_waitcnt lgkmcnt(" #n ")" ::: "memory")
#define PG_BAR __builtin_amdgcn_s_barrier()
#define PG_SCHED __builtin_amdgcn_sched_barrier(0)
    GUnit cur, nxt; int ui = 0;
    if (!S.next(0, cur)) return;
    f32x4 acc[2][2][4][2];
#pragma unroll
    for (int a = 0; a < 2; ++a)
#pragma unroll
        for (int b = 0; b < 2; ++b)
#pragma unroll
            for (int m = 0; m < 4; ++m)
#pragma unroll
                for (int n = 0; n < 2; ++n) acc[a][b][m][n] = (f32x4){0.f, 0.f, 0.f, 0.f};
    bf16x8 At[4][2], B0[2][2], B1[2][2];
    const char* cA = cur.A; const char* cB = cur.B; unsigned lda = cur.lda, ldb = cur.ldb; int nt = cur.nt;
    LAS unsigned char* const par = lds + STAGE_BYTES;
    if constexpr (Epi::PREFETCH) E.prefetch(cur, par, wid, lane);
    {   const size_t hA = (size_t)HROWS_A * lda, hB = (size_t)128 * ldb;
        if constexpr (SP2) {
            PG_STAGE(PG_SB(0, 0), cB, RB, ldb); PG_STAGE(PG_SB(0, 1), cB + hB, RB, ldb); PG_STAGE(PG_SA(0, 0), cA, RA, lda); PG_STAGE(PG_SA(0, 1), cA + hA, RA, lda);
            if (wr == 1) PG_BAR;
            PG_WAIT_V(2); PG_BAR;
            PG_STAGE(PG_SB(1, 0), cB + kstep, RB, ldb); PG_STAGE(PG_SA(1, 0), cA + kstep, RA, lda); PG_STAGE(PG_SB(1, 1), cB + hB + kstep, RB, ldb);
            PG_WAIT_V(6); PG_BAR;
        } else {
            PG_STAGE(PG_SB(0, 0), cB, RB, ldb); PG_STAGE(PG_SA(0, 0), cA, RA, lda); PG_STAGE(PG_SB(0, 1), cB + hB, RB, ldb); PG_STAGE(PG_SA(0, 1), cA + hA, RA, lda);
            if (wr == 1) PG_BAR;
            PG_WAIT_V(4); PG_BAR;
            PG_STAGE(PG_SB(1, 0), cB + kstep, RB, ldb); PG_STAGE(PG_SA(1, 0), cA + kstep, RA, lda); PG_STAGE(PG_SB(1, 1), cB + hB + kstep, RB, ldb);
            PG_WAIT_V(6); PG_BAR;
        }
    }
    for (;;) {
        const bool has_next = S.next(ui + 1, nxt);
        const char* nA = has_next ? nxt.A : cA; const char* nB = has_next ? nxt.B : cB;
        const unsigned nlda = has_next ? nxt.lda : lda, nldb = has_next ? nxt.ldb : ldb;
        const size_t hA = (size_t)HROWS_A * lda, hB = (size_t)128 * ldb;
        for (int t = 0; t < nt; t += 2) {
            const bool last = (t == nt - 2);
            const char* a1 = cA + (size_t)(t + 1) * kstep;
            const char* a2 = last ? nA : cA + (size_t)(t + 2) * kstep; const char* b2 = last ? nB : cB + (size_t)(t + 2) * kstep;
            const unsigned lda2 = last ? nlda : lda, ldb2 = last ? nldb : ldb;
            const size_t hA2 = (size_t)HROWS_A * lda2, hB2 = (size_t)128 * ldb2;
            const char* a3 = a2 + kstep; const char* b3 = b2 + kstep;
            if constexpr (SP2) {
            PG_LDB(B0, 0, 0); PG_LDB(B1, 0, 1); PG_SCHED; PG_LDA(At, 0, 0); PG_STAGE(PG_SA(1, 1), a1 + hA, RA, lda);
            PG_WAIT_V(8); PG_WAIT_L(0); PG_BAR; PG_MMA(0, 0, At, B0); PG_MMA(0, 1, At, B1); PG_BAR; PG_SCHED;
            PG_LDA(At, 0, 1); PG_STAGE(PG_SB(0, 0), b2, RB, ldb2); PG_STAGE(PG_SB(0, 1), b2 + hB2, RB, ldb2); PG_STAGE(PG_SA(0, 0), a2, RA, lda2);
            PG_WAIT_V(8); PG_WAIT_L(0); PG_BAR; PG_MMA(1, 0, At, B0); PG_MMA(1, 1, At, B1); PG_BAR; PG_SCHED;
            PG_LDB(B0, 1, 0); PG_LDB(B1, 1, 1); PG_SCHED; PG_LDA(At, 1, 0); PG_STAGE(PG_SA(0, 1), a2 + hA2, RA, lda2);
            PG_WAIT_V(8); PG_WAIT_L(0); PG_BAR; PG_MMA(0, 0, At, B0); PG_MMA(0, 1, At, B1); PG_BAR; PG_SCHED;
            PG_LDA(At, 1, 1); PG_STAGE(PG_SB(1, 0), b3, RB, ldb2); PG_STAGE(PG_SB(1, 1), b3 + hB2, RB, ldb2); PG_STAGE(PG_SA(1, 0), a3, RA, lda2);
            PG_WAIT_V(8); PG_WAIT_L(0); PG_BAR; PG_MMA(1, 0, At, B0); PG_MMA(1, 1, At, B1); PG_BAR; PG_SCHED;
            } else {
            PG_LDB(B0, 0, 0); PG_SCHED; PG_LDA(At, 0, 0); PG_STAGE(PG_SA(1, 1), a1 + hA, RA, lda);
            PG_WAIT_L(8); PG_BAR; PG_WAIT_L(0); PG_MMA(0, 0, At, B0); PG_BAR; PG_SCHED;
            PG_LDB(B1, 0, 1); PG_STAGE(PG_SB(0, 0), b2, RB, ldb2);
            PG_BAR; PG_WAIT_L(0); PG_MMA(0, 1, At, B1); PG_BAR;
            PG_LDA(At, 0, 1); PG_STAGE(PG_SA(0, 0), a2, RA, lda2);
            PG_BAR; PG_WAIT_L(0); PG_MMA(1, 0, At, B0); PG_BAR; PG_SCHED;
            PG_STAGE(PG_SB(0, 1), b2 + hB2, RB, ldb2);
            PG_WAIT_V(6); PG_BAR; PG_MMA(1, 1, At, B1); PG_BAR;
            PG_LDB(B0, 1, 0); PG_SCHED; PG_LDA(At, 1, 0); PG_STAGE(PG_SA(0, 1), a2 + hA2, RA, lda2);
            PG_WAIT_L(8); PG_BAR; PG_WAIT_L(0); PG_MMA(0, 0, At, B0); PG_BAR; PG_SCHED;
            PG_LDB(B1, 1, 1); PG_STAGE(PG_SB(1, 0), b3, RB, ldb2);
            PG_BAR; PG_WAIT_L(0); PG_MMA(0, 1, At, B1); PG_BAR;
            PG_LDA(At, 1, 1); PG_STAGE(PG_SA(1, 0), a3, RA, lda2);
            PG_BAR; PG_WAIT_L(0); PG_MMA(1, 0, At, B0); PG_BAR; PG_SCHED;
            PG_STAGE(PG_SB(1, 1), b3 + hB2, RB, ldb2);
            PG_WAIT_V(6); PG_BAR; PG_MMA(1, 1, At, B1); PG_BAR;
            }
        }
        if constexpr (ALIGN_EPI) { if (wr == 0) PG_BAR; }
        if constexpr (Epi::PREFETCH) { E(acc, cur, wr, wc, fr, fq, par + (ui & 1) * Epi::PAR_BYTES); if (has_next) E.prefetch(nxt, par + ((ui + 1) & 1) * Epi::PAR_BYTES, wid, lane); }
        else E(acc, cur, wr, wc, fr, fq);
        if (!has_next) break;
#pragma unroll
        for (int a = 0; a < 2; ++a)
#pragma unroll
            for (int b = 0; b < 2; ++b)
#pragma unroll
                for (int m = 0; m < 4; ++m)
#pragma unroll
                    for (int n = 0; n < 2; ++n) acc[a][b][m][n] = (f32x4){0.f, 0.f, 0.f, 0.f};
        cur = nxt; cA = nA; cB = nB; lda = nlda; ldb = nldb; nt = cur.nt; ++ui;
        if constexpr (ALIGN_EPI) { if (wr == 1) PG_BAR; }
    }
    PG_WAIT_V(0);
    if constexpr (!ALIGN_EPI) { if (wr == 0) PG_BAR; }
    PG_BAR;
#undef PG_SA
#undef PG_SB
#undef PG_STAGE
#undef PG_LDA
#undef PG_LDB
#undef PG_MMA
#undef PG_WAIT_V
#undef PG_WAIT_L
#undef PG_BAR
#undef PG_SCHED
}

struct DenseOrder {
    const char* A; const char* B; char* C; unsigned lda, ldb, ldc; int csz; int nM, nN, nt, G, c; int gs = 8;
    __device__ __forceinline__ bool next(int i, GUnit& u) const {
        const int nwg = nM * nN; const long L = (long)i * G + c; if (L >= nwg) return false;
        int wgid = (int)L; { const int q = nwg / 8, r = nwg % 8, xcd = wgid % 8, off = wgid / 8; wgid = (xcd < r ? xcd * (q + 1) : r * (q + 1) + (xcd - r) * q) + off; }
        const int nig = gs * nN, gid = wgid / nig, fm = gid * gs, gsz = (nM - fm) < gs ? (nM - fm) : gs;
        const int pm = fm + ((wgid % nig) % gsz), pn = (wgid % nig) / gsz;
        u.A = A + (size_t)pm * 256 * lda; u.B = B + (size_t)pn * 256 * ldb; u.lda = lda; u.ldb = ldb; u.nt = nt;
        u.C = C + ((size_t)pm * 256 * ldc + (size_t)pn * 256) * csz; u.ldc = ldc; u.grow0 = pm * 256; u.gcol0 = pn * 256; u.aux = 0;
        return true;
    }
};
struct DynOrder : DenseOrder {
    unsigned* ctr; volatile LAS unsigned* slot; int wave; int dynr;
    __device__ __forceinline__ bool next(int i, GUnit& u) const {
        const int nwg = nM * nN, sr = nwg / G - dynr, left = nwg - sr * G;
        if (i + 1 >= sr && wave == 0) {
            unsigned t = 0u; if (threadIdx.x == 0) t = __hip_atomic_fetch_add(ctr, 1u, __ATOMIC_RELAXED, __HIP_MEMORY_SCOPE_AGENT);
            t = (unsigned)__builtin_amdgcn_readfirstlane((int)t);
            if (threadIdx.x == 0) slot[(i + 1) & 1] = t;
        }
        long L;
        if (i < sr) L = (long)i * G + c;
        else { const unsigned t = (unsigned)__builtin_amdgcn_readfirstlane((int)slot[i & 1]); if (t >= (unsigned)left) return false; L = (long)sr * G + t; }
        int wgid = (int)L; { const int q = nwg / 8, r = nwg % 8, xcd = wgid % 8, off = wgid / 8; wgid = (xcd < r ? xcd * (q + 1) : r * (q + 1) + (xcd - r) * q) + off; }
        const int nig = gs * nN, gid = wgid / nig, fm = gid * gs, gsz = (nM - fm) < gs ? (nM - fm) : gs;
        const int pm = fm + ((wgid % nig) % gsz), pn = (wgid % nig) / gsz;
        u.A = A + (size_t)pm * 256 * lda; u.B = B + (size_t)pn * 256 * ldb; u.lda = lda; u.ldb = ldb; u.nt = nt;
        u.C = C + ((size_t)pm * 256 * ldc + (size_t)pn * 256) * csz; u.ldc = ldc; u.grow0 = pm * 256; u.gcol0 = pn * 256; u.aux = 0;
        return true;
    }
};
}

namespace at {
constexpr int DH = 128, NW = 8, QBLK = 32, KVBLK = 64;
constexpr float SCALE = 0.088388347648318440f;
constexpr float THR = 8.f;
constexpr int LDQ = NQKV, LDK = NQKV, LDO = D;
constexpr size_t SHM_V = KVBLK * DH * 2, SHM_K = KVBLK * DH * 2, SHM_ATTN = 2 * SHM_V + 2 * SHM_K + NW * 64 * 4;
#define KSWZ(row, colB) ((row) * 256 + ((colB) ^ (((row) & 7) << 4)))
#define SBAR() __builtin_amdgcn_sched_barrier(0)
__device__ __forceinline__ int crow(int r, int hi) { return (r & 3) + 8 * (r >> 2) + 4 * hi; }
__device__ __forceinline__ unsigned cvtpk(float lo, float hi) { unsigned r; asm volatile("v_cvt_pk_bf16_f32 %0, %1, %2" : "=v"(r) : "v"(lo), "v"(hi)); return r; }
__device__ __forceinline__ void partialSM(f32x16& p0, f32x16& p1, float& m_reg, float& mn, float& alpha) {
  constexpr float C = SCALE * 1.4426950408889634f;
  float pmax = p0[0]; for (int r = 1; r < 16; ++r) pmax = fmaxf(pmax, p0[r]); for (int r = 0; r < 16; ++r) pmax = fmaxf(pmax, p1[r]);
  { auto rr = __builtin_amdgcn_permlane32_swap(__float_as_uint(pmax), __float_as_uint(pmax), false, false);
    pmax = fmaxf(__uint_as_float(rr[0]), __uint_as_float(rr[1])); }
  if (__builtin_expect(__all(pmax - m_reg <= THR / SCALE), 1)) { mn = m_reg; alpha = 1.f; }
  else { mn = fmaxf(m_reg, pmax); alpha = __builtin_amdgcn_exp2f((m_reg - mn) * C); m_reg = mn; }
  float mnC = -mn * C;
  for (int r = 0; r < 16; ++r) p0[r] = fmaf(p0[r], C, mnC); for (int r = 0; r < 16; ++r) p1[r] = fmaf(p1[r], C, mnC);
  for (int r = 0; r < 16; ++r) p0[r] = __builtin_amdgcn_exp2f(p0[r]);
}
__device__ __forceinline__ void finishSM(f32x16& p0, f32x16& p1, float alpha, float& l_reg, bf16x8& pa0, bf16x8& pa1, bf16x8& pa2, bf16x8& pa3) {
  for (int r = 0; r < 16; ++r) p1[r] = __builtin_amdgcn_exp2f(p1[r]);
  float ps = 0; for (int r = 0; r < 16; ++r) ps += p0[r]; for (int r = 0; r < 16; ++r) ps += p1[r];
  { auto rr = __builtin_amdgcn_permlane32_swap(__float_as_uint(ps), __float_as_uint(ps), false, false);
    ps = __uint_as_float(rr[0]) + __uint_as_float(rr[1]); }
  l_reg = l_reg * alpha + ps;
#define PK4(P, BASE, OUT) do { unsigned a0 = cvtpk(P[BASE + 0], P[BASE + 1]), a1 = cvtpk(P[BASE + 2], P[BASE + 3]);   \
    unsigned b0 = cvtpk(P[BASE + 4], P[BASE + 5]), b1 = cvtpk(P[BASE + 6], P[BASE + 7]);                              \
    auto r0 = __builtin_amdgcn_permlane32_swap(a0, b0, false, false); auto r1 = __builtin_amdgcn_permlane32_swap(a1, b1, false, false); \
    u32x4 w = {r0[0], r1[0], r0[1], r1[1]}; OUT = *reinterpret_cast<bf16x8*>(&w); } while (0)
  PK4(p0, 0, pa0); PK4(p0, 8, pa1); PK4(p1, 0, pa2); PK4(p1, 8, pa3);
#undef PK4
}
__device__ __forceinline__ void qkt(f32x16& p0, f32x16& p1, const bf16_t* Ks, const bf16x8* qr, int r32, int hi) {
  p0 = f32x16{}; p1 = f32x16{};
  for (int d0 = 0; d0 < 8; ++d0) { int cb = (d0 * 16 + hi * 8) * 2;
    bf16x8 b0 = *reinterpret_cast<const bf16x8*>((const char*)Ks + KSWZ(r32, cb));
    bf16x8 b1 = *reinterpret_cast<const bf16x8*>((const char*)Ks + KSWZ(32 + r32, cb));
    p0 = __builtin_amdgcn_mfma_f32_32x32x16_bf16(b0, qr[d0], p0, 0, 0, 0);
    p1 = __builtin_amdgcn_mfma_f32_32x32x16_bf16(b1, qr[d0], p1, 0, 0, 0); }
}
__device__ __forceinline__ void qkt_pipe(f32x16& p0, f32x16& p1, int kbase, const bf16x8* qr) {
  bf16x8 kb[3][2];
#define KRD(slot, d0) do { const int _a = kbase ^ ((d0) << 5); asm volatile("ds_read_b128 %0, %1" : "=&v"(kb[slot][0]) : "v"(_a) : "memory"); \
    asm volatile("ds_read_b128 %0, %1 offset:8192" : "=&v"(kb[slot][1]) : "v"(_a) : "memory"); } while (0)
#define KW(n) do { asm volatile("s_waitcnt lgkmcnt(" #n ")" ::: "memory"); SBAR(); } while (0)
#define KMM(slot, d0, c0, c1) do { p0 = __builtin_amdgcn_mfma_f32_32x32x16_bf16(kb[slot][0], qr[d0], c0, 0, 0, 0); p1 = __builtin_amdgcn_mfma_f32_32x32x16_bf16(kb[slot][1], qr[d0], c1, 0, 0, 0); SBAR(); } while (0)
  const f32x16 z = f32x16{};
  KRD(0, 0); KRD(1, 1); KRD(2, 2);
  __builtin_amdgcn_s_setprio(3);
  KW(4); KMM(0, 0, z, z); KRD(0, 3);
  KW(4); KMM(1, 1, p0, p1); KRD(1, 4);
  KW(4); KMM(2, 2, p0, p1); KRD(2, 5);
  KW(4); KMM(0, 3, p0, p1); KRD(0, 6);
  KW(4); KMM(1, 4, p0, p1); KRD(1, 7);
  KW(4); KMM(2, 5, p0, p1);
  KW(2); KMM(0, 6, p0, p1);
  KW(0); KMM(1, 7, p0, p1);
  __builtin_amdgcn_s_setprio(0);
#undef KRD
#undef KW
#undef KMM
}
__device__ __forceinline__ int v_st(int k, int c) { const int kk = (k & ~0xC) | ((k & 4) << 1) | ((k & 8) >> 1); return ((kk >> 3) * 4 + (c >> 5)) * 512 + ((kk & 7) * 32 + (c & 31)) * 2; }
__device__ __forceinline__ int v_rd_base(int lane) { return ((lane & 3) << 3) | (((lane >> 2) & 3) << 6) | (((lane >> 4) & 1) << 5) | (((lane >> 5) & 1) << 8); }
constexpr int v_rd_off(int d0, int ks, int half) { return d0 * 512 + ks * 4096 + half * 2048; }
template <int OFF> __device__ __forceinline__ s16x4 tr_read(int vb) {
  s16x4 r; asm volatile("ds_read_b64_tr_b16 %0, %1 offset:%2" : "=&v"(r) : "v"(vb), "i"(OFF) : "memory"); return r;
}
template <int D0> __device__ __forceinline__ void pv_one(f32x16& od, int vb, bf16x8 pa0, bf16x8 pa1, bf16x8 pa2, bf16x8 pa3) {
  const s16x4 l0 = tr_read<v_rd_off(D0, 0, 0)>(vb), h0 = tr_read<v_rd_off(D0, 0, 1)>(vb), l1 = tr_read<v_rd_off(D0, 1, 0)>(vb), h1 = tr_read<v_rd_off(D0, 1, 1)>(vb);
  const s16x4 l2 = tr_read<v_rd_off(D0, 2, 0)>(vb), h2 = tr_read<v_rd_off(D0, 2, 1)>(vb), l3 = tr_read<v_rd_off(D0, 3, 0)>(vb), h3 = tr_read<v_rd_off(D0, 3, 1)>(vb);
  asm volatile("s_waitcnt lgkmcnt(0)" ::: "memory"); SBAR();
#define PK(L, H) (bf16x8){L[0], L[1], L[2], L[3], H[0], H[1], H[2], H[3]}
  od = __builtin_amdgcn_mfma_f32_32x32x16_bf16(pa0, PK(l0, h0), od, 0, 0, 0);
  od = __builtin_amdgcn_mfma_f32_32x32x16_bf16(pa1, PK(l1, h1), od, 0, 0, 0);
  od = __builtin_amdgcn_mfma_f32_32x32x16_bf16(pa2, PK(l2, h2), od, 0, 0, 0);
  od = __builtin_amdgcn_mfma_f32_32x32x16_bf16(pa3, PK(l3, h3), od, 0, 0, 0);
#undef PK
}
__device__ __forceinline__ void pv_d0(f32x16* o, int vb, bf16x8 pa0, bf16x8 pa1, bf16x8 pa2, bf16x8 pa3) {
  pv_one<0>(o[0], vb, pa0, pa1, pa2, pa3); pv_one<1>(o[1], vb, pa0, pa1, pa2, pa3); pv_one<2>(o[2], vb, pa0, pa1, pa2, pa3); pv_one<3>(o[3], vb, pa0, pa1, pa2, pa3);
}
#define TRD(dst, D, vb) do { const int _b = (vb) + ((D) >> 2) * 16384; \
    dst[0] = tr_read<v_rd_off((D) & 3, 0, 0)>(_b); dst[1] = tr_read<v_rd_off((D) & 3, 0, 1)>(_b); dst[2] = tr_read<v_rd_off((D) & 3, 1, 0)>(_b); dst[3] = tr_read<v_rd_off((D) & 3, 1, 1)>(_b); \
    dst[4] = tr_read<v_rd_off((D) & 3, 2, 0)>(_b); dst[5] = tr_read<v_rd_off((D) & 3, 2, 1)>(_b); dst[6] = tr_read<v_rd_off((D) & 3, 3, 0)>(_b); dst[7] = tr_read<v_rd_off((D) & 3, 3, 1)>(_b); } while (0)
#define PKV(L, H) (bf16x8){L[0], L[1], L[2], L[3], H[0], H[1], H[2], H[3]}
#define MM4(od, src) do { __builtin_amdgcn_s_setprio(2); od = __builtin_amdgcn_mfma_f32_32x32x16_bf16(pa0, PKV(src[0], src[1]), od, 0, 0, 0); od = __builtin_amdgcn_mfma_f32_32x32x16_bf16(pa1, PKV(src[2], src[3]), od, 0, 0, 0); \
    od = __builtin_amdgcn_mfma_f32_32x32x16_bf16(pa2, PKV(src[4], src[5]), od, 0, 0, 0); od = __builtin_amdgcn_mfma_f32_32x32x16_bf16(pa3, PKV(src[6], src[7]), od, 0, 0, 0); __builtin_amdgcn_s_setprio(0); } while (0)
#define LW(n) do { asm volatile("s_waitcnt lgkmcnt(" #n ")" ::: "memory"); SBAR(); } while (0)
__device__ __forceinline__ void pv8(f32x16* o, int vb, bf16x8 pa0, bf16x8 pa1, bf16x8 pa2, bf16x8 pa3) {
  s16x4 va[8], vq[8];
  TRD(va, 0, vb); TRD(vq, 1, vb);
  LW(8); MM4(o[0], va); SBAR(); TRD(va, 2, vb);
  LW(8); MM4(o[1], vq); SBAR(); TRD(vq, 3, vb);
  LW(8); MM4(o[2], va); SBAR(); TRD(va, 4, vb);
  LW(8); MM4(o[3], vq); SBAR(); TRD(vq, 5, vb);
  LW(8); MM4(o[4], va); SBAR(); TRD(va, 6, vb);
  LW(8); MM4(o[5], vq); SBAR(); TRD(vq, 7, vb);
  LW(8); MM4(o[6], va);
  LW(0); MM4(o[7], vq);
}
#undef TRD
#undef PKV
#undef MM4
#undef LW
constexpr int KB_BYTES = KVBLK * DH * 2  , VB_BYTES = KVBLK * 256 * 2  ;
constexpr int AT_K_OFF = 0, AT_V_OFF = 2 * KB_BYTES, AT_W_OFF = AT_V_OFF + 2 * VB_BYTES, AT_LDS = AT_W_OFF + NW * 64 * 4;
__device__ __forceinline__ void attn256_body(const bf16_t* __restrict__ Qb, const bf16_t* __restrict__ Kh, const bf16_t* __restrict__ Vh, bf16_t* __restrict__ Ob, int seq, char* lds, const int wid) {
  const int tid = tid_opaque(wid), lane = tid & 63, r32 = lane & 31, hi = lane >> 5, grp = wid >> 2;
  LAS char* L = (LAS char*)lds;
  float* ws = (float*)(lds + AT_W_OFF) + wid * 64; float* li_l = ws; float* al_l = ws + 32;
  float m_reg = -1e30f, l_reg = 0; f32x16 o[8]; bf16x8 qr[8];
#pragma unroll
  for (int d = 0; d < 8; ++d) o[d] = f32x16{};
  const bf16_t* Qw = Qb + (long)(wid * QBLK + r32) * LDQ + hi * 8;
#pragma unroll
  for (int d0 = 0; d0 < 8; ++d0) qr[d0] = *reinterpret_cast<const bf16x8*>(Qw + d0 * 16);
  const int wq = wid & 3;
#define DMA_K(j, b) do { const char* _g = (const char*)Kh + (size_t)(j) * (KVBLK * LDK * 2); const int _l = tid_opaque(0); _Pragma("unroll") for (int _i = 0; _i < 4; ++_i) { \
    const int _r = 16 * wq + 4 * _i + (_l >> 4); const unsigned _o = (unsigned)(_r * (LDK * 2) + (((_l & 15) ^ (_r & 7)) << 4)); \
    __builtin_amdgcn_global_load_lds((const unsigned*)(_g + _o), (LAS unsigned*)(L + AT_K_OFF + (b) * KB_BYTES + wq * 4096 + _i * 1024), 16, 0, 0); } } while (0)
#define DMA_V(j, b) do { const char* _g = (const char*)Vh + (size_t)(j) * (KVBLK * LDK * 2); const int _l = tid_opaque(0); _Pragma("unroll") for (int _i = 0; _i < 8; ++_i) { \
    const int _tt = 8 * (wq & 1) + _i, _kk = (_tt >> 1) * 8 + ((_l & 31) >> 2), _k = (_kk & ~0xC) | ((_kk & 4) << 1) | ((_kk & 8) >> 1); \
    const int _c = (2 * (_tt & 1) + (_l >> 5)) * 32 + (_l & 3) * 8; const unsigned _o = (unsigned)(_k * (LDK * 2) + ((wq >> 1) * 128 + _c) * 2); \
    __builtin_amdgcn_global_load_lds((const unsigned*)(_g + _o), (LAS unsigned*)(L + AT_V_OFF + (b) * VB_BYTES + wq * 8192 + _i * 1024), 16, 0, 0); } } while (0)
#define RESC8(a) do { if (__any((a) < 1.f)) { if (hi == 0) al_l[r32] = (a); asm volatile("s_waitcnt lgkmcnt(0)" ::: "memory"); \
    _Pragma("unroll") for (int d = 0; d < 8; ++d) _Pragma("unroll") for (int r = 0; r < 16; ++r) o[d][r] *= al_l[crow(r, hi)]; } } while (0)
  const int vb0 = (int)(uintptr_t)(lds + AT_V_OFF) + v_rd_base(lane);
  const int NT = seq / KVBLK;
  f32x16 p0, p1; float mn, al; bf16x8 pa0, pa1, pa2, pa3;
  asm volatile("s_waitcnt vmcnt(0)" ::: "memory");
  if (grp) DMA_K(0, 0); else DMA_V(0, 0);
  asm volatile("s_waitcnt vmcnt(0)" ::: "memory"); __builtin_amdgcn_s_barrier();
#define QKSM(jq) do { const int kbase = (int)(uintptr_t)(lds + AT_K_OFF) + ((jq) & 1) * KB_BYTES + r32 * 256 + ((hi << 4) ^ ((r32 & 7) << 4)); qkt_pipe(p0, p1, kbase, qr); partialSM(p0, p1, m_reg, mn, al); RESC8(al); \
    finishSM(p0, p1, al, l_reg, pa0, pa1, pa2, pa3); } while (0)
#define PV(jp) do { const int vb = vb0 + ((jp) & 1) * VB_BYTES; pv8(o, vb, pa0, pa1, pa2, pa3); } while (0)
#define VM0_BAR() do { asm volatile("s_waitcnt vmcnt(0)" ::: "memory"); __builtin_amdgcn_s_barrier(); } while (0)
  if (grp == 0) {
    for (int j = 0; j < NT; ++j) {
      QKSM(j); VM0_BAR();
      if (j + 1 < NT) DMA_V(j + 1, (j + 1) & 1);
      PV(j); __builtin_amdgcn_s_barrier();
    }
    VM0_BAR();
  } else {
    for (int j = 0; j < NT; ++j) {
      if (j + 1 < NT) DMA_K(j + 1, (j + 1) & 1);
      if (j > 0) PV(j - 1);
      __builtin_amdgcn_s_barrier();
      QKSM(j); VM0_BAR();
    }
    PV(NT - 1);
    VM0_BAR();
  }
#undef VM0_BAR
#undef QKSM
#undef PV
  if (hi == 0) li_l[r32] = l_reg; asm volatile("s_waitcnt lgkmcnt(0)" ::: "memory");
  float rli[16];
#pragma unroll
  for (int r = 0; r < 16; ++r) rli[r] = __builtin_amdgcn_rcpf(li_l[crow(r, hi)]);
  unsigned* Ow = (unsigned*)Ob + (long)(wid * (QBLK / 2)) * LDO;
#pragma unroll
  for (int r = 0; r < 16; r += 2) { const int prow = crow(r, hi) >> 1;
#pragma unroll
    for (int d0 = 0; d0 < 8; ++d0) Ow[(long)prow * LDO + d0 * 32 + r32] = cvtpk(o[d0][r] * rli[r], o[d0][r + 1] * rli[r + 1]); }
  asm volatile("s_waitcnt vmcnt(0) lgkmcnt(0)" ::: "memory"); __builtin_amdgcn_s_barrier();
#undef DMA_K
#undef DMA_V
#undef RESC8
}
#undef KSWZ
#undef SBAR
}

struct Frame {
    LAS unsigned char* lds; volatile LAS unsigned* MISC; unsigned* ctl;
    int wave, G, bx;
    const float* in[22]; float* out; unsigned char* ws;
};

constexpr int TP_S = 65, TP_BYTES = 64 * TP_S * 4;
template <bool NT>
__device__ __forceinline__ void transpose_item(const float* W, int K, int N, bf16_t* WT, int k0, int n0, int dst_row0, const float* gk, int gmask, float gmul, const float* gn,
                                               LAS float* scr, int lane) {
    const int lr = lane >> 4, lc = (lane & 15) * 4;
    f32x4 v[16];
#pragma unroll
    for (int i = 0; i < 16; ++i) { const GAS f32x4* p = (const GAS f32x4*)(W + (size_t)(k0 + 4 * i + lr) * N + n0 + lc); if constexpr (NT) v[i] = __builtin_nontemporal_load(p); else v[i] = *p; }
    f32x4 ns = {1.f, 1.f, 1.f, 1.f}; if (gn) ns = *(const f32x4*)(gn + n0 + lc);
#pragma unroll
    for (int i = 0; i < 16; ++i) { const int k = 4 * i + lr; const float ks = (gk ? gk[(k0 + k) & gmask] : 1.0f) * gmul;
        const f32x4 x = v[i] * ns * ks; LAS float* p = scr + k * TP_S + lc; p[0] = x.x; p[1] = x.y; p[2] = x.z; p[3] = x.w; }
    LDS_WAIT(); asm volatile("" ::: "memory");
    const int c = lane >> 3, nl = lane & 7;
#pragma unroll
    for (int j = 0; j < 8; ++j) { const int n = 8 * j + nl; const LAS float* sp = scr + (8 * c) * TP_S + n;
        u32x4 o; o.x = cvt_pk_bf16(sp[0 * TP_S], sp[1 * TP_S]); o.y = cvt_pk_bf16(sp[2 * TP_S], sp[3 * TP_S]); o.z = cvt_pk_bf16(sp[4 * TP_S], sp[5 * TP_S]); o.w = cvt_pk_bf16(sp[6 * TP_S], sp[7 * TP_S]);
        *(GAS u32x4*)(WT + (size_t)(dst_row0 + n) * K + k0 + 8 * c) = o; }
    LDS_WAIT(); asm volatile("" ::: "memory");
}
template <class RowMap>
__device__ __forceinline__ void transpose_matrix(const float* W, int K, int N, bf16_t* WT, const float* gk, int gmask, float gmul, const float* gn, RowMap rowmap,
                                                 LAS float* scr, int lane, int gw, int NGW, int& rot) {
    const int nblk = N / 64, nitems = (K / 64) * nblk;
    int first = gw - rot; if (first < 0) first += NGW;
    for (int it = first; it < nitems; it += NGW) { const int kb = it / nblk, nb = it % nblk;
        transpose_item<true>(W, K, N, WT, 64 * kb, 64 * nb, rowmap(64 * nb), gk, gmask, gmul, gn, scr, lane); }
    rot = (rot + nitems) % NGW;
}
struct RowId { __device__ __forceinline__ int operator()(int n0) const { return n0; } };
struct RowUp { __device__ __forceinline__ int operator()(int n0) const { const int up = n0 >= DFF, nn = up ? n0 - DFF : n0; return (nn >> 7) * 256 + up * 128 + (nn & 127); } };

__device__ __forceinline__ void p_wdn_filler(Frame& F, int l, unsigned* ctr) {
    LAS float* scr = (LAS float*)(F.lds + RING_OFF + F.wave * TP_BYTES);
    const int lane = tid_opaque(F.wave) & 63;
    const float* W = F.in[20] + (size_t)l * DFF * D; bf16_t* WT = (bf16_t*)(F.ws + WS_WDN) + (size_t)l * D * DFF;
    constexpr int NBLK = D / 64, PER = 2, NTICK = (DFF / 64) * NBLK / (NWAVES * PER);
    static_assert((DFF / 64) * NBLK % (NWAVES * PER) == 0, "whole tickets");
    for (int k = 0;; ++k) {
        if (threadIdx.x == 0) F.MISC[22 + (k & 1)] = __hip_atomic_fetch_add(ctr, 1u, __ATOMIC_RELAXED, __HIP_MEMORY_SCOPE_AGENT);
        __syncthreads();
        const unsigned t = (unsigned)__builtin_amdgcn_readfirstlane((int)F.MISC[22 + (k & 1)]);
        if (t >= (unsigned)NTICK) break;
#pragma unroll 1
        for (int b = 0; b < PER; ++b) { const int it = ((int)t * PER + b) * NWAVES + F.wave, kb = it / NBLK, nb = it % NBLK;
            transpose_item<false>(W, DFF, D, WT, 64 * kb, 64 * nb, 64 * nb, nullptr, 0, 1.0f, nullptr, scr, lane); }
    }
}

__device__ __forceinline__ void p_prologue(Frame& F) {
    LAS float* scr = (LAS float*)(F.lds + RING_OFF + F.wave * TP_BYTES);
    const int tid = tid_opaque(F.wave), lane = tid & 63; int rot = 0;
    const int gw = F.bx * NWAVES + F.wave, NGW = F.G * NWAVES;
    unsigned char* ws = F.ws;
    {   float* rstd = (float*)(ws + WS_RSTD); bf16_t* xb = (bf16_t*)(ws + WS_XB);
        for (int r = gw; r < M; r += NGW) {
            const float* xrow = (r < MP) ? F.in[0] + (size_t)r * D : F.in[1] + (size_t)(r - MP) * D;
            const GAS f32x4* xr = (const GAS f32x4*)xrow + lane;
            f32x4 v[16]; float s = 0.f;
#pragma unroll
            for (int j = 0; j < 16; ++j) { v[j] = __builtin_nontemporal_load(xr + 64 * j); s += (v[j].x * v[j].x + v[j].y * v[j].y) + (v[j].z * v[j].z + v[j].w * v[j].w); }
            s = wave_sum(s);
            if (lane == 0) rstd[r] = 1.0f / sqrtf(s * (1.0f / D) + NORM_EPS);
            GAS u32x2* o8 = (GAS u32x2*)(xb + (size_t)r * D) + lane;
#pragma unroll
            for (int j = 0; j < 16; ++j) { u32x2 w; w.x = pk2(v[j].x, v[j].y); w.y = pk2(v[j].z, v[j].w); o8[64 * j] = w; }
        }
    }
    transpose_matrix(F.in[3], D, D, (bf16_t*)(ws + WS_WIN), F.in[2], 0xffff, 1.0f, nullptr, RowId(), scr, lane, gw, NGW, rot);
    for (int g = 0; g < 4; ++g)
        transpose_matrix(F.in[4] + (size_t)g * PG * PG, PG, PG, (bf16_t*)(ws + WS_POOLT) + (size_t)g * PG * PG, nullptr, 0, 1.0f, F.in[5] + g * PG, RowId(), scr, lane, gw, NGW, rot);
    transpose_matrix(F.in[7], D, D, (bf16_t*)(ws + WS_WOE), nullptr, 0, 1.0f, nullptr, RowId(), scr, lane, gw, NGW, rot);
    transpose_matrix(F.in[9], D, NQKV, (bf16_t*)(ws + WS_WQKV), F.in[8], 0xffff, 1.0f, nullptr, RowId(), scr, lane, gw, NGW, rot);
    transpose_matrix(F.in[15], D, D, (bf16_t*)(ws + WS_WOO), F.in[14], 255, 1.0f - LAMBDA_INIT, nullptr, RowId(), scr, lane, gw, NGW, rot);
    for (int l = 0; l < 2; ++l) {
        transpose_matrix(F.in[17] + (size_t)l * D * NUP, D, NUP, (bf16_t*)(ws + WS_WUP) + (size_t)l * NUP * D, F.in[16] + l * D, 0xffff, 1.0f, nullptr, RowUp(), scr, lane, gw, NGW, rot);
    }
    for (int which = 0; which < 2; ++which) {
        const int L = which ? LS : LP, Hf = L / 2; bf16_t* dft = (bf16_t*)(ws + (which ? WS_DFTS : WS_DFTP));
        const float inv = 1.0f / (float)L, nrm = 1.0f / sqrtf((float)L);
        const int chunks = Hf / 512, per = Hf * chunks, nitems = 2 * per;
        for (int it = gw; it < nitems; it += NGW) { const int part = it / per, r = it % per, k = r / chunks, t0 = (r % chunks) * 512 + lane * 8; float v[8];
#pragma unroll
            for (int e = 0; e < 8; ++e) { const int idx = (k * (t0 + e) + (part ? 3 * (L >> 2) : 0)) & (L - 1); v[e] = __builtin_amdgcn_cosf((float)idx * inv) * nrm; }
            u32x4 o; o.x = pk2(v[0], v[1]); o.y = pk2(v[2], v[3]); o.z = pk2(v[4], v[5]); o.w = pk2(v[6], v[7]);
            *(GAS u32x4*)(dft + ((size_t)part * Hf + k) * Hf + t0) = o; }
    }
    {   __syncthreads();
        LAS float* tab = (LAS float*)(F.lds + RING_OFF);
        if (tid < 256) tab[tid] = cospif((float)tid * (1.0f / 128.0f));
        __syncthreads();
        bf16_t* gt = (bf16_t*)(ws + WS_GT); const float* fw = F.in[6];
        for (int it = gw; it < 2048; it += NGW) { const int h = it >> 9, c = ((it >> 7) & 3) * 64 + lane, n0 = (it & 127) * 8;
            float ac[8], as[8];
#pragma unroll
            for (int q = 0; q < 8; ++q) { ac[q] = 0.f; as[q] = 0.f; }
#pragma unroll 4
            for (int cp = 0; cp < 256; ++cp) { const float tc = tab[(c * cp) & 255], ts = tab[(c * cp + 192) & 255];
                const float* fr = fw + (size_t)(h * 256 + cp) * FD + n0;
#pragma unroll
                for (int q = 0; q < 8; ++q) { const float f = fr[q]; ac[q] += tc * f; as[q] += ts * f; } }
#pragma unroll
            for (int q = 0; q < 8; ++q) { gt[(size_t)(2 * (n0 + q)) * FD + h * 256 + c] = (bf16_t)f2bf(ac[q] * (1.0f / 16.0f)); gt[(size_t)(2 * (n0 + q) + 1) * FD + h * 256 + c] = (bf16_t)f2bf(as[q] * (1.0f / 16.0f)); }
        }
    }
    {   float* rot = (float*)(ws + WS_ROT);
        for (int i = gw * 64 + lane; i < LP * 16; i += NGW * 64) { const int pos = i >> 4, j = i & 15;
            const float invf = (float)pow(500000.0, -(double)(2 * j) / 32.0); const float ang = (float)pos * invf;
            rot[pos * 32 + j] = (float)cos((double)ang); rot[pos * 32 + 16 + j] = (float)sin((double)ang); }
        if (F.bx == 0 && F.wave == 0) {
            float a = F.in[10][lane] * F.in[11][lane] + F.in[10][lane + 64] * F.in[11][lane + 64];
            float b = F.in[12][lane] * F.in[13][lane] + F.in[12][lane + 64] * F.in[13][lane + 64];
            a = wave_sum(a); b = wave_sum(b);
            if (lane == 0) F.ctl[CW_LAM] = __builtin_bit_cast(unsigned, expf(a) - expf(b) + LAMBDA_INIT);
        }
    }
}

__device__ __forceinline__ void p_finalize_rstd(Frame& F) {
    const float* psum = (const float*)(F.ws + WS_PSUM); float* rstd = (float*)(F.ws + WS_RSTD);
    const int tid = tid_opaque(F.wave);
    for (int r = F.bx * NTHREADS + tid; r < M; r += F.G * NTHREADS) { const f32x4* p = (const f32x4*)(psum + (size_t)r * 64); float s = 0.f;
#pragma unroll
        for (int j = 0; j < 16; ++j) { const f32x4 v = p[j]; s += (v.x + v.y) + (v.z + v.w); }
        rstd[r] = 1.0f / sqrtf(s * (1.0f / D) + NORM_EPS); }
}

__device__ __forceinline__ f32x4 bf4lo(u32x4 w) { return (f32x4){bf2f(w.x & 0xffff), bf2f(w.x >> 16), bf2f(w.y & 0xffff), bf2f(w.y >> 16)}; }
__device__ __forceinline__ f32x4 bf4hi(u32x4 w) { return (f32x4){bf2f(w.z & 0xffff), bf2f(w.z >> 16), bf2f(w.w & 0xffff), bf2f(w.w >> 16)}; }
__device__ __forceinline__ void p_pool(Frame& F) {
    const bf16_t* u = (const bf16_t*)(F.ws + WS_U); bf16_t* pooled = (bf16_t*)(F.ws + WS_POOLED);
    const int gw = F.bx * NWAVES + F.wave, NGW = F.G * NWAVES, lane = tid_opaque(F.wave) & 63;
    for (int it = gw; it < (M / 32) * 6; it += NGW) {
        const int rc = it / 6, cb = it % 6, t0 = rc * 32, col = cb * 512 + lane * 8, h = 1 << (col / PG);
        const int s0 = (t0 < MP) ? 0 : MP + ((t0 - MP) / LS) * LS, s1 = (t0 < MP) ? MP : s0 + LS;
        const bf16_t* up = u + col;
        f32x4 sa = {0.f, 0.f, 0.f, 0.f}, sb = {0.f, 0.f, 0.f, 0.f};
#pragma unroll
        for (int d = -8; d < 8; ++d) { const int sidx = t0 + d; const bool ok = (d >= -h) && (d < h) && (sidx >= s0) && (sidx < s1); const int sc = sidx < s0 ? s0 : (sidx >= s1 ? s1 - 1 : sidx);
            const u32x4 w = *(const u32x4*)(up + (size_t)sc * D); const float mk = ok ? 1.0f : 0.0f; sa += bf4lo(w) * mk; sb += bf4hi(w) * mk; }
#pragma unroll 8
        for (int t = t0; t < t0 + 32; ++t) {
            const int a = (t - h > s0) ? t - h : s0, b = (t + h < s1) ? t + h : s1;
            const int ia = t + h, is = t - h; const float ma = (ia < s1) ? 1.0f : 0.0f, ms = (is >= s0) ? 1.0f : 0.0f;
            const u32x4 wt = *(const u32x4*)(up + (size_t)t * D), wa = *(const u32x4*)(up + (size_t)(ia < s1 ? ia : s1 - 1) * D), wsb = *(const u32x4*)(up + (size_t)(is >= s0 ? is : s0) * D);
            const float inv = 1.0f / (float)(b - a);
            const f32x4 oa = sa * inv - bf4lo(wt), ob = sb * inv - bf4hi(wt);
            u32x4 ow; ow.x = pk2(oa.x, oa.y); ow.y = pk2(oa.z, oa.w); ow.z = pk2(ob.x, ob.y); ow.w = pk2(ob.z, ob.w);
            *(u32x4*)(pooled + (size_t)t * POOL_DIM + col) = ow;
            sa += bf4lo(wa) * ma - bf4lo(wsb) * ms; sb += bf4hi(wa) * ma - bf4hi(wsb) * ms;
        }
    }
}

__device__ __forceinline__ void hr_decode(int hr, int& s, int& t, int& row0, int& L) { if (hr < HP) { s = 0; t = hr; row0 = 0; L = LP; } else { const int j = hr - HP; s = 1 + (j >> 10); t = j & (HS - 1); row0 = MP + (s - 1) * LS; L = LS; } }
__device__ __forceinline__ void bf8_to_f(u32x4 w, f32x4& lo, f32x4& hi) { lo = (f32x4){bf2f(w.x & 0xffff), bf2f(w.x >> 16), bf2f(w.y & 0xffff), bf2f(w.y >> 16)}; hi = (f32x4){bf2f(w.z & 0xffff), bf2f(w.z >> 16), bf2f(w.w & 0xffff), bf2f(w.w >> 16)}; }
__device__ __forceinline__ void p_fold(Frame& F) {
    const bf16_t* u = (const bf16_t*)(F.ws + WS_U); bf16_t* ufp = (bf16_t*)(F.ws + WS_UFP); bf16_t* ufm = (bf16_t*)(F.ws + WS_UFM);
    const int gw = F.bx * NWAVES + F.wave, NGW = F.G * NWAVES, lane = tid_opaque(F.wave) & 63;
    for (int hr = gw; hr < MH; hr += NGW) { int sq, t, row0, L; hr_decode(hr, sq, t, row0, L);
        const bf16_t* pa = u + (size_t)(row0 + t) * D + POOL_DIM + lane * 16; const bf16_t* pb = u + (size_t)(row0 + (t ? L - t : 0)) * D + POOL_DIM + lane * 16;
        const float mk = t ? 1.0f : 0.0f;
#pragma unroll
        for (int q = 0; q < 2; ++q) { f32x4 a0, a1, b0, b1; bf8_to_f(*(const u32x4*)(pa + 8 * q), a0, a1); bf8_to_f(*(const u32x4*)(pb + 8 * q), b0, b1);
            const f32x4 p0 = a0 + b0 * mk, p1 = a1 + b1 * mk, m0 = (a0 - b0) * mk, m1 = (a1 - b1) * mk;
            u32x4 wp, wm; wp.x = pk2(p0.x, p0.y); wp.y = pk2(p0.z, p0.w); wp.z = pk2(p1.x, p1.y); wp.w = pk2(p1.z, p1.w); wm.x = pk2(m0.x, m0.y); wm.y = pk2(m0.z, m0.w); wm.z = pk2(m1.x, m1.y); wm.w = pk2(m1.z, m1.w);
            *(u32x4*)(ufp + (size_t)hr * FD + lane * 16 + 8 * q) = wp; *(u32x4*)(ufm + (size_t)hr * FD + lane * 16 + 8 * q) = wm; }
    }
}
__device__ __forceinline__ void p_ych(Frame& F) {
    const bf16_t* u = (const bf16_t*)(F.ws + WS_U); const bf16_t* gt = (const bf16_t*)(F.ws + WS_GT); float* ych = (float*)(F.ws + WS_YCH);
    const int gw = F.bx * NWAVES + F.wave, NGW = F.G * NWAVES, lane = tid_opaque(F.wave) & 63;
    for (int it = gw; it < 9 * FD; it += NGW) { const int sq = it >> 10, cpp = it & (FD - 1); const int row = sq ? MP + (sq - 1) * LS + HS : HP;
        const bf16_t* g = gt + (size_t)(2 * cpp) * FD + lane * 16; const bf16_t* x = u + (size_t)row * D + POOL_DIM + lane * 16; float a = 0.f;
#pragma unroll
        for (int q = 0; q < 2; ++q) { f32x4 g0, g1, x0, x1; bf8_to_f(*(const u32x4*)(g + 8 * q), g0, g1); bf8_to_f(*(const u32x4*)(x + 8 * q), x0, x1);
            a += (g0.x * x0.x + g0.y * x0.y) + (g0.z * x0.z + g0.w * x0.w) + (g1.x * x1.x + g1.y * x1.y) + (g1.z * x1.z + g1.w * x1.w); }
        a = wave_sum(a); if (lane == 0) ych[it] = a; }
}
__device__ __forceinline__ void p_alt(Frame& F) {
    float* alt = (float*)(F.ws + WS_ALT);
    const int gw = F.bx * NWAVES + F.wave, NGW = F.G * NWAVES, lane = tid_opaque(F.wave) & 63;
    for (int it = gw; it < 9 * FD; it += NGW) { const int sq = it >> 10, cpp = it & (FD - 1); const int Hf = sq ? HS : HP;
        const bf16_t* y = sq ? (const bf16_t*)(F.ws + WS_YFS) + ((size_t)(sq - 1) * 2 * FD + cpp) * HS : (const bf16_t*)(F.ws + WS_YFP) + (size_t)cpp * HP;
        float a = 0.f;
        for (int ch = lane; ch < Hf / 8; ch += 64) { f32x4 v0, v1; bf8_to_f(*(const u32x4*)(y + 8 * ch), v0, v1); a += (v0.x - v0.y) + (v0.z - v0.w) + (v1.x - v1.y) + (v1.z - v1.w); }
        a = wave_sum(a); if (lane == 0) alt[it] = a; }
}
__device__ __forceinline__ void p_unfold(Frame& F) {
    const float* eb = (const float*)(F.ws + WS_EB); const float* ob = (const float*)(F.ws + WS_OB2); const float* ych = (const float*)(F.ws + WS_YCH); const float* alt = (const float*)(F.ws + WS_ALT);
    bf16_t* cat = (bf16_t*)(F.ws + WS_CAT);
    const int gw = F.bx * NWAVES + F.wave, NGW = F.G * NWAVES, lane = tid_opaque(F.wave) & 63;
    constexpr int NROWS = (HP + 1) + NSS * (HS + 1);
    for (int it = gw; it < NROWS; it += NGW) {
        int sq, k; if (it <= HP) { sq = 0; k = it; } else { const int j = it - (HP + 1); sq = 1 + j / (HS + 1); k = j % (HS + 1); }
        const int L = sq ? LS : LP, Hf = L / 2, row0 = sq ? MP + (sq - 1) * LS : 0, hrow0 = sq ? HP + (sq - 1) * HS : 0;
        const float nrm = 1.0f / sqrtf((float)L);
        const float* yc = ych + sq * FD + lane * 16;
        if (k == Hf) { const float* al = alt + sq * FD + lane * 16; bf16_t* o = cat + (size_t)(row0 + Hf) * D + POOL_DIM + lane * 16;
#pragma unroll
            for (int q = 0; q < 4; ++q) { const f32x4 v = (*(const f32x4*)(al + 4 * q) + *(const f32x4*)(yc + 4 * q)) * nrm; u32x2 w; w.x = pk2(v.x, v.y); w.y = pk2(v.z, v.w); *(u32x2*)(o + 4 * q) = w; }
        } else { const float sg = (k & 1) ? -nrm : nrm;
            const float* e = eb + (size_t)(hrow0 + k) * FD + lane * 16; const float* od = ob + (size_t)(hrow0 + k) * FD + lane * 16;
            bf16_t* o1 = cat + (size_t)(row0 + k) * D + POOL_DIM + lane * 16; bf16_t* o2 = cat + (size_t)(row0 + (k ? L - k : 0)) * D + POOL_DIM + lane * 16;
#pragma unroll
            for (int q = 0; q < 4; ++q) { const f32x4 ev = *(const f32x4*)(e + 4 * q) + *(const f32x4*)(yc + 4 * q) * sg, ov = *(const f32x4*)(od + 4 * q);
                const f32x4 f1 = ev - ov, f2 = ev + ov; u32x2 w; w.x = pk2(f1.x, f1.y); w.y = pk2(f1.z, f1.w); *(u32x2*)(o1 + 4 * q) = w;
                if (k) { u32x2 w2; w2.x = pk2(f2.x, f2.y); w2.y = pk2(f2.z, f2.w); *(u32x2*)(o2 + 4 * q) = w2; } }
        }
    }
}

__device__ __forceinline__ void p_fixup(Frame& F, const float* cw, const float* cb) {
    const float* halo = (const float*)(F.ws + WS_HALO); bf16_t* act = (bf16_t*)(F.ws + WS_ACT);
    constexpr int CH = DFF / 4;
    const int tid = tid_opaque(F.wave);
    for (int i = F.bx * NTHREADS + tid; i < (M / 128) * 2 * CH; i += F.G * NTHREADS) {
        const int ch = i % CH, be = i / CH, blk = be >> 1, e = be & 1, c = ch * 4;
        const int t = blk * 128 + (e ? 127 : 0);
        const int s0 = (t < MP) ? 0 : MP + ((t - MP) / LS) * LS, s1 = (t < MP) ? MP : s0 + LS;
        const float* hb = halo + (size_t)blk * 4 * NUP;
        f32x4 a4;
        f32x4 y[2];
#pragma unroll
        for (int bj = 0; bj < 2; ++bj) { const int cc = bj * DFF + c;
            f32x4 xl, xc, xr; const f32x4 z = {0.f, 0.f, 0.f, 0.f};
            if (e == 0) { xl = (t > s0) ? *(const f32x4*)(hb - (size_t)4 * NUP + 3 * NUP + cc) : z; xc = *(const f32x4*)(hb + cc); xr = *(const f32x4*)(hb + NUP + cc); }
            else { xl = *(const f32x4*)(hb + 2 * NUP + cc); xc = *(const f32x4*)(hb + 3 * NUP + cc); xr = (t + 1 < s1) ? *(const f32x4*)(hb + (size_t)4 * NUP + cc) : z; }
            y[bj] = xl * *(const f32x4*)(cw + cc) + xc * *(const f32x4*)(cw + NUP + cc) + xr * *(const f32x4*)(cw + 2 * NUP + cc) + *(const f32x4*)(cb + cc); }
#pragma unroll
        for (int q = 0; q < 4; ++q) { const float g = y[0][q]; a4[q] = g * __builtin_amdgcn_rcpf(1.0f + __expf(-g)) * y[1][q]; }
        u32x2 w; w.x = cvt_pk_bf16(a4[0], a4[1]); w.y = cvt_pk_bf16(a4[2], a4[3]);
        *(u32x2*)(act + (size_t)t * DFF + c) = w;
    }
}

__device__ __forceinline__ void p_combine(Frame& F) {
    const unsigned* oa0 = (const unsigned*)(F.ws + WS_OA); const unsigned* oa1 = oa0 + (size_t)(M / 2) * D; bf16_t* ob = (bf16_t*)(F.ws + WS_OB);
    const float lam = __builtin_bit_cast(float, __hip_atomic_load(F.ctl + CW_LAM, RLX_AGENT));
    const int gw = F.bx * NWAVES + F.wave, NGW = F.G * NWAVES, lane = tid_opaque(F.wave) & 63;
    for (int p = gw; p < M / 2; p += NGW) {
        const u32x4* a = (const u32x4*)(oa0 + (size_t)p * D) + lane; const u32x4* b = (const u32x4*)(oa1 + (size_t)p * D) + lane;
        u32x2* o0 = (u32x2*)(ob + (size_t)(2 * p) * D) + lane; u32x2* o1 = (u32x2*)(ob + (size_t)(2 * p + 1) * D) + lane;
#pragma unroll 8
        for (int h = 0; h < 16; ++h) { const u32x4 wa = __builtin_nontemporal_load(a + 64 * h), wb = __builtin_nontemporal_load(b + 64 * h);
            const f32x4 a0 = {bf2f(wa.x & 0xffff), bf2f(wa.y & 0xffff), bf2f(wa.z & 0xffff), bf2f(wa.w & 0xffff)}, a1 = {bf2f(wa.x >> 16), bf2f(wa.y >> 16), bf2f(wa.z >> 16), bf2f(wa.w >> 16)};
            const f32x4 b0 = {bf2f(wb.x & 0xffff), bf2f(wb.y & 0xffff), bf2f(wb.z & 0xffff), bf2f(wb.w & 0xffff)}, b1 = {bf2f(wb.x >> 16), bf2f(wb.y >> 16), bf2f(wb.z >> 16), bf2f(wb.w >> 16)};
            const f32x4 v0 = a0 - b0 * lam, v1 = a1 - b1 * lam;
            float s0 = (v0.x * v0.x + v0.y * v0.y) + (v0.z * v0.z + v0.w * v0.w), s1 = (v1.x * v1.x + v1.y * v1.y) + (v1.z * v1.z + v1.w * v1.w);
#pragma unroll
            for (int of = 1; of < 64; of <<= 1) { s0 += __shfl_xor(s0, of); s1 += __shfl_xor(s1, of); }
            const float r0 = 1.0f / sqrtf(s0 * (1.0f / 256.0f) + SUBLN_EPS), r1 = 1.0f / sqrtf(s1 * (1.0f / 256.0f) + SUBLN_EPS);
            u32x2 w0, w1; w0.x = pk2(v0.x * r0, v0.y * r0); w0.y = pk2(v0.z * r0, v0.w * r0); w1.x = pk2(v1.x * r1, v1.y * r1); w1.y = pk2(v1.z * r1, v1.w * r1);
            o0[64 * h] = w0; o1[64 * h] = w1; }
    }
}

__device__ __forceinline__ void p_final(Frame& F) {
    const float* psum = (const float*)(F.ws + WS_PSUM); const float* fn = F.in[21]; const bf16_t* xb = (const bf16_t*)(F.ws + WS_XB);
    const int gw = F.bx * NWAVES + F.wave, NGW = F.G * NWAVES, lane = tid_opaque(F.wave) & 63;
    for (int r = gw; r < M; r += NGW) {
        const float s = wave_sum(psum[(size_t)r * 64 + lane]); const float rs = 1.0f / sqrtf(s * (1.0f / D) + NORM_EPS);
        const u32x2* x = (const u32x2*)(xb + (size_t)r * D) + lane; f32x4* y = (f32x4*)(F.out + (size_t)r * D) + lane; const f32x4* g = (const f32x4*)fn + lane;
#pragma unroll 8
        for (int j = 0; j < 16; ++j) { const u32x2 w = x[64 * j]; const f32x4 v = {bf2f(w.x & 0xffff), bf2f(w.x >> 16), bf2f(w.y & 0xffff), bf2f(w.y >> 16)}; y[64 * j] = v * rs * g[64 * j]; }
    }
}

struct YFOrder {
    const char* gt; const char* ufp; const char* ufm; char* yfp; char* yfs; int G, c;
    __device__ __forceinline__ bool next(int i, pg::GUnit& un) const {
        const int id = i * G + c; if (id >= 384) return false;
        int part, pm, pn, Hf, hrow0; char* Cb;
        if (id < 128) { part = id >> 6; const int r = id & 63; pm = r & 3; pn = r >> 2; Hf = HP; hrow0 = 0; Cb = yfp + (size_t)part * FD * HP * 2; }
        else { const int j = id - 128, sq = j >> 5, r = j & 31; part = r >> 4; pm = r & 3; pn = (r >> 2) & 3; Hf = HS; hrow0 = HP + sq * HS; Cb = yfs + (size_t)(sq * 2 + part) * FD * HS * 2; }
        un.A = gt + (size_t)part * (FD * 2) + (size_t)pm * 256 * (2 * FD * 2); un.lda = 2 * FD * 2; un.B = (part ? ufm : ufp) + (size_t)(hrow0 + pn * 256) * (FD * 2); un.ldb = FD * 2; un.nt = FD / 64;
        un.C = Cb + ((size_t)pm * 256 * Hf + (size_t)pn * 256) * 2; un.ldc = (unsigned)Hf; un.grow0 = 0; un.gcol0 = 0; un.aux = 0;
        return true;
    }
};
struct EOOrder {
    const char* dftp; const char* dfts; const char* yfp; const char* yfs; char* eb; char* ob; const char* pooled; const char* poolt; char* cat; int G, c;
    __device__ __forceinline__ void eo_unit(int sq, int which, int pm, int pn, pg::GUnit& un) const {
        const int Hf = sq ? HS : HP, hrow0 = sq ? HP + (sq - 1) * HS : 0;
        un.A = (sq ? dfts : dftp) + ((size_t)which * Hf + (size_t)pm * 256) * ((size_t)Hf * 2); un.lda = (unsigned)Hf * 2u;
        un.B = (sq ? yfs + (size_t)((sq - 1) * 2 + which) * FD * HS * 2 : yfp + (size_t)which * FD * HP * 2) + (size_t)pn * 256 * ((size_t)Hf * 2); un.ldb = (unsigned)Hf * 2u; un.nt = Hf / 64;
        un.C = (which ? ob : eb) + ((size_t)(hrow0 + pm * 256) * FD + pn * 256) * 4; un.ldc = FD; un.grow0 = 0; un.gcol0 = 0; un.aux = 1;
    }
    __device__ __forceinline__ void pool_unit(int id, pg::GUnit& un) const {
        const int g = id / 288, r = id % 288, pm = r / 3, pn = r % 3;
        un.A = pooled + ((size_t)pm * 256 * POOL_DIM + g * PG) * 2; un.lda = POOL_DIM * 2; un.B = poolt + ((size_t)g * PG * PG + (size_t)pn * 256 * PG) * 2; un.ldb = PG * 2; un.nt = PG / 64;
        un.C = cat + ((size_t)pm * 256 * D + g * PG + pn * 256) * 2; un.ldc = D; un.grow0 = pm * 256; un.gcol0 = g * PG + pn * 256; un.aux = 0;
    }
    __device__ __forceinline__ bool next(int i, pg::GUnit& un) const {
        if (G == 256) {
            if (c < 128) { if (i == 0) { eo_unit(0, c >> 6, (c & 63) >> 2, c & 3, un); return true; } if (i < 4) { pool_unit(3 * c + (i - 1), un); return true; } return false; }
            const int j = c - 128;
            if (i < 2) { const int id = 2 * j + i, r = id & 31; eo_unit(1 + (id >> 5), r >> 4, (r >> 2) & 3, r & 3, un); return true; }
            if (i < 8) { pool_unit(384 + 6 * j + (i - 2), un); return true; }
            return false;
        }
        const int id = i * G + c;
        if (id < 128) { eo_unit(0, id >> 6, (id & 63) >> 2, id & 3, un); return true; }
        if (id < 384) { const int k = id - 128, r = k & 31; eo_unit(1 + (k >> 5), r >> 4, (r >> 2) & 3, r & 3, un); return true; }
        if (id < 384 + 1152) { pool_unit(id - 384, un); return true; }
        return false;
    }
};

struct Args { const float* in[22]; float* out; unsigned char* ws; int ph_lo, ph_hi; };
constexpr int N_PHASES = 32;

__global__ void __launch_bounds__(NTHREADS, 2) mk_fwd(Args args) {
    extern __shared__ __attribute__((aligned(16))) unsigned char lds[];
    Frame F;
    F.lds = (LAS unsigned char*)lds; F.MISC = (volatile LAS unsigned*)(F.lds + MISC_OFF);
    F.wave = __builtin_amdgcn_readfirstlane((int)threadIdx.x >> 6);
    F.G = gridDim.x; F.bx = blockIdx.x;
#pragma unroll
    for (int i = 0; i < 22; ++i) F.in[i] = args.in[i];
    F.out = args.out; F.ws = args.ws; F.ctl = (unsigned*)(args.ws + WS_CTL);
    unsigned char* ws = args.ws;
    for (int u = threadIdx.x; u < (LDS_BYTES - LDSCTL_OFF) / 4; u += NTHREADS) ((LAS unsigned*)(F.lds + LDSCTL_OFF))[u] = 0u;
    __syncthreads();
    XcdBarrier bar; bar.bar = F.ctl + CW_BAR; bar.x = 0; bar.st = nullptr;
    if (MK_N_LAUNCHES == 1) bar = xcd_barrier_post(F.ctl + CW_BAR, F.MISC + 8);
    const int lo = args.ph_lo, hi = args.ph_hi;
#define IN(k) (lo <= (k) && (k) < hi)
    unsigned long long pr_t0 = 0, pr_span = 0;
#ifndef PROBE_CYC
#define PROBE_CYC 0
#endif
#define PB(k) do { if (PROBE_PH == (k)) pr_t0 = PROBE_CYC ? __builtin_amdgcn_s_memtime() : __builtin_amdgcn_s_memrealtime(); } while (0)
#define PE(k) do { if (PROBE_PH == (k)) pr_span += (PROBE_CYC ? __builtin_amdgcn_s_memtime() / 1 : __builtin_amdgcn_s_memrealtime()) - pr_t0; } while (0)
#define SEAMX(k, kn) do { if (IN(k) && IN(kn)) { if (PROBE_PH == 100 || PROBE_PH == 100 + (k)) pr_t0 = __builtin_amdgcn_s_memrealtime(); xcd_barrier(bar); if (PROBE_PH == 100 || PROBE_PH == 100 + (k)) pr_span += __builtin_amdgcn_s_memrealtime() - pr_t0; } } while (0)
#define SEAM(k) SEAMX(k, (k) + 1)
    LAS unsigned char* ring = F.lds + RING_OFF;
    const int G = F.G, c = F.bx;
    float* rstd = (float*)(ws + WS_RSTD); float* psum = (float*)(ws + WS_PSUM); bf16_t* xb = (bf16_t*)(ws + WS_XB);

    PB(0);
    if (IN(0)) p_prologue(F);
    PE(0);
    SEAM(0);
    PB(1);
    if (IN(1)) { pg::DenseOrder S{(const char*)xb, (const char*)(ws + WS_WIN), (char*)(ws + WS_U), D * 2, D * 2, D, 2, M / 256, D / 256, D / 64, G, c, 4};
        pg::EpiBf16 E{rstd}; pg::gemm_phase<pg::EpiBf16, pg::DenseOrder, true, true>(ring, S, E, F.wave, pr_span); }
    PE(1);
    SEAM(1);
    PB(2);
    if (IN(2)) { p_pool(F); p_fold(F); p_ych(F); }
    PE(2);
    SEAMX(2, 3);
    PB(3);
    if (IN(3)) { YFOrder S{(const char*)(ws + WS_GT), (const char*)(ws + WS_UFP), (const char*)(ws + WS_UFM), (char*)(ws + WS_YFP), (char*)(ws + WS_YFS), G, c};
        pg::EpiBf16 E{nullptr}; pg::gemm_phase<pg::EpiBf16, YFOrder, true, true>(ring, S, E, F.wave, pr_span); }
    PE(3);
    SEAMX(3, 19);
    PB(19);
    if (IN(19)) { p_alt(F);
        EOOrder S{(const char*)(ws + WS_DFTP), (const char*)(ws + WS_DFTS), (const char*)(ws + WS_YFP), (const char*)(ws + WS_YFS), (char*)(ws + WS_EB), (char*)(ws + WS_OB2), (const char*)(ws + WS_POOLED), (const char*)(ws + WS_POOLT), (char*)(ws + WS_CAT), G, c};
        pg::EpiMix E{}; pg::gemm_phase<pg::EpiMix, EOOrder, true, true>(ring, S, E, F.wave, pr_span); }
    PE(19);
    SEAMX(19, 20);
    PB(20);
    if (IN(20)) p_unfold(F);
    PE(20);
    SEAMX(20, 4);
    PB(4);
    if (IN(4)) { pg::DenseOrder S{(const char*)(ws + WS_CAT), (const char*)(ws + WS_WOE), nullptr, D * 2, D * 2, D, 4, M / 256, D / 256, D / 64, G, c, 4};
        pg::EpiResid E{xb, psum}; pg::gemm_phase<pg::EpiResid, pg::DenseOrder, true, true>(ring, S, E, F.wave, pr_span); }
    PE(4);
    SEAM(4);
    PB(5);
    if (IN(5)) p_finalize_rstd(F);
    PE(5);
    SEAM(5);
    PB(6);
    if (IN(6)) { pg::DynOrder S{{(const char*)xb, (const char*)(ws + WS_WUP), nullptr, D * 2, D * 2, 0, 0, M / 256, NUP / 256, D / 64, G, c, 4}, F.ctl + CW_DYN, F.MISC + 16, F.wave, 1};
        pg::EpiFfnUp E{(bf16_t*)(ws + WS_ACT), (float*)(ws + WS_HALO), rstd, F.in[18], F.in[19]}; pg::gemm_phase<pg::EpiFfnUp, pg::DynOrder, true, true>(ring, S, E, F.wave, pr_span);
        p_wdn_filler(F, 0, F.ctl + CW_DYN + 64 * 2); }
    PE(6);
    SEAM(6);
    PB(7);
    if (IN(7)) p_fixup(F, F.in[18], F.in[19]);
    PE(7);
    SEAM(7);
    PB(8);
    if (IN(8)) { pg::DenseOrder S{(const char*)(ws + WS_ACT), (const char*)(ws + WS_WDN), nullptr, DFF * 2, DFF * 2, D, 4, M / 256, D / 256, DFF / 64, G, c, 4};
        pg::EpiResid E{xb, psum}; pg::gemm_phase<pg::EpiResid, pg::DenseOrder, true, true>(ring, S, E, F.wave, pr_span); }
    PE(8);
    SEAM(8);
    PB(9);
    if (IN(9)) p_finalize_rstd(F);
    PE(9);
    SEAM(9);
    PB(10);
    if (IN(10)) { pg::DenseOrder S{(const char*)xb, (const char*)(ws + WS_WQKV), (char*)(ws + WS_QKV), D * 2, D * 2, NQKV, 2, M / 256, NQKV / 256, D / 64, G, c, 4};
        pg::EpiQkv E{rstd, (const float*)(ws + WS_ROT)}; pg::gemm_phase<pg::EpiQkv, pg::DenseOrder, true, true>(ring, S, E, F.wave, pr_span); }
    PE(10);
    SEAM(10);
    PB(11);
    if (IN(11)) {
        const bf16_t* qkv = (const bf16_t*)(ws + WS_QKV); bf16_t* oa = (bf16_t*)(ws + WS_OA);
        const int nun = 1024 + 2048;
        for (int i = 0;; ++i) {
            int id;
            if (G == 256) { const int x = c & 7, j = c >> 3;
                if (i < 4) id = (4 * x + i) * 32 + j;
                else if (i < 10) { const int p = 32 * x + 4 * (i - 4) + (j >> 3); id = 1024 + p * 8 + (j & 7); }
                else {
                    if (threadIdx.x == 0) F.MISC[20] = __hip_atomic_fetch_add(F.ctl + CW_DYN + 64 * 8, 1u, __ATOMIC_RELAXED, __HIP_MEMORY_SCOPE_AGENT);
                    __syncthreads();
                    const unsigned t = (unsigned)__builtin_amdgcn_readfirstlane((int)F.MISC[20]);
                    __syncthreads();
                    if (t >= 512u) break;
                    const int p = 32 * (int)(t >> 6) + 24 + (int)((t & 63u) >> 3); id = 1024 + p * 8 + (int)(t & 7u);
                }
            } else { id = i * G + c; if (id >= nun) break; }
            int row0, L, hm, qb;
            if (id < 1024) { hm = id >> 5; qb = id & 31; row0 = 0; L = LP; }
            else { const int k = id - 1024, p = k >> 3; qb = k & 7; hm = p & 31; row0 = MP + (p >> 5) * LS; L = LS; }
            const int h = hm >> 1, m = hm & 1;
            const bf16_t* Qb = qkv + (size_t)(row0 + qb * 256) * NQKV + h * 256 + m * 128;
            const bf16_t* Kh = qkv + (size_t)row0 * NQKV + D + h * 256 + m * 128;
            const bf16_t* Vh = qkv + (size_t)row0 * NQKV + 2 * D + h * 256;
            bf16_t* Ob = oa + (size_t)m * M * D + (size_t)(row0 + qb * 256) * D + 2 * (h * 256);
            at::attn256_body(Qb, Kh, Vh, Ob, L, (char*)lds + RING_OFF, F.wave);
        }
    }
    PE(11);
    SEAM(11);
    PB(12);
    if (IN(12)) p_combine(F);
    PE(12);
    SEAM(12);
    PB(13);
    if (IN(13)) { pg::DenseOrder S{(const char*)(ws + WS_OB), (const char*)(ws + WS_WOO), nullptr, D * 2, D * 2, D, 4, M / 256, D / 256, D / 64, G, c, 4};
        pg::EpiResid E{xb, psum}; pg::gemm_phase<pg::EpiResid, pg::DenseOrder, true, true>(ring, S, E, F.wave, pr_span); }
    PE(13);
    SEAM(13);
    PB(14);
    if (IN(14)) p_finalize_rstd(F);
    PE(14);
    SEAM(14);
    PB(15);
    if (IN(15)) { pg::DynOrder S{{(const char*)xb, (const char*)(ws + WS_WUP + (size_t)NUP * D * 2), nullptr, D * 2, D * 2, 0, 0, M / 256, NUP / 256, D / 64, G, c, 4}, F.ctl + CW_DYN + 64, F.MISC + 18, F.wave, 1};
        pg::EpiFfnUp E{(bf16_t*)(ws + WS_ACT), (float*)(ws + WS_HALO), rstd, F.in[18] + 3 * NUP, F.in[19] + NUP}; pg::gemm_phase<pg::EpiFfnUp, pg::DynOrder, true, true>(ring, S, E, F.wave, pr_span);
        p_wdn_filler(F, 1, F.ctl + CW_DYN + 64 * 3); }
    PE(15);
    SEAM(15);
    PB(16);
    if (IN(16)) p_fixup(F, F.in[18] + 3 * NUP, F.in[19] + NUP);
    PE(16);
    SEAM(16);
    PB(17);
    if (IN(17)) { pg::DenseOrder S{(const char*)(ws + WS_ACT), (const char*)(ws + WS_WDN + (size_t)D * DFF * 2), nullptr, DFF * 2, DFF * 2, D, 4, M / 256, D / 256, DFF / 64, G, c, 4};
        pg::EpiResid E{xb, psum}; pg::gemm_phase<pg::EpiResid, pg::DenseOrder, true, true>(ring, S, E, F.wave, pr_span); }
    PE(17);
    SEAM(17);
    PB(18);
    if (IN(18)) p_final(F);
    PE(18);
    if (PROBE_PH >= 0) { const unsigned long long te = __builtin_amdgcn_s_memrealtime(); while (__builtin_amdgcn_s_memrealtime() - te < (PROBE_CYC ? pr_span / 24 : pr_span)) __builtin_amdgcn_s_sleep(16); }
#undef PB
#undef PE
#undef IN
#undef SEAM
#undef SEAMX
}

extern "C" void kernel_launch(void* const* d_in, const int* in_sizes, int n_in, void* d_out, int out_size, void* d_ws, size_t ws_size, hipStream_t stream) {
    static int grid = 0;
    if (grid == 0) {
        if (n_in != 22 || out_size != M * D || ws_size < WS_END) { fprintf(stderr, "kernel_launch: unexpected shapes: n_in %d out %d ws %zu (need %zu)\n", n_in, out_size, ws_size, (size_t)WS_END); grid = -1; return; }
        int dev = 0, cus = 0, per_cu = 0;
        if (hipGetDevice(&dev) != hipSuccess || hipDeviceGetAttribute(&cus, hipDeviceAttributeMultiprocessorCount, dev) != hipSuccess) { grid = -1; return; }
        if (hipFuncSetAttribute((const void*)mk_fwd, hipFuncAttributeMaxDynamicSharedMemorySize, LDS_BYTES) != hipSuccess) { fprintf(stderr, "kernel_launch: hipFuncSetAttribute failed\n"); grid = -1; return; }
        if (hipOccupancyMaxActiveBlocksPerMultiprocessor(&per_cu, (const void*)mk_fwd, NTHREADS, LDS_BYTES) != hipSuccess || per_cu < 1)
            fprintf(stderr, "kernel_launch: note: occupancy query reports %d workgroups per CU\n", per_cu);
        (void)hipGetLastError();
        grid = cus;
    }
    if (grid < 0) return;
    if (hipMemsetAsync((char*)d_ws + WS_CTL, 0, CTL_ZERO_BYTES, stream) != hipSuccess) { fprintf(stderr, "kernel_launch: memset failed\n"); return; }
    Args a{};
    for (int i = 0; i < 22; ++i) a.in[i] = (const float*)d_in[i];
    a.out = (float*)d_out; a.ws = (unsigned char*)d_ws;
#if MK_N_LAUNCHES == 1
    a.ph_lo = 0; a.ph_hi = N_PHASES;
    hipLaunchKernelGGL(mk_fwd, dim3(grid), dim3(NTHREADS), LDS_BYTES, stream, a);
#else
    { static const int order[21] = {0, 1, 2, 3, 19, 20, 4, 5, 6, 7, 8, 9, 10, 11, 12, 13, 14, 15, 16, 17, 18};
      for (int p = 0; p < 21; ++p) { a.ph_lo = order[p]; a.ph_hi = order[p] + 1; hipLaunchKernelGGL(mk_fwd, dim3(grid), dim3(NTHREADS), LDS_BYTES, stream, a); } }
#endif
    const hipError_t le = hipPeekAtLastError();
    if (le != hipSuccess) fprintf(stderr, "kernel_launch: launch failed: %s\n", hipGetErrorName(le));
}
```
